# Optimizing an MI355X kernel written in HIP

```python
import jax, jax.numpy as jnp
from jax import lax
import numpy as np

D_MODEL = 1024
BATCH = 2
SEQ = 8192
DEPTH = 4
DEC_BATCH = 32
DEC_SEQ = 1
PAST_LEN = 8192
PAGE_SIZE = 128

N_MIXERS = 2
N_ATTN_LAYERS = (DEPTH + 1) // 2
N_CONV_LAYERS = DEPTH // 2
N_HEADS = 16
HEAD_DIM = D_MODEL // N_HEADS
N_KV_HEADS = 4
GROUP = N_HEADS // N_KV_HEADS
IDX_HEADS = 8
IDX_DIM = 64
TOPK_MAX = 256
Q_BLOCK = 128
CONV_WIDTH = 3
D_FF = 2816
N_MOD = 9
RMS_EPS = 1e-6
ATTN_SPLITS = (N_HEADS * HEAD_DIM, N_KV_HEADS * HEAD_DIM, N_KV_HEADS * HEAD_DIM,
               IDX_HEADS * IDX_DIM, IDX_DIM, IDX_HEADS)
ATTN_IN_COLS = sum(ATTN_SPLITS)

kernel_name = 'hybrid_dsa_shortconv_macaron_adaln_step'


def rms_norm(x):
    x32 = x.astype(jnp.float32)
    y = x32 * lax.rsqrt(jnp.mean(x32 * x32, axis=-1, keepdims=True) + RMS_EPS)
    return y.astype(x.dtype)


def adaln_params(c, w_ada, b_ada):
    m = jax.nn.silu(c) @ w_ada + b_ada
    return m.reshape(c.shape[0], N_MOD, D_MODEL)[:, :, None, :]


def modulate(x, shift, scale):
    return rms_norm(x) * (1 + scale) + shift


def swiglu(h, w_in, w_out):
    a, g = jnp.split(h @ w_in, 2, axis=-1)
    return (jax.nn.silu(a) * g) @ w_out


def split_cols(p, sizes):
    offsets = np.cumsum(np.array(sizes))[:-1].tolist()
    return jnp.split(p, offsets, axis=-1)


def gather_rows(rows, idx):
    return jax.vmap(lambda r, i: r[i])(rows, idx)


def attn_project(h, w_in, q_gain, k_gain):
    B, T, _ = h.shape
    q, k, v, qi, ki, wi = split_cols(h @ w_in, ATTN_SPLITS)
    q = rms_norm(q.reshape(B, T, N_HEADS, HEAD_DIM)) * q_gain
    k = rms_norm(k.reshape(B, T, N_KV_HEADS, HEAD_DIM)) * k_gain
    v = v.reshape(B, T, N_KV_HEADS, HEAD_DIM)
    qi = qi.reshape(B, T, IDX_HEADS, IDX_DIM)
    wi = wi * IDX_HEADS ** -0.5
    return q, k, v, qi, ki, wi


def indexer_scores(qi, ki, wi):
    s = jnp.einsum('bqhd,bsd->bqhs', qi, ki).astype(jnp.float32) * IDX_DIM ** -0.5
    return jnp.einsum('bqh,bqhs->bqs', wi.astype(jnp.float32), jax.nn.relu(s))


def select_topk(scores, qpos, topk):
    keypos = jnp.arange(scores.shape[-1])
    scores = jnp.where(keypos[None, None, :] <= qpos[None, :, None], scores, -jnp.inf)
    _, idx = lax.top_k(scores, topk)
    return idx, idx <= qpos[None, :, None]


def attend_selected(q, ksel, vsel, valid):
    B, T = q.shape[:2]
    qg = q.reshape(B, T, N_KV_HEADS, GROUP, HEAD_DIM)
    logits = jnp.einsum('bqhgd,bqnhd->bqhgn', qg, ksel).astype(jnp.float32) * HEAD_DIM ** -0.5
    logits = jnp.where(valid[:, :, None, None, :], logits, -jnp.inf)
    p = jax.nn.softmax(logits, axis=-1).astype(vsel.dtype)
    o = jnp.einsum('bqhgn,bqnhd->bqhgd', p, vsel)
    return o.reshape(B, T, N_HEADS * HEAD_DIM)


def dsa_prompt(q, k, v, qi, ki, wi):
    B, T = q.shape[:2]
    topk = min(TOPK_MAX, T // 4)
    nb = T // Q_BLOCK

    def blocks(a):
        return jnp.moveaxis(a.reshape(B, nb, Q_BLOCK, *a.shape[2:]), 1, 0)

    def one_block(args):
        i, qb, qib, wib = args
        qpos = i * Q_BLOCK + jnp.arange(Q_BLOCK)
        idx, valid = select_topk(indexer_scores(qib, ki, wib), qpos, topk)
        return attend_selected(qb, gather_rows(k, idx), gather_rows(v, idx), valid)

    out = lax.map(one_block, (jnp.arange(nb), blocks(q), blocks(qi), blocks(wi)))
    return jnp.moveaxis(out, 0, 1).reshape(B, T, N_HEADS * HEAD_DIM)


def dsa_sample(q, k, v, qi, ki, wi, cache_k, cache_v, cache_kidx, page_table):
    DB, TN = q.shape[:2]
    n_pages = page_table.shape[1]
    past = n_pages * PAGE_SIZE
    topk = min(TOPK_MAX, (past + TN) // 4)
    ki_past = cache_kidx[page_table].reshape(DB, past, IDX_DIM)
    ki_all = jnp.concatenate([ki_past, ki.astype(ki_past.dtype)], axis=1)
    qpos = past + jnp.arange(TN)
    idx, valid = select_topk(indexer_scores(qi, ki_all, wi), qpos, topk)
    in_past = (idx < past)[..., None, None]
    page = gather_rows(page_table, jnp.minimum(idx // PAGE_SIZE, n_pages - 1))
    phys = page * PAGE_SIZE + idx % PAGE_SIZE
    k_pool = cache_k.reshape(-1, N_KV_HEADS, HEAD_DIM)
    v_pool = cache_v.reshape(-1, N_KV_HEADS, HEAD_DIM)
    new_i = jnp.clip(idx - past, 0, TN - 1)
    ksel = jnp.where(in_past, k_pool[phys], gather_rows(k, new_i))
    vsel = jnp.where(in_past, v_pool[phys], gather_rows(v, new_i))
    return attend_selected(q, ksel, vsel, valid)


def short_conv(h, prefix, w_in, conv_w, w_out):
    T = h.shape[1]
    b_gate, c_gate, u = jnp.split(h @ w_in, 3, axis=-1)
    z = jnp.concatenate([prefix.astype(h.dtype), c_gate * u], axis=1)
    y = conv_w[0] * z[:, 0:T]
    for j in range(1, CONV_WIDTH):
        y = y + conv_w[j] * z[:, j:j + T]
    return (b_gate * y) @ w_out, z[:, z.shape[1] - (CONV_WIDTH - 1):]


def macaron_layer(x, mod, ffn1, ffn2, mixer):
    x = x + 0.5 * mod[:, 2] * swiglu(modulate(x, mod[:, 0], mod[:, 1]), ffn1[0], ffn1[1])
    mix_out, state = mixer(modulate(x, mod[:, 3], mod[:, 4]))
    x = x + mod[:, 5] * mix_out
    x = x + 0.5 * mod[:, 8] * swiglu(modulate(x, mod[:, 6], mod[:, 7]), ffn2[0], ffn2[1])
    return x, state


def setup_inputs(seed: int = 0) -> dict:
    key = jax.random.key(seed)
    ks = jax.random.split(key, 20)
    n_pages = PAST_LEN // PAGE_SIZE
    n_used = DEC_BATCH * n_pages
    n_pool = n_used + max(1, n_used // 4)

    def nrm(k, shape, scale=1.0):
        return jax.random.normal(k, shape, jnp.float32) * scale

    page_table = jax.random.permutation(ks[0], n_pool)[:n_used].reshape(DEC_BATCH, n_pages).astype(jnp.int32)
    return {
        'x_prompt': nrm(ks[1], (BATCH, SEQ, D_MODEL)),
        'x_sample': nrm(ks[2], (DEC_BATCH, DEC_SEQ, D_MODEL)),
        'cache_k': nrm(ks[3], (N_ATTN_LAYERS, n_pool, PAGE_SIZE, N_KV_HEADS, HEAD_DIM)),
        'cache_v': nrm(ks[4], (N_ATTN_LAYERS, n_pool, PAGE_SIZE, N_KV_HEADS, HEAD_DIM)),
        'cache_kidx': nrm(ks[5], (N_ATTN_LAYERS, n_pool, PAGE_SIZE, IDX_DIM)),
        'state_conv': nrm(ks[6], (N_CONV_LAYERS, DEC_BATCH, CONV_WIDTH - 1, D_MODEL)),
        'page_table': page_table,
        'c_prompt': nrm(ks[7], (BATCH, D_MODEL)),
        'c_sample': nrm(ks[8], (DEC_BATCH, D_MODEL)),
        'w_ada': nrm(ks[9], (DEPTH, D_MODEL, N_MOD * D_MODEL), 0.5 * D_MODEL ** -0.5),
        'b_ada': nrm(ks[10], (DEPTH, N_MOD * D_MODEL), 0.02),
        'w_ffn_in': nrm(ks[11], (DEPTH, 2, D_MODEL, 2 * D_FF), D_MODEL ** -0.5),
        'w_ffn_out': nrm(ks[12], (DEPTH, 2, D_FF, D_MODEL), D_FF ** -0.5),
        'w_attn_in': nrm(ks[13], (N_ATTN_LAYERS, D_MODEL, ATTN_IN_COLS), D_MODEL ** -0.5),
        'w_attn_out': nrm(ks[14], (N_ATTN_LAYERS, N_HEADS * HEAD_DIM, D_MODEL), (N_HEADS * HEAD_DIM) ** -0.5),
        'q_norm_gain': 1.0 + nrm(ks[15], (N_ATTN_LAYERS, HEAD_DIM), 0.05),
        'k_norm_gain': 1.0 + nrm(ks[16], (N_ATTN_LAYERS, HEAD_DIM), 0.05),
        'w_conv_in': nrm(ks[17], (N_CONV_LAYERS, D_MODEL, 3 * D_MODEL), D_MODEL ** -0.5),
        'conv_w': nrm(ks[18], (N_CONV_LAYERS, CONV_WIDTH, D_MODEL), CONV_WIDTH ** -0.5),
        'w_conv_out': nrm(ks[19], (N_CONV_LAYERS, D_MODEL, D_MODEL), D_MODEL ** -0.5),
    }


def reference(x_prompt, x_sample, cache_k, cache_v, cache_kidx, state_conv, page_table,
              c_prompt, c_sample, w_ada, b_ada, w_ffn_in, w_ffn_out, w_attn_in, w_attn_out,
              q_norm_gain, k_norm_gain, w_conv_in, conv_w, w_conv_out):
    xp, xs = x_prompt, x_sample
    pk, pv, pki, pconv = [], [], [], []
    sk, sv, ski, sconv = [], [], [], []
    for layer in range(DEPTH):
        mp = adaln_params(c_prompt, w_ada[layer], b_ada[layer])
        ms = adaln_params(c_sample, w_ada[layer], b_ada[layer])
        ffn1 = (w_ffn_in[layer, 0], w_ffn_out[layer, 0])
        ffn2 = (w_ffn_in[layer, 1], w_ffn_out[layer, 1])
        li = layer // N_MIXERS
        if layer % N_MIXERS == 0:
            wa_in, wa_out = w_attn_in[li], w_attn_out[li]
            qg, kg = q_norm_gain[li], k_norm_gain[li]

            def prompt_mixer(h):
                q, k, v, qi, ki, wi = attn_project(h, wa_in, qg, kg)
                return dsa_prompt(q, k, v, qi, ki, wi) @ wa_out, (k, v, ki)

            def sample_mixer(h):
                q, k, v, qi, ki, wi = attn_project(h, wa_in, qg, kg)
                o = dsa_sample(q, k, v, qi, ki, wi, cache_k[li], cache_v[li], cache_kidx[li], page_table)
                return o @ wa_out, (k, v, ki)

            xp, (k_p, v_p, ki_p) = macaron_layer(xp, mp, ffn1, ffn2, prompt_mixer)
            xs, (k_s, v_s, ki_s) = macaron_layer(xs, ms, ffn1, ffn2, sample_mixer)
            pk.append(k_p); pv.append(v_p); pki.append(ki_p)
            sk.append(k_s); sv.append(v_s); ski.append(ki_s)
        else:
            wc_in, cw, wc_out = w_conv_in[li], conv_w[li], w_conv_out[li]
            zero_prefix = jnp.zeros((xp.shape[0], CONV_WIDTH - 1, D_MODEL), xp.dtype)
            past_prefix = state_conv[li]
            xp, st_p = macaron_layer(xp, mp, ffn1, ffn2,
                                     lambda h: short_conv(h, zero_prefix, wc_in, cw, wc_out))
            xs, st_s = macaron_layer(xs, ms, ffn1, ffn2,
                                     lambda h: short_conv(h, past_prefix, wc_in, cw, wc_out))
            pconv.append(st_p)
            sconv.append(st_s)
    new_k_prompt = jnp.stack(pk)
    new_v_prompt = jnp.stack(pv)
    new_kidx_prompt = jnp.stack(pki)
    new_conv_prompt = jnp.stack(pconv)
    new_k_sample = jnp.stack(sk)
    new_v_sample = jnp.stack(sv)
    new_kidx_sample = jnp.stack(ski)
    new_conv_sample = jnp.stack(sconv)
    return (xp, xs, new_k_prompt, new_v_prompt, new_kidx_prompt, new_conv_prompt,
            new_k_sample, new_v_sample, new_kidx_sample, new_conv_sample)
```

```cpp
#include <hip/hip_runtime.h>
#include <cstdio>
#include <cstdint>
namespace pg8 {
#define PG8_LAS __attribute__((address_space(3)))
typedef unsigned short bf16_t;
typedef short bf16x8 __attribute__((ext_vector_type(8)));
typedef float f32x4 __attribute__((ext_vector_type(4)));
typedef unsigned u32x4 __attribute__((ext_vector_type(4)));
constexpr int BM = 256, BK = 64, HALF = 128, HTB = HALF * BK * 2  , STAGE_BYTES = 8 * HTB, NXCD = 8, WGM = 8;

__host__ __device__ __forceinline__ int lds_byte(int r, int c) { const int st = (r >> 4) * 2 + (c >> 5), rr = r & 15, cc = c & 31, ob = rr * 64 + cc * 2; return st * 1024 + (ob ^ (((ob >> 9) & 1) << 5)); }
__host__ __device__ __forceinline__ void stage_rc(int b, int& R, int& C) { const int st = b / 1024, sb = b % 1024, swz = sb ^ (((sb >> 9) & 1) << 5); R = (st >> 1) * 16 + swz / 64; C = (st & 1) * 32 + (swz % 64) / 2; }
__host__ __device__ __forceinline__ int perm32(int rho) { const int n = rho >> 4, i = rho & 15; return 8 * (i >> 2) + 4 * n + (i & 3); }

struct Unit { int pm, pn; };
struct Gemm { const bf16_t* A; const bf16_t* Bt; int M, N, K; };

struct StaticOrder {
    int nM, nN, nwg, G, c;
    __host__ __device__ void init(int M, int N, int G_, int c_) { nM = M / BM; nN = N / BM; nwg = nM * nN; G = G_; c = c_; }
    __host__ __device__ __forceinline__ bool next(int i, Unit& u) const {
        const long L = (long)i * G + c; if (L >= nwg) return false;
        int wgid = (int)L; { const int q = nwg / NXCD, r = nwg % NXCD, xcd = wgid % NXCD, off = wgid / NXCD; wgid = (xcd < r ? xcd * (q + 1) : r * (q + 1) + (xcd - r) * q) + off; }
        const int nig = WGM * nN, gid = wgid / nig, fm = gid * WGM, gsz = (nM - fm) < WGM ? (nM - fm) : WGM;
        u.pm = fm + ((wgid % nig) % gsz); u.pn = (wgid % nig) / gsz; return true;
    }
    __device__ __forceinline__ void a_ready(const Unit&) const {}
    __device__ __forceinline__ void done(const Unit&) const {}
};

__device__ __forceinline__ unsigned cvt_pk_bf16(float lo, float hi) { unsigned r; asm volatile("v_cvt_pk_bf16_f32 %0, %1, %2" : "=v"(r) : "v"(lo), "v"(hi)); return r; }
typedef float f32x2 __attribute__((ext_vector_type(2)));
template <class Epi, class Sched, bool ALIGN_EPI = false, bool SP2 = false>
__device__ __forceinline__ void gemm_phase(PG8_LAS unsigned char* lds, const Gemm g, const Sched S, const Epi E) {
    int tid_ = threadIdx.x; asm volatile("" : "+v"(tid_));
    const int tid = tid_, wid = __builtin_amdgcn_readfirstlane(tid >> 6), lane = tid & 63, wr = wid >> 2, wc = wid & 3, fr = lane & 15, fq = lane >> 4;
    const int K = g.K, nt = K / BK;
    unsigned voffA[2], voffB[2];
#pragma unroll
    for (int i = 0; i < 2; ++i) { int R, C; stage_rc(tid * 16 + i * 8192, R, C); const int Rb = Epi::PERM ? ((R & ~31) + perm32(R & 31)) : R;
        voffA[i] = (unsigned)(R * K + C) * 2u; voffB[i] = (unsigned)(Rb * K + C) * 2u; }
    const size_t kstep = (size_t)(BK * 2);
    const size_t hstep = (size_t)HALF * K * 2;
    const size_t tstep = 2 * hstep;
    const unsigned ldsw = (unsigned)wid * 1024u;
    const int aoff = lds_byte(wr * 64 + fr, fq * 8), boff = lds_byte(wc * 32 + fr, fq * 8);
#define PG8_SA(b, h) (((b) * 2 + (h)) * HTB)
#define PG8_SB(b, h) ((4 + (b) * 2 + (h)) * HTB)
#define PG8_STAGE(bufoff, gbase, voff) do { _Pragma("unroll") for (int _i = 0; _i < 2; ++_i) \
        __builtin_amdgcn_global_load_lds((const unsigned*)((const char*)(gbase) + (voff)[_i]), (PG8_LAS unsigned*)(lds + (bufoff) + ldsw + _i * 8192), 16, 0, 0); } while (0)
#define PG8_LDA(dst, b, h) do { _Pragma("unroll") for (int m = 0; m < 4; ++m) _Pragma("unroll") for (int k = 0; k < 2; ++k) dst[m][k] = *(const PG8_LAS bf16x8*)(lds + PG8_SA(b, h) + aoff + m * 2048 + k * 1024); } while (0)
#define PG8_LDB(dst, b, h) do { _Pragma("unroll") for (int n = 0; n < 2; ++n) _Pragma("unroll") for (int k = 0; k < 2; ++k) dst[n][k] = *(const PG8_LAS bf16x8*)(lds + PG8_SB(b, h) + boff + n * 2048 + k * 1024); } while (0)
#define PG8_MMA(ai, bj, At, Bt) do { __builtin_amdgcn_s_setprio(1); _Pragma("unroll") for (int m = 0; m < 4; ++m) _Pragma("unroll") for (int n = 0; n < 2; ++n) _Pragma("unroll") for (int k = 0; k < 2; ++k) \
        acc[ai][bj][m][n] = __builtin_amdgcn_mfma_f32_16x16x32_bf16(Bt[n][k], At[m][k], acc[ai][bj][m][n], 0, 0, 0); __builtin_amdgcn_s_setprio(0); } while (0)
#define PG8_WAIT_V(n) asm volatile("s_waitcnt vmcnt(" #n ")" ::: "memory")
#define PG8_WAIT_L(n) asm volatile("s_waitcnt lgkmcnt(" #n ")" ::: "memory")
#define PG8_BAR __builtin_amdgcn_s_barrier()
#define PG8_SCHED __builtin_amdgcn_sched_barrier(0)
    Unit cur, nxt; int ui = 0;
    if (!S.next(0, cur)) return;
    f32x4 acc[2][2][4][2];
#pragma unroll
    for (int a = 0; a < 2; ++a)
#pragma unroll
        for (int b = 0; b < 2; ++b)
#pragma unroll
            for (int m = 0; m < 4; ++m)
#pragma unroll
                for (int n = 0; n < 2; ++n) acc[a][b][m][n] = (f32x4){0.f, 0.f, 0.f, 0.f};
    bf16x8 At[4][2], B0[2][2], B1[2][2];
    const char* cA = (const char*)g.A + (size_t)cur.pm * tstep; const char* cB = (const char*)g.Bt + (size_t)cur.pn * tstep;
    S.a_ready(cur);
    if constexpr (SP2) {
        PG8_STAGE(PG8_SB(0, 0), cB, voffB); PG8_STAGE(PG8_SB(0, 1), cB + hstep, voffB); PG8_STAGE(PG8_SA(0, 0), cA, voffA); PG8_STAGE(PG8_SA(0, 1), cA + hstep, voffA);
        if (wr == 1) PG8_BAR;
        PG8_WAIT_V(2); PG8_BAR;
        PG8_STAGE(PG8_SB(1, 0), cB + kstep, voffB); PG8_STAGE(PG8_SA(1, 0), cA + kstep, voffA); PG8_STAGE(PG8_SB(1, 1), cB + hstep + kstep, voffB);
        PG8_WAIT_V(6); PG8_BAR;
    } else {
        PG8_STAGE(PG8_SB(0, 0), cB, voffB); PG8_STAGE(PG8_SA(0, 0), cA, voffA); PG8_STAGE(PG8_SB(0, 1), cB + hstep, voffB); PG8_STAGE(PG8_SA(0, 1), cA + hstep, voffA);
        if (wr == 1) PG8_BAR;
        PG8_WAIT_V(4); PG8_BAR;
        PG8_STAGE(PG8_SB(1, 0), cB + kstep, voffB); PG8_STAGE(PG8_SA(1, 0), cA + kstep, voffA); PG8_STAGE(PG8_SB(1, 1), cB + hstep + kstep, voffB);
        PG8_WAIT_V(6); PG8_BAR;
    }
    for (;;) {
        const bool has_next = S.next(ui + 1, nxt);
        const char* nA = has_next ? (const char*)g.A + (size_t)nxt.pm * tstep : cA; const char* nB = has_next ? (const char*)g.Bt + (size_t)nxt.pn * tstep : cB;
        for (int t = 0; t < nt; t += 2) {
            const bool last = (t == nt - 2);
            const char* a1 = cA + (size_t)(t + 1) * kstep;
            const char* a2 = last ? nA : cA + (size_t)(t + 2) * kstep; const char* b2 = last ? nB : cB + (size_t)(t + 2) * kstep;
            const char* a3 = a2 + kstep; const char* b3 = b2 + kstep;
            if (last && has_next) S.a_ready(nxt);
            if constexpr (SP2) {
            PG8_LDB(B0, 0, 0); PG8_LDB(B1, 0, 1); PG8_SCHED; PG8_LDA(At, 0, 0); PG8_STAGE(PG8_SA(1, 1), a1 + hstep, voffA);
            PG8_WAIT_V(8); PG8_WAIT_L(0); PG8_BAR; PG8_MMA(0, 0, At, B0); PG8_MMA(0, 1, At, B1); PG8_BAR; PG8_SCHED;
            PG8_LDA(At, 0, 1); PG8_STAGE(PG8_SB(0, 0), b2, voffB); PG8_STAGE(PG8_SB(0, 1), b2 + hstep, voffB); PG8_STAGE(PG8_SA(0, 0), a2, voffA);
            PG8_WAIT_V(8); PG8_WAIT_L(0); PG8_BAR; PG8_MMA(1, 0, At, B0); PG8_MMA(1, 1, At, B1); PG8_BAR; PG8_SCHED;
            PG8_LDB(B0, 1, 0); PG8_LDB(B1, 1, 1); PG8_SCHED; PG8_LDA(At, 1, 0); PG8_STAGE(PG8_SA(0, 1), a2 + hstep, voffA);
            PG8_WAIT_V(8); PG8_WAIT_L(0); PG8_BAR; PG8_MMA(0, 0, At, B0); PG8_MMA(0, 1, At, B1); PG8_BAR; PG8_SCHED;
            PG8_LDA(At, 1, 1); PG8_STAGE(PG8_SB(1, 0), b3, voffB); PG8_STAGE(PG8_SB(1, 1), b3 + hstep, voffB); PG8_STAGE(PG8_SA(1, 0), a3, voffA);
            PG8_WAIT_V(8); PG8_WAIT_L(0); PG8_BAR; PG8_MMA(1, 0, At, B0); PG8_MMA(1, 1, At, B1); PG8_BAR; PG8_SCHED;
            } else {
            PG8_LDB(B0, 0, 0); PG8_SCHED; PG8_LDA(At, 0, 0); PG8_STAGE(PG8_SA(1, 1), a1 + hstep, voffA);
            PG8_WAIT_L(8); PG8_BAR; PG8_WAIT_L(0); PG8_MMA(0, 0, At, B0); PG8_BAR; PG8_SCHED;
            PG8_LDB(B1, 0, 1); PG8_STAGE(PG8_SB(0, 0), b2, voffB);
            PG8_BAR; PG8_WAIT_L(0); PG8_MMA(0, 1, At, B1); PG8_BAR;
            PG8_LDA(At, 0, 1); PG8_STAGE(PG8_SA(0, 0), a2, voffA);
            PG8_BAR; PG8_WAIT_L(0); PG8_MMA(1, 0, At, B0); PG8_BAR; PG8_SCHED;
            PG8_STAGE(PG8_SB(0, 1), b2 + hstep, voffB);
            PG8_WAIT_V(6); PG8_BAR; PG8_MMA(1, 1, At, B1); PG8_BAR;
            PG8_LDB(B0, 1, 0); PG8_SCHED; PG8_LDA(At, 1, 0); PG8_STAGE(PG8_SA(0, 1), a2 + hstep, voffA);
            PG8_WAIT_L(8); PG8_BAR; PG8_WAIT_L(0); PG8_MMA(0, 0, At, B0); PG8_BAR; PG8_SCHED;
            PG8_LDB(B1, 1, 1); PG8_STAGE(PG8_SB(1, 0), b3, voffB);
            PG8_BAR; PG8_WAIT_L(0); PG8_MMA(0, 1, At, B1); PG8_BAR;
            PG8_LDA(At, 1, 1); PG8_STAGE(PG8_SA(1, 0), a3, voffA);
            PG8_BAR; PG8_WAIT_L(0); PG8_MMA(1, 0, At, B0); PG8_BAR; PG8_SCHED;
            PG8_STAGE(PG8_SB(1, 1), b3 + hstep, voffB);
            PG8_WAIT_V(6); PG8_BAR; PG8_MMA(1, 1, At, B1); PG8_BAR;
            }
        }
        if constexpr (ALIGN_EPI) { if (wr == 0) PG8_BAR; }
        if constexpr (!Epi::AFTER_DRAIN) { E(acc, cur, wr, wc, fr, fq); S.done(cur); }
        if (!has_next) break;
#pragma unroll
        for (int a = 0; a < 2; ++a)
#pragma unroll
            for (int b = 0; b < 2; ++b)
#pragma unroll
                for (int m = 0; m < 4; ++m)
#pragma unroll
                    for (int n = 0; n < 2; ++n) acc[a][b][m][n] = (f32x4){0.f, 0.f, 0.f, 0.f};
        cur = nxt; cA = nA; cB = nB; ++ui;
        if constexpr (ALIGN_EPI) { if (wr == 1) PG8_BAR; }
    }
    PG8_WAIT_V(0);
    if constexpr (!ALIGN_EPI) { if (wr == 0) PG8_BAR; }
    PG8_BAR;
    if constexpr (Epi::AFTER_DRAIN) { E.fused(acc, cur, wr, wc, fr, fq, lds, wid, lane); S.done(cur); }
#undef PG8_SA
#undef PG8_SB
#undef PG8_STAGE
#undef PG8_LDA
#undef PG8_LDB
#undef PG8_MMA
#undef PG8_WAIT_V
#undef PG8_WAIT_L
#undef PG8_BAR
#undef PG8_SCHED
}
}

constexpr int DM = 1024, SEQ = 8192, NBP = 2, MP = NBP * SEQ, NS = 32;
constexpr int MROWS = 16640, MVALID = MP + NS;
constexpr int DFF = 2816, NFFIN = 2 * DFF;
constexpr int NHEAD = 16, HDIM = 64, KVW = 256, IQW = 512, IDIM = 64, IHEADS = 8, TOPK = 256;
constexpr int ATT_COLS = 2120, ATT_NP = 2304;
constexpr int MODW = 9 * DM, NBATCH = 34;
constexpr int NPG = 64, PAGE = 128, NPOOL = 2560;
constexpr float RMS_EPS = 1e-6f;
constexpr float QSCALE = 0.125f * 1.4426950408889634f;
constexpr float WISCALE = 0.35355339059327373f * 0.125f;
constexpr size_t O_YP = 0, O_YS = 16777216, O_KP = 16809984, O_VP = 25198592, O_KIP = 33587200, O_CVP = 35684352,
                 O_KS = 35692544, O_VS = 35708928, O_KIS = 35725312, O_CVS = 35729408, O_END = 35860480;
constexpr size_t MiB = 1u << 20;
constexpr size_t WS_CTL = 0, CTL_ZERO_BYTES = 1 * MiB;
constexpr size_t WS_MOD = 1 * MiB;
constexpr size_t WS_WFI = 8 * MiB;
constexpr size_t WS_WFO = 96 * MiB;
constexpr size_t WS_WAI = 140 * MiB;
constexpr size_t WS_WAO = 150 * MiB;
constexpr size_t WS_WCU = 154 * MiB;
constexpr size_t WS_WCB = 162 * MiB;
constexpr size_t WS_WCO = 166 * MiB;
constexpr size_t WS_X = 176 * MiB;
constexpr size_t WS_H = 242 * MiB;
constexpr size_t WS_U = 276 * MiB;
constexpr size_t WS_Q = 366 * MiB;
constexpr size_t WS_K = 399 * MiB;
constexpr size_t WS_V = 408 * MiB;
constexpr size_t WS_QI = 417 * MiB;
constexpr size_t WS_KI = 434 * MiB;
constexpr size_t WS_WI = 437 * MiB;
constexpr size_t WS_O = 438 * MiB;
constexpr size_t WS_Z = 471 * MiB;
constexpr size_t WS_IDX = 504 * MiB;
constexpr size_t WS_NSEL = 512 * MiB;
constexpr size_t WS_XS = 513 * MiB;
constexpr size_t XS_STRIDE = (size_t)MP * 4 + 32 * 64;
constexpr size_t WS_END = 517 * MiB;
static_assert(WS_MOD + (size_t)4 * 34 * 9216 * 4 <= WS_WFI && WS_WFI + (size_t)8 * 5632 * 1024 * 2 <= WS_WFO && WS_WFO + (size_t)8 * 1024 * 2816 * 2 <= WS_WAI &&
              WS_WAI + (size_t)2 * 2304 * 1024 * 2 <= WS_WAO && WS_X + (size_t)MROWS * DM * 4 <= WS_H && WS_H + (size_t)MROWS * DM * 2 <= WS_U &&
              WS_U + (size_t)MROWS * DFF * 2 <= WS_Q && WS_Q + (size_t)MROWS * DM * 2 <= WS_K && WS_K + (size_t)MROWS * KVW * 2 <= WS_V && WS_V + (size_t)MROWS * KVW * 2 <= WS_QI &&
              WS_QI + (size_t)MROWS * IQW * 2 <= WS_KI && WS_KI + (size_t)MROWS * IDIM * 2 <= WS_WI && WS_WI + (size_t)MROWS * 8 * 4 <= WS_O && WS_O + (size_t)MROWS * DM * 2 <= WS_Z &&
              WS_Z + (size_t)MROWS * DM * 2 <= WS_IDX && WS_IDX + (size_t)MP * TOPK * 2 <= WS_NSEL && WS_NSEL + (size_t)MP * 4 <= WS_XS && WS_XS + 12 * XS_STRIDE * 4 <= WS_END, "d_ws map");
constexpr int CW_TMO = 0, CW_BAR = 4096, CW_Q = 8192, CW_PC = 16384;
constexpr int RING_OFF = 0, RING_BYTES = 131072;
constexpr int LDSCTL_OFF = RING_BYTES, MISC_OFF = LDSCTL_OFF + 320;
constexpr int LDS_BYTES = 147456;
constexpr int NWAVES = 8;

#define GAS __attribute__((address_space(1)))
#define LAS __attribute__((address_space(3)))
typedef unsigned short bf16;
typedef unsigned v4u __attribute__((ext_vector_type(4)));
typedef unsigned v2u __attribute__((ext_vector_type(2)));
typedef float f32x4 __attribute__((ext_vector_type(4)));
typedef float f32x2 __attribute__((ext_vector_type(2)));
typedef float f32x16 __attribute__((ext_vector_type(16)));
typedef short bf16x8 __attribute__((ext_vector_type(8)));
typedef GAS unsigned gu32;
#define LDS_WAIT() asm volatile("s_waitcnt lgkmcnt(0)" ::: "memory")
#define VM_WAIT() asm volatile("s_waitcnt vmcnt(0)" ::: "memory")
__device__ __forceinline__ unsigned pk2(float lo, float hi) { return pg8::cvt_pk_bf16(lo, hi); }
__device__ __forceinline__ float bflo(unsigned u) { return __uint_as_float(u << 16); }
__device__ __forceinline__ float bfhi(unsigned u) { return __uint_as_float(u & 0xffff0000u); }
__device__ __forceinline__ float silu1(float a) { return a * __builtin_amdgcn_rcpf(1.f + __builtin_amdgcn_exp2f(-1.4426950408889634f * a)); }
__device__ __forceinline__ int batch_of(int row) { const int b = row < MP ? (row >> 13) : (2 + row - MP); return b > 33 ? 33 : b; }
__device__ __forceinline__ float wave_sum(float v) {
#pragma unroll
    for (int o = 1; o < 64; o <<= 1) v += __shfl_xor(v, o);
    return v;
}
__device__ __forceinline__ float wave_max(float v) {
#pragma unroll
    for (int o = 1; o < 64; o <<= 1) v = fmaxf(v, __shfl_xor(v, o));
    return v;
}
#define XB_TMO      128
#define XB_XCNT(j)  (256  + 64 * (j))
#define XB_XSUB(j)  (1280 + 64 * (j))
#define XB_XGEN(j)  (2304 + 64 * (j))
#define XB_TOP      3328
#define XB_TOPGEN   3392
#define XCD_BAR_WORDS 3456
#define XB_SPIN_CAP (1u << 18)

__device__ __forceinline__ unsigned xb_ld(unsigned* p)              { return __hip_atomic_load(p, __ATOMIC_RELAXED, __HIP_MEMORY_SCOPE_AGENT); }
__device__ __forceinline__ unsigned xb_add(unsigned* p, unsigned v) { return __hip_atomic_fetch_add(p, v, __ATOMIC_RELAXED, __HIP_MEMORY_SCOPE_AGENT); }
__device__ __forceinline__ unsigned xb_xcc_id() { return (unsigned)__builtin_amdgcn_s_getreg((3 << 11) | 20) & 0xFu; }
#define XB_SPIN(cond, bar) do { unsigned _sp = 0; while (cond) { __builtin_amdgcn_s_sleep(1); \
    if ((++_sp & 255u) == 0u) { if (xb_ld(&(bar)[XB_TMO])) break; if (_sp > XB_SPIN_CAP) { atomicAdd(&(bar)[XB_TMO], 1u); break; } } } } while (0)

struct XcdBarrier {
    unsigned* bar; unsigned x;
    volatile LAS unsigned* st;
};

__device__ __forceinline__ XcdBarrier xcd_barrier_post(unsigned* bar, volatile LAS unsigned* st) {
    XcdBarrier b; b.bar = bar; b.x = xb_xcc_id(); b.st = st;
    if (threadIdx.x == 0) (void)xb_add(&bar[XB_XCNT(b.x)], 1u);
    return b;
}
__device__ __forceinline__ void xcd_barrier_complete(unsigned* bar, unsigned x, unsigned& nloc, unsigned& nx) {
    const unsigned G = gridDim.x * gridDim.y * gridDim.z;
    unsigned sum, cnt, mine, sp = 0u;
    for (;;) {
        sum = 0u; cnt = 0u; mine = 0u;
#pragma unroll
        for (unsigned j = 0; j < 16; ++j) { const unsigned c = xb_ld(&bar[XB_XCNT(j)]); sum += c; cnt += (c > 0u) ? 1u : 0u; mine = (j == x) ? c : mine; }
        if (sum == G) break;
        __builtin_amdgcn_s_sleep(1);
        if ((++sp & 255u) == 0u) { if (xb_ld(&bar[XB_TMO])) break; if (sp > XB_SPIN_CAP) { atomicAdd(&bar[XB_TMO], 1u); break; } }
    }
    nloc = mine > 0u ? mine : 1u; nx = cnt > 0u ? cnt : 1u;
}

__device__ __forceinline__ void xcd_barrier(const XcdBarrier& b) {
    asm volatile("s_waitcnt vmcnt(0)" ::: "memory");
    __syncthreads();
    if (threadIdx.x == 0) {
        unsigned* bar = b.bar;
        __builtin_amdgcn_s_waitcnt(0);
        unsigned nloc = b.st[0], nx = b.st[1];
        if (nloc == 0u) { xcd_barrier_complete(bar, b.x, nloc, nx); b.st[0] = nloc; b.st[1] = nx; }
        const unsigned old = xb_add(&bar[XB_XSUB(b.x)], 1u);
        const unsigned gen = old / nloc;
        if (old + 1u == (gen + 1u) * nloc) {
            __builtin_amdgcn_fence(__ATOMIC_RELEASE, "agent");
            asm volatile("s_waitcnt vmcnt(0)" ::: "memory");
            const unsigned og = xb_add(&bar[XB_TOP], 1u);
            const unsigned tg = og / nx;
            if (og + 1u == (tg + 1u) * nx) xb_add(&bar[XB_TOPGEN], 1u);
            else XB_SPIN(xb_ld(&bar[XB_TOPGEN]) == tg, bar);
            __builtin_amdgcn_fence(__ATOMIC_ACQUIRE, "agent");
            xb_add(&bar[XB_XGEN(b.x)], 1u);
            asm volatile("s_waitcnt vmcnt(0)" ::: "memory");
        } else {
            XB_SPIN(xb_ld(&bar[XB_XGEN(b.x)]) == gen, bar);
            __builtin_amdgcn_fence(__ATOMIC_ACQUIRE, "agent");
            asm volatile("s_waitcnt vmcnt(0)" ::: "memory");
        }
    }
    __syncthreads();
}

using pg8::Unit;
typedef _Float16 h2e __attribute__((ext_vector_type(2)));
__device__ __forceinline__ unsigned pkh2(float a, float b) { const h2e t = __builtin_convertvector((f32x2){a, b}, h2e); return __builtin_bit_cast(unsigned, t); }

struct EpiSwiglu {
    static constexpr bool PERM = true, AFTER_DRAIN = false;
    bf16* U;
    __device__ __forceinline__ void operator()(const f32x4 (&acc)[2][2][4][2], const Unit& u, int wr, int wc, int fr, int fq) const {
        const int row0 = u.pm * 256 + wr * 64 + fr, col0 = u.pn * 128 + wc * 32 + 8 * fq;
#pragma unroll
        for (int ai = 0; ai < 2; ++ai)
#pragma unroll
            for (int m = 0; m < 4; ++m) {
                const f32x4 a0 = acc[ai][0][m][0], a1 = acc[ai][0][m][1], g0 = acc[ai][1][m][0], g1 = acc[ai][1][m][1];
                v4u w;
                w.x = pk2(silu1(a0[0]) * g0[0], silu1(a0[1]) * g0[1]); w.y = pk2(silu1(a0[2]) * g0[2], silu1(a0[3]) * g0[3]);
                w.z = pk2(silu1(a1[0]) * g1[0], silu1(a1[1]) * g1[1]); w.w = pk2(silu1(a1[2]) * g1[2], silu1(a1[3]) * g1[3]);
                *(v4u*)(U + (size_t)(row0 + ai * 128 + m * 16) * DFF + col0) = w;
            }
    }
};

struct EpiResid {
    static constexpr bool PERM = false, AFTER_DRAIN = false;
    float* X; const float* gate; float* outp; int flags;
    __device__ __forceinline__ void operator()(const f32x4 (&acc)[2][2][4][2], const Unit& u, int wr, int wc, int fr, int fq) const {
        const int row0 = u.pm * 256 + wr * 64 + fr, colb = u.pn * 256 + wc * 32 + 4 * fq;
        const float coef = (flags & 1) ? 0.5f : 1.0f; const bool mirror = (flags & 2) != 0;
#pragma unroll
        for (int ai = 0; ai < 2; ++ai)
#pragma unroll
            for (int m = 0; m < 4; ++m) {
                const int row = row0 + ai * 128 + m * 16; const int b = batch_of(row);
                const float* gp = gate + (size_t)b * MODW + colb; float* xp = X + (size_t)row * DM + colb;
#pragma unroll
                for (int bj = 0; bj < 2; ++bj)
#pragma unroll
                    for (int n = 0; n < 2; ++n) { const int off = bj * 128 + n * 16;
                        const f32x4 g = *(const f32x4*)(gp + off); f32x4 x = *(const f32x4*)(xp + off);
                        x = x + (g * coef) * acc[ai][bj][m][n]; *(f32x4*)(xp + off) = x;
                        if (mirror && row < MVALID) *(f32x4*)(outp + (size_t)row * DM + colb + off) = x; }
            }
    }
};

struct EpiResidMod {
    static constexpr bool PERM = false, AFTER_DRAIN = true;
    float* X; const float* gate; float* outp; int flags;
    float* xbuf; unsigned* cnt; bf16* H; const float* modn;
    __device__ __forceinline__ void fused(f32x4 (&acc)[2][2][4][2], const Unit& u, int wr, int wc, int fr, int fq, LAS unsigned char* lds, int wid, int lane) const {
        asm volatile("" : "+v"(fr), "+v"(fq));
        const int row0 = u.pm * 256 + wr * 64 + fr, colb = u.pn * 256 + wc * 32 + 4 * fq;
        const float coef = (flags & 1) ? 0.5f : 1.0f; const bool mirror = (flags & 2) != 0;
        const int b = u.pm >> 5;
        const float* gp = gate + (size_t)b * MODW + colb;
        f32x4 gv[2][2];
#pragma unroll
        for (int bj = 0; bj < 2; ++bj)
#pragma unroll
            for (int n = 0; n < 2; ++n) gv[bj][n] = *(const f32x4*)(gp + bj * 128 + n * 16);
#pragma unroll
        for (int ai = 0; ai < 2; ++ai) {
            float* xp = X + (size_t)(row0 + ai * 128) * DM + colb;
            f32x4 xv[4][2][2];
#pragma unroll
            for (int m = 0; m < 4; ++m)
#pragma unroll
                for (int bj = 0; bj < 2; ++bj)
#pragma unroll
                    for (int n = 0; n < 2; ++n) xv[m][bj][n] = *(const f32x4*)(xp + (size_t)m * 16 * DM + bj * 128 + n * 16);
            asm volatile("" ::: "memory");
            if (ai == 0) {
#pragma unroll
                for (int bj = 0; bj < 2; ++bj)
#pragma unroll
                    for (int n = 0; n < 2; ++n) gv[bj][n] = gv[bj][n] * coef; }
#pragma unroll
            for (int m = 0; m < 4; ++m)
#pragma unroll
                for (int bj = 0; bj < 2; ++bj)
#pragma unroll
                    for (int n = 0; n < 2; ++n) { const f32x4 x = xv[m][bj][n] + gv[bj][n] * acc[ai][bj][m][n]; acc[ai][bj][m][n] = x; *(f32x4*)(xp + (size_t)m * 16 * DM + bj * 128 + n * 16) = x; }
            if (mirror) { float* op = outp + (size_t)(row0 + ai * 128) * DM + colb;
#pragma unroll
                for (int m = 0; m < 4; ++m)
#pragma unroll
                    for (int bj = 0; bj < 2; ++bj)
#pragma unroll
                        for (int n = 0; n < 2; ++n) *(f32x4*)(op + (size_t)m * 16 * DM + bj * 128 + n * 16) = acc[ai][bj][m][n]; }
        }
        if (!(flags & 4)) return;
        const float* mb = modn + (size_t)b * MODW + colb;
        f32x4 shv[2][2], scv[2][2];
#pragma unroll
        for (int bj = 0; bj < 2; ++bj)
#pragma unroll
            for (int n = 0; n < 2; ++n) { shv[bj][n] = *(const f32x4*)(mb + bj * 128 + n * 16); scv[bj][n] = *(const f32x4*)(mb + DM + bj * 128 + n * 16); }
        LAS float* P = (LAS float*)lds;
        LAS float* S = (LAS float*)(lds + 8192);
        LAS unsigned* flag = (LAS unsigned*)(lds + 8192 + 2048);
#pragma unroll
        for (int ai = 0; ai < 2; ++ai)
#pragma unroll
            for (int m = 0; m < 4; ++m) { float s = 0.f;
#pragma unroll
                for (int bj = 0; bj < 2; ++bj)
#pragma unroll
                    for (int n = 0; n < 2; ++n) { const f32x4 x = acc[ai][bj][m][n]; s += (x[0] * x[0] + x[1] * x[1]) + (x[2] * x[2] + x[3] * x[3]); }
                s += __shfl_xor(s, 16); s += __shfl_xor(s, 32);
                if (fq == 0) P[(ai * 128 + wr * 64 + m * 16 + fr) * 4 + wc] = s; }
        asm volatile("s_waitcnt lgkmcnt(0)" ::: "memory"); __builtin_amdgcn_s_barrier(); asm volatile("" ::: "memory");
        const int prow = wid * 32 + (lane & 31);
        if (lane < 32) { const f32x4 p4 = *(const LAS f32x4*)(P + prow * 4); const float t = (p4[0] + p4[1]) + (p4[2] + p4[3]);
            __hip_atomic_store((unsigned*)xbuf + ((size_t)(u.pm * 256 + prow) * 4 + u.pn), __float_as_uint(t), __ATOMIC_RELAXED, __HIP_MEMORY_SCOPE_AGENT); }
        asm volatile("s_waitcnt vmcnt(0)" ::: "memory");
        if (lane == 0) __hip_atomic_fetch_add(cnt + 64 * u.pm, 1u, __ATOMIC_RELAXED, __HIP_MEMORY_SCOPE_AGENT);
        if (wid == 0) {
            unsigned sp = 0;
            while ((unsigned)__builtin_amdgcn_readfirstlane(__hip_atomic_load(cnt + 64 * u.pm, __ATOMIC_RELAXED, __HIP_MEMORY_SCOPE_AGENT)) < 32u) { __builtin_amdgcn_s_sleep(2); if (++sp > (1u << 20)) break; }
            __builtin_amdgcn_fence(__ATOMIC_ACQUIRE, "agent");
            if (lane == 0) flag[0] = 1u;
        }
        asm volatile("s_waitcnt vmcnt(0) lgkmcnt(0)" ::: "memory"); __builtin_amdgcn_s_barrier(); asm volatile("" ::: "memory");
        if (lane < 32) { const unsigned* sl = (const unsigned*)xbuf + (size_t)(u.pm * 256 + prow) * 4; f32x4 q4;
            asm volatile("global_load_dwordx4 %0, %1, off sc1\n\ts_waitcnt vmcnt(0)" : "=v"(q4) : "v"(sl) : "memory");
            const float q = (q4[0] + q4[1]) + (q4[2] + q4[3]);
            S[prow] = __builtin_amdgcn_rsqf(q * (1.f / DM) + RMS_EPS); }
        asm volatile("s_waitcnt lgkmcnt(0)" ::: "memory"); __builtin_amdgcn_s_barrier(); asm volatile("" ::: "memory");
#pragma unroll
        for (int bj = 0; bj < 2; ++bj)
#pragma unroll
            for (int n = 0; n < 2; ++n) { const int off = bj * 128 + n * 16;
                const f32x4 sh = shv[bj][n], sc = scv[bj][n] + 1.f;
#pragma unroll
                for (int ai = 0; ai < 2; ++ai)
#pragma unroll
                    for (int m = 0; m < 4; ++m) { const int r = ai * 128 + wr * 64 + m * 16 + fr; const float rs = S[r];
                        const f32x4 h = acc[ai][bj][m][n] * rs * sc + sh; v2u o; o.x = pk2(h[0], h[1]); o.y = pk2(h[2], h[3]);
                        *(v2u*)(H + (size_t)(u.pm * 256 + r) * DM + colb + off) = o; } }
    }
};

struct EpiAttnIn {
    static constexpr bool PERM = true, AFTER_DRAIN = false;
    bf16 *Qb, *Kb, *Vb, *QIb, *KIb; float* WIb; const float *qg, *kg; float *okp, *ovp, *okip, *oks, *ovs, *okis;
    __device__ __forceinline__ void operator()(const f32x4 (&acc)[2][2][4][2], const Unit& u, int wr, int wc, int fr, int fq) const {
        const int tile = u.pn; const int row0 = u.pm * 256 + wr * 64 + fr;
        if (tile < 5) {
            const float* gain = tile < 4 ? qg : kg; const float post = tile < 4 ? QSCALE : 1.f;
            f32x4 gv[2][2];
#pragma unroll
            for (int bj = 0; bj < 2; ++bj)
#pragma unroll
                for (int n = 0; n < 2; ++n) gv[bj][n] = *(const f32x4*)(gain + 32 * bj + 8 * fq + 4 * n);
#pragma unroll
            for (int ai = 0; ai < 2; ++ai)
#pragma unroll
                for (int m = 0; m < 4; ++m) {
                    const int row = row0 + ai * 128 + m * 16; float ss = 0.f;
#pragma unroll
                    for (int bj = 0; bj < 2; ++bj)
#pragma unroll
                        for (int n = 0; n < 2; ++n) { const f32x4 v = acc[ai][bj][m][n]; ss += (v[0] * v[0] + v[1] * v[1]) + (v[2] * v[2] + v[3] * v[3]); }
                    ss += __shfl_xor(ss, 16); ss += __shfl_xor(ss, 32);
                    const float r = __builtin_amdgcn_rsqf(ss * (1.f / 64.f) + RMS_EPS);
#pragma unroll
                    for (int bj = 0; bj < 2; ++bj) {
                        const f32x4 v0 = acc[ai][bj][m][0] * r * gv[bj][0], v1 = acc[ai][bj][m][1] * r * gv[bj][1];
                        const int hc = 32 * bj + 8 * fq;
                        if (tile < 4) { v4u w; w.x = pk2(v0[0] * post, v0[1] * post); w.y = pk2(v0[2] * post, v0[3] * post); w.z = pk2(v1[0] * post, v1[1] * post); w.w = pk2(v1[2] * post, v1[3] * post);
                            *(v4u*)(Qb + (size_t)row * DM + (4 * tile + wc) * 64 + hc) = w; }
                        else { v4u w; w.x = pk2(v0[0], v0[1]); w.y = pk2(v0[2], v0[3]); w.z = pk2(v1[0], v1[1]); w.w = pk2(v1[2], v1[3]);
                            if (row < MP) *(v4u*)(Kb + ((size_t)((row >> 13) * 4 + wc) * SEQ + (row & (SEQ - 1))) * 64 + hc) = w;
                            float* o = row < MP ? okp + (size_t)row * KVW : (row < MVALID ? oks + (size_t)(row - MP) * KVW : nullptr);
                            if (o) { *(f32x4*)(o + wc * 64 + hc) = v0; *(f32x4*)(o + wc * 64 + hc + 4) = v1; } }
                    }
                }
        } else if (tile == 5) {
#pragma unroll
            for (int ai = 0; ai < 2; ++ai)
#pragma unroll
                for (int m = 0; m < 4; ++m) {
                    const int row = row0 + ai * 128 + m * 16;
                    float* o = row < MP ? ovp + (size_t)row * KVW : (row < MVALID ? ovs + (size_t)(row - MP) * KVW : nullptr);
#pragma unroll
                    for (int bj = 0; bj < 2; ++bj) { const f32x4 v0 = acc[ai][bj][m][0], v1 = acc[ai][bj][m][1]; const int hc = 32 * bj + 8 * fq;
                        v4u w; w.x = pkh2(v0[0], v0[1]); w.y = pkh2(v0[2], v0[3]); w.z = pkh2(v1[0], v1[1]); w.w = pkh2(v1[2], v1[3]);
                        if (row < MP) *(v4u*)(Vb + ((size_t)((row >> 13) * 4 + wc) * SEQ + (row & (SEQ - 1))) * 64 + hc) = w;
                        if (o) { *(f32x4*)(o + wc * 64 + hc) = v0; *(f32x4*)(o + wc * 64 + hc + 4) = v1; } }
                }
        } else if (tile < 8) {
#pragma unroll
            for (int ai = 0; ai < 2; ++ai)
#pragma unroll
                for (int m = 0; m < 4; ++m) {
                    const int row = row0 + ai * 128 + m * 16;
#pragma unroll
                    for (int bj = 0; bj < 2; ++bj) { const f32x4 v0 = acc[ai][bj][m][0], v1 = acc[ai][bj][m][1]; const int hc = 32 * bj + 8 * fq;
                        v4u w; w.x = pk2(v0[0], v0[1]); w.y = pk2(v0[2], v0[3]); w.z = pk2(v1[0], v1[1]); w.w = pk2(v1[2], v1[3]);
                        *(v4u*)(QIb + (size_t)row * IQW + (4 * (tile - 6) + wc) * 64 + hc) = w; }
                }
        } else {
#pragma unroll
            for (int ai = 0; ai < 2; ++ai)
#pragma unroll
                for (int m = 0; m < 4; ++m) {
                    const int row = row0 + ai * 128 + m * 16;
                    if (wc == 0) {
                        float* o = row < MP ? okip + (size_t)row * IDIM : (row < MVALID ? okis + (size_t)(row - MP) * IDIM : nullptr);
#pragma unroll
                        for (int bj = 0; bj < 2; ++bj) { const f32x4 v0 = acc[ai][bj][m][0], v1 = acc[ai][bj][m][1]; const int hc = 32 * bj + 8 * fq;
                            v4u w; w.x = pk2(v0[0], v0[1]); w.y = pk2(v0[2], v0[3]); w.z = pk2(v1[0], v1[1]); w.w = pk2(v1[2], v1[3]);
                            *(v4u*)(KIb + (size_t)row * IDIM + hc) = w;
                            if (o) { *(f32x4*)(o + hc) = v0; *(f32x4*)(o + hc + 4) = v1; } }
                    } else if (wc == 1 && fq == 0) {
                        *(f32x4*)(WIb + (size_t)row * 8) = acc[ai][0][m][0] * WISCALE; *(f32x4*)(WIb + (size_t)row * 8 + 4) = acc[ai][0][m][1] * WISCALE;
                    }
                }
        }
    }
};

struct EpiConvCU {
    static constexpr bool PERM = true, AFTER_DRAIN = false;
    bf16* Zb; float* ocvp; float* ocvs; const float* state;
    __device__ __forceinline__ void operator()(const f32x4 (&acc)[2][2][4][2], const Unit& u, int wr, int wc, int fr, int fq) const {
        const int row0 = u.pm * 256 + wr * 64 + fr, col0 = u.pn * 128 + wc * 32 + 8 * fq;
#pragma unroll
        for (int ai = 0; ai < 2; ++ai)
#pragma unroll
            for (int m = 0; m < 4; ++m) {
                const int row = row0 + ai * 128 + m * 16;
                const f32x4 z0 = acc[ai][0][m][0] * acc[ai][1][m][0], z1 = acc[ai][0][m][1] * acc[ai][1][m][1];
                v4u w; w.x = pk2(z0[0], z0[1]); w.y = pk2(z0[2], z0[3]); w.z = pk2(z1[0], z1[1]); w.w = pk2(z1[2], z1[3]);
                *(v4u*)(Zb + (size_t)row * DM + col0) = w;
                { const int t = row & (SEQ - 1);
                    if (t >= SEQ - 2) { float* o = ocvp + ((size_t)(row >> 13) * 2 + (t - (SEQ - 2))) * DM + col0; *(f32x4*)o = z0; *(f32x4*)(o + 4) = z1; } }
            }
    }
};

struct EpiConvB {
    static constexpr bool PERM = true, AFTER_DRAIN = false;
    const bf16* Zb; bf16* A2; const float* cw; const float* state;
    __device__ __forceinline__ void operator()(const f32x4 (&acc)[2][2][4][2], const Unit& u, int wr, int wc, int fr, int fq) const {
        const int row0 = u.pm * 256 + wr * 64 + fr;
#pragma unroll
        for (int bj = 0; bj < 2; ++bj) {
            const int col0 = u.pn * 256 + bj * 128 + wc * 32 + 8 * fq;
            f32x4 w0[2], w1[2], w2[2];
#pragma unroll
            for (int n = 0; n < 2; ++n) { w0[n] = *(const f32x4*)(cw + col0 + 4 * n); w1[n] = *(const f32x4*)(cw + DM + col0 + 4 * n); w2[n] = *(const f32x4*)(cw + 2 * DM + col0 + 4 * n); }
#pragma unroll
            for (int am = 0; am < 4; ++am) { const int ai = am >> 1, mb = (am & 1) * 2;
                v4u zt[2], q1[2], q2[2];
#pragma unroll
                for (int mm = 0; mm < 2; ++mm) { const int row = row0 + ai * 128 + (mb + mm) * 16, t = row & (SEQ - 1); const bf16* zp = Zb + (size_t)row * DM + col0;
                    zt[mm] = *(const v4u*)zp; q1[mm] = *(const v4u*)(zp - (t >= 1 ? DM : 0)); q2[mm] = *(const v4u*)(zp - (t >= 2 ? 2 * DM : 0)); }
                asm volatile("" ::: "memory");
#pragma unroll
                for (int mm = 0; mm < 2; ++mm) { const int m = mb + mm; const int row = row0 + ai * 128 + m * 16, t = row & (SEQ - 1);
                    const v4u z0 = (v4u){0u, 0u, 0u, 0u}; const v4u p1 = t >= 1 ? q1[mm] : z0, p2 = t >= 2 ? q2[mm] : z0, pt = zt[mm];
                    const f32x4 a1[2] = {(f32x4){bflo(p1.x), bfhi(p1.x), bflo(p1.y), bfhi(p1.y)}, (f32x4){bflo(p1.z), bfhi(p1.z), bflo(p1.w), bfhi(p1.w)}};
                    const f32x4 a2[2] = {(f32x4){bflo(p2.x), bfhi(p2.x), bflo(p2.y), bfhi(p2.y)}, (f32x4){bflo(p2.z), bfhi(p2.z), bflo(p2.w), bfhi(p2.w)}};
                    const f32x4 c0 = (f32x4){bflo(pt.x), bfhi(pt.x), bflo(pt.y), bfhi(pt.y)}, c1 = (f32x4){bflo(pt.z), bfhi(pt.z), bflo(pt.w), bfhi(pt.w)};
                    const f32x4 y0 = (w0[0] * a2[0] + w1[0] * a1[0] + w2[0] * c0) * acc[ai][bj][m][0], y1 = (w0[1] * a2[1] + w1[1] * a1[1] + w2[1] * c1) * acc[ai][bj][m][1];
                    v4u w; w.x = pk2(y0[0], y0[1]); w.y = pk2(y0[2], y0[3]); w.z = pk2(y1[0], y1[1]); w.w = pk2(y1[2], y1[3]);
                    *(v4u*)(A2 + (size_t)row * DM + col0) = w;
                }
            }
        }
    }
};

struct Args { const float* in[20]; float* out; unsigned char* ws; int ph_lo, ph_hi; };
typedef __attribute__((address_space(4))) const unsigned char* kaptr_t;
struct PArgs {
    kaptr_t p;
    __device__ __forceinline__ const float* in(int i) const { return *(const float* const __attribute__((address_space(4)))*)(p + 8 * i); }
    __device__ __forceinline__ float* out() const { return *(float* const __attribute__((address_space(4)))*)(p + 160); }
    __device__ __forceinline__ unsigned char* ws() const { return *(unsigned char* const __attribute__((address_space(4)))*)(p + 168); }
};
static_assert(sizeof(Args) == 184, "kernarg layout");
__device__ __forceinline__ PArgs args_fresh() { kaptr_t p = (kaptr_t)__builtin_amdgcn_kernarg_segment_ptr(); asm volatile("" : "+s"(p)); PArgs a; a.p = p; return a; }
struct Frame {
    LAS unsigned char* lds; volatile LAS unsigned* MISC;
    int vcu, G;
};
struct Tid { int tid, lane, wave; };
__device__ __forceinline__ Tid tid_fresh() { int t = threadIdx.x; asm volatile("" : "+v"(t)); Tid r; r.tid = t; r.lane = t & 63; r.wave = __builtin_amdgcn_readfirstlane(t >> 6); return r; }
#define WSP(T, off) ((T*)(args.ws() + (off)))

__device__ __forceinline__ f32x4 silu4(f32x4 c) { f32x4 r; r[0] = c[0] / (1.f + __expf(-c[0])); r[1] = c[1] / (1.f + __expf(-c[1])); r[2] = c[2] / (1.f + __expf(-c[2])); r[3] = c[3] / (1.f + __expf(-c[3])); return r; }
__device__ __forceinline__ f32x4 silu4f(f32x4 c) { f32x4 r;
#pragma unroll
    for (int e = 0; e < 4; ++e) r[e] = c[e] * __builtin_amdgcn_rcpf(1.f + __builtin_amdgcn_exp2f(-1.4426950408889634f * c[e]));
    return r; }
__device__ __forceinline__ void ada_item16(const float* w_ada, const float* b_ada, const float* c_prompt, const float* c_sample, float* MOD, int item, int lane) {
    const int layer = item / 576, c0 = (item % 576) * 16; const int li = lane & 15, kk = lane >> 4;
    const float* W = w_ada + (size_t)layer * DM * MODW + c0 + li;
    f32x4 acc[2]; float pa[2] = {0.f, 0.f};
    acc[0] = acc[1] = (f32x4){0.f, 0.f, 0.f, 0.f};
#pragma unroll 4
    for (int k0 = 0; k0 < DM; k0 += 16) {
        float w[4]; f32x4 cs[2], cp[2];
#pragma unroll
        for (int st = 0; st < 4; ++st) w[st] = W[(size_t)(k0 + 4 * kk + st) * MODW];
#pragma unroll
        for (int rb = 0; rb < 2; ++rb) cs[rb] = silu4f(*(const f32x4*)(c_sample + (size_t)(16 * rb + li) * DM + k0 + 4 * kk));
#pragma unroll
        for (int b = 0; b < 2; ++b) cp[b] = silu4f(*(const f32x4*)(c_prompt + (size_t)b * DM + k0 + 4 * kk));
#pragma unroll
        for (int st = 0; st < 4; ++st) {
            acc[0] = __builtin_amdgcn_mfma_f32_16x16x4f32(cs[0][st], w[st], acc[0], 0, 0, 0);
            acc[1] = __builtin_amdgcn_mfma_f32_16x16x4f32(cs[1][st], w[st], acc[1], 0, 0, 0);
            pa[0] = fmaf(cp[0][st], w[st], pa[0]); pa[1] = fmaf(cp[1][st], w[st], pa[1]);
        }
    }
    const float bias = b_ada[(size_t)layer * MODW + c0 + li];
    float* Mo = MOD + (size_t)layer * NBATCH * MODW + c0 + li;
#pragma unroll
    for (int rb = 0; rb < 2; ++rb)
#pragma unroll
        for (int reg = 0; reg < 4; ++reg) Mo[(size_t)(2 + 16 * rb + 4 * kk + reg) * MODW] = acc[rb][reg] + bias;
#pragma unroll
    for (int b = 0; b < 2; ++b) { float v = pa[b]; v += __shfl_xor(v, 16); v += __shfl_xor(v, 32); if (kk == 0) Mo[(size_t)b * MODW] = v + bias; }
}
__device__ __forceinline__ void ada_item_wg(Frame& F, const float* w_ada, const float* b_ada, const float* c_prompt, const float* c_sample, float* MOD, int item, const Tid T) {
    const int lane = T.lane, wave = T.wave;
    const int layer = item / 576, c0 = (item % 576) * 16; const int li = lane & 15, kk = lane >> 4;
    const float* W = w_ada + (size_t)layer * DM * MODW + c0 + li;
    f32x4 acc[2]; float pa[2] = {0.f, 0.f};
    acc[0] = acc[1] = (f32x4){0.f, 0.f, 0.f, 0.f};
    const int kb = wave * 128;
    float w[8][4]; f32x4 cs[8][2], cp[8][2];
#pragma unroll
    for (int i = 0; i < 8; ++i) { const int k0 = kb + 16 * i;
#pragma unroll
        for (int st = 0; st < 4; ++st) w[i][st] = W[(size_t)(k0 + 4 * kk + st) * MODW];
#pragma unroll
        for (int rb = 0; rb < 2; ++rb) cs[i][rb] = *(const f32x4*)(c_sample + (size_t)(16 * rb + li) * DM + k0 + 4 * kk);
#pragma unroll
        for (int b = 0; b < 2; ++b) cp[i][b] = *(const f32x4*)(c_prompt + (size_t)b * DM + k0 + 4 * kk); }
    asm volatile("" ::: "memory");
#pragma unroll
    for (int i = 0; i < 8; ++i) { const f32x4 s0 = silu4f(cs[i][0]), s1 = silu4f(cs[i][1]), p0 = silu4f(cp[i][0]), p1 = silu4f(cp[i][1]);
#pragma unroll
        for (int st = 0; st < 4; ++st) {
            acc[0] = __builtin_amdgcn_mfma_f32_16x16x4f32(s0[st], w[i][st], acc[0], 0, 0, 0);
            acc[1] = __builtin_amdgcn_mfma_f32_16x16x4f32(s1[st], w[i][st], acc[1], 0, 0, 0);
            pa[0] = fmaf(p0[st], w[i][st], pa[0]); pa[1] = fmaf(p1[st], w[i][st], pa[1]);
        } }
    LAS float* red = (LAS float*)(F.lds + RING_OFF);
#pragma unroll
    for (int r = 0; r < 8; ++r) red[(wave * 10 + r) * 64 + lane] = acc[r >> 2][r & 3];
    red[(wave * 10 + 8) * 64 + lane] = pa[0]; red[(wave * 10 + 9) * 64 + lane] = pa[1];
    __syncthreads();
    const float bias = b_ada[(size_t)layer * MODW + c0 + li];
    float* Mo = MOD + (size_t)layer * NBATCH * MODW + c0 + li;
    { float s = 0.f;
#pragma unroll
      for (int ww = 0; ww < 8; ++ww) s += red[(ww * 10 + wave) * 64 + lane];
      Mo[(size_t)(2 + 16 * (wave >> 2) + 4 * kk + (wave & 3)) * MODW] = s + bias; }
    if (wave < 2) { float v = 0.f;
#pragma unroll
      for (int ww = 0; ww < 8; ++ww) v += red[(ww * 10 + 8 + wave) * 64 + lane];
      v += __shfl_xor(v, 16); v += __shfl_xor(v, 32); if (kk == 0) Mo[(size_t)wave * MODW] = v + bias; }
    __syncthreads();
}
__device__ __forceinline__ void titem_load(const float* W, int ldn, int nvalid, int sc0, int k0, int lane, f32x4 (&v)[8]) {
    const int rr = lane >> 3, c4 = 4 * (lane & 7); const bool ok = sc0 + c4 < nvalid;
    const float* src = W + (size_t)(k0 + rr) * ldn + sc0 + c4;
#pragma unroll
    for (int i = 0; i < 8; ++i) v[i] = ok ? *(const f32x4*)(src + (size_t)(8 * i) * ldn) : (f32x4){0.f, 0.f, 0.f, 0.f};
}
__device__ __forceinline__ void titem_store(const f32x4 (&v)[8], int K, bf16* WT, int n0, int k0, LAS float* scr, int lane) {
    const int rr = lane >> 3, c4 = 4 * (lane & 7);
#pragma unroll
    for (int i = 0; i < 8; ++i) { LAS float* d = scr + (8 * i + rr) * 33 + c4; d[0] = v[i][0]; d[1] = v[i][1]; d[2] = v[i][2]; d[3] = v[i][3]; }
    LDS_WAIT(); asm volatile("" ::: "memory");
    const int c = lane & 7;
#pragma unroll
    for (int j = 0; j < 4; ++j) { const int n = (lane >> 3) + 8 * j; const LAS float* s = scr + (8 * c) * 33 + n;
        v4u o; o.x = pk2(s[0 * 33], s[1 * 33]); o.y = pk2(s[2 * 33], s[3 * 33]); o.z = pk2(s[4 * 33], s[5 * 33]); o.w = pk2(s[6 * 33], s[7 * 33]);
        *(GAS v4u*)(WT + (size_t)(n0 + n) * K + k0 + 8 * c) = o; }
    LDS_WAIT(); asm volatile("" ::: "memory");
}
__device__ __forceinline__ int src_col_ffn(int nb) { const int p = 32 * nb, tile = p >> 8, w = p & 255; return w < 128 ? 128 * tile + w : DFF + 128 * tile + (w - 128); }
__device__ __forceinline__ int src_col_att(int nb) { const int p = 32 * nb, tile = p >> 8, w = p & 255; return 256 * tile + 64 * ((w >> 5) & 3) + 32 * (w >> 7); }
__device__ __forceinline__ int src_col_ccu(int nb) { const int p = 32 * nb, tile = p >> 8, w = p & 255; return w < 128 ? DM + 128 * tile + w : 2 * DM + 128 * tile + (w - 128); }

namespace wc {
constexpr int I_FI = 16 * 176, I_FO = 44 * 32, I_AI = 16 * 72, I_SQ = 16 * 32, I_CU = 16 * 64;
constexpr int OFF_FI = 0, OFF_FO = OFF_FI + 8 * I_FI, OFF_AI = OFF_FO + 8 * I_FO, OFF_AO = OFF_AI + 2 * I_AI, OFF_CU = OFF_AO + 2 * I_SQ, OFF_CB = OFF_CU + 2 * I_CU, OFF_CO = OFF_CB + 2 * I_SQ;
}
__device__ __forceinline__ void convert_set(Frame& F, int code, int w, int nw) {
    using namespace wc;
    const PArgs args = args_fresh(); const Tid T = tid_fresh();
    LAS float* scr = (LAS float*)(F.lds + RING_OFF + T.wave * 16384);
    int lo0, n0, lo1, n1, lo2 = 0, n2 = 0;
    if (code < 8) { lo0 = OFF_FI + code * I_FI; n0 = I_FI; lo1 = OFF_FO + code * I_FO; n1 = I_FO; }
    else if (code < 10) { const int li = code - 8; lo0 = OFF_AI + li * I_AI; n0 = I_AI; lo1 = OFF_AO + li * I_SQ; n1 = I_SQ; }
    else { const int li = code - 10; lo0 = OFF_CU + li * I_CU; n0 = I_CU; lo1 = OFF_CB + li * I_SQ; n1 = I_SQ; lo2 = OFF_CO + li * I_SQ; n2 = I_SQ; }
    const int ntot = n0 + n1 + n2;
    struct TD { const float* W; bf16* WT; int K, ldn, nvalid, n0, sc0, k0; };
    auto decode = [&](int v) __attribute__((always_inline)) -> TD {
        int r = v < n0 ? lo0 + v : (v < n0 + n1 ? lo1 + (v - n0) : lo2 + (v - n0 - n1)); TD t;
        if (r < 8 * I_FI) { const int s = r / I_FI, q = r % I_FI, nb = q % 176, kb = q / 176;
            t = TD{args.in(11) + (size_t)s * DM * NFFIN, WSP(bf16, WS_WFI) + (size_t)s * NFFIN * DM, DM, NFFIN, NFFIN, 32 * nb, src_col_ffn(nb), 64 * kb}; return t; } r -= 8 * I_FI;
        if (r < 8 * I_FO) { const int s = r / I_FO, q = r % I_FO, nb = q % 32, kb = q / 32;
            t = TD{args.in(12) + (size_t)s * DFF * DM, WSP(bf16, WS_WFO) + (size_t)s * DM * DFF, DFF, DM, DM, 32 * nb, 32 * nb, 64 * kb}; return t; } r -= 8 * I_FO;
        if (r < 2 * I_AI) { const int s = r / I_AI, q = r % I_AI, nb = q % 72, kb = q / 72;
            t = TD{args.in(13) + (size_t)s * DM * ATT_COLS, WSP(bf16, WS_WAI) + (size_t)s * ATT_NP * DM, DM, ATT_COLS, ATT_COLS, 32 * nb, src_col_att(nb), 64 * kb}; return t; } r -= 2 * I_AI;
        if (r < 2 * I_SQ) { const int s = r / I_SQ, q = r % I_SQ, nb = q % 32, kb = q / 32;
            t = TD{args.in(14) + (size_t)s * DM * DM, WSP(bf16, WS_WAO) + (size_t)s * DM * DM, DM, DM, DM, 32 * nb, 32 * nb, 64 * kb}; return t; } r -= 2 * I_SQ;
        if (r < 2 * I_CU) { const int s = r / I_CU, q = r % I_CU, nb = q % 64, kb = q / 64;
            t = TD{args.in(17) + (size_t)s * DM * 3 * DM, WSP(bf16, WS_WCU) + (size_t)s * 2 * DM * DM, DM, 3 * DM, 3 * DM, 32 * nb, src_col_ccu(nb), 64 * kb}; return t; } r -= 2 * I_CU;
        if (r < 2 * I_SQ) { const int s = r / I_SQ, q = r % I_SQ, nb = q % 32, kb = q / 32;
            t = TD{args.in(17) + (size_t)s * DM * 3 * DM, WSP(bf16, WS_WCB) + (size_t)s * DM * DM, DM, 3 * DM, 3 * DM, 32 * nb, 32 * nb, 64 * kb}; return t; } r -= 2 * I_SQ;
        { const int s = r / I_SQ, q = r % I_SQ, nb = q % 32, kb = q / 32;
            t = TD{args.in(19) + (size_t)s * DM * DM, WSP(bf16, WS_WCO) + (size_t)s * DM * DM, DM, DM, DM, 32 * nb, 32 * nb, 64 * kb}; return t; }
    };
    f32x4 va[8], vb[8], vc[8], vd[8];
    const int npair = (ntot + 1) >> 1;
#define CV_LOAD(P, X, Y) do { const TD t_ = decode(2 * (P)); titem_load(t_.W, t_.ldn, t_.nvalid, t_.sc0, t_.k0, T.lane, X); \
        if (2 * (P) + 1 < ntot) { const TD u_ = decode(2 * (P) + 1); titem_load(u_.W, u_.ldn, u_.nvalid, u_.sc0, u_.k0, T.lane, Y); } } while (0)
#define CV_STORE(P, X, Y) do { const TD t_ = decode(2 * (P)); titem_store(X, t_.K, t_.WT, t_.n0, t_.k0, scr, T.lane); \
        if (2 * (P) + 1 < ntot) { const TD u_ = decode(2 * (P) + 1); titem_store(Y, u_.K, u_.WT, u_.n0, u_.k0, scr, T.lane); } } while (0)
    if (w < npair) CV_LOAD(w, va, vb);
#pragma unroll 1
    for (int p = w; p < npair; p += 2 * nw) {
        const bool hb = p + nw < npair, hc = p + 2 * nw < npair;
        if (hb) CV_LOAD(p + nw, vc, vd);
        CV_STORE(p, va, vb);
        if (hc) CV_LOAD(p + 2 * nw, va, vb);
        if (hb) CV_STORE(p + nw, vc, vd);
    }
#undef CV_LOAD
#undef CV_STORE
}
__device__ __forceinline__ void convert_in_tail(Frame& F, int code, int first_idle) {
    if (code < 0 || (int)blockIdx.x < first_idle) return;
    const int wv = __builtin_amdgcn_readfirstlane((int)threadIdx.x >> 6);
    convert_set(F, code, ((int)blockIdx.x - first_idle) * NWAVES + wv, (F.G - first_idle) * NWAVES);
}

__device__ __forceinline__ void p0_prologue(Frame& F) {
    const PArgs args = args_fresh(); const Tid T = tid_fresh();
    const int gw = F.vcu * NWAVES + T.wave, NGW = F.G * NWAVES;
    if (gw < 2304) ada_item16(args.in(9), args.in(10), args.in(7), args.in(8), WSP(float, WS_MOD), gw, T.lane);
#pragma unroll 1
    for (int it = NGW + F.vcu; it < 2304; it += F.G) ada_item_wg(F, args.in(9), args.in(10), args.in(7), args.in(8), WSP(float, WS_MOD), it, tid_fresh());
#pragma unroll 1
    for (int k = 0; k < 2; ++k) { const int rot = k == 0 ? 0 : NGW - 64; convert_set(F, k == 0 ? 0 : 8, (gw + rot) % NGW, NGW); }
}

__device__ __forceinline__ void mod_phase(Frame& F, int layer, int which) {
    const PArgs args = args_fresh(); const Tid T = tid_fresh();
    const int gw = F.vcu * NWAVES + T.wave, NGW = F.G * NWAVES;
    float* X = WSP(float, WS_X); bf16* H = WSP(bf16, WS_H);
    const float* mod = WSP(float, WS_MOD) + (size_t)layer * NBATCH * MODW + which * 3 * DM;
    for (int m = gw; m < MROWS; m += NGW) {
        const float* mb = mod + (size_t)batch_of(m) * MODW + 4 * T.lane;
        f32x4 v[4]; float s = 0.f;
        const float* src = m < MP ? args.in(0) + (size_t)m * DM : (m < MVALID ? args.in(1) + (size_t)(m - MP) * DM : nullptr);
        f32x4 shv[4], scv[4];
#pragma unroll
        for (int j = 0; j < 4; ++j) { v[j] = src ? *(const f32x4*)(src + 4 * T.lane + 256 * j) : (f32x4){0.f, 0.f, 0.f, 0.f}; shv[j] = *(const f32x4*)(mb + 256 * j); scv[j] = *(const f32x4*)(mb + DM + 256 * j); }
        asm volatile("" ::: "memory");
#pragma unroll
        for (int j = 0; j < 4; ++j) { *(f32x4*)(X + (size_t)m * DM + 4 * T.lane + 256 * j) = v[j];
            s += (v[j][0] * v[j][0] + v[j][1] * v[j][1]) + (v[j][2] * v[j][2] + v[j][3] * v[j][3]); }
        const float rstd = __builtin_amdgcn_rsqf(wave_sum(s) * (1.f / DM) + RMS_EPS);
#pragma unroll
        for (int j = 0; j < 4; ++j) { const f32x4 sh = shv[j], sc = scv[j];
            const f32x4 h = v[j] * rstd * (sc + 1.f) + sh; v2u o; o.x = pk2(h[0], h[1]); o.y = pk2(h[2], h[3]);
            *(v2u*)(H + (size_t)m * DM + 4 * T.lane + 256 * j) = o; }
    }
}


namespace a1 {
constexpr int CAP = 768, NE = CAP / 64;
constexpr int KT = 128;
constexpr int LDS_KT = 0, LDS_BUF = 32768;
constexpr int LDS_CNT = LDS_BUF + 8 * 4 * CAP * 4;
typedef _Float16 h2 __attribute__((ext_vector_type(2)));
typedef _Float16 h8 __attribute__((ext_vector_type(8)));
typedef _Float16 h4 __attribute__((ext_vector_type(4)));
typedef float f32x8_t __attribute__((ext_vector_type(8)));
typedef short s16x4_t __attribute__((ext_vector_type(4)));
typedef short s16x8_t __attribute__((ext_vector_type(8)));
__device__ __forceinline__ unsigned pkh(float a, float b) { const h2 t = __builtin_convertvector((f32x2){a, b}, h2); return __builtin_bit_cast(unsigned, t); }
__device__ __forceinline__ int mbcnt64(unsigned long long m) { return (int)__builtin_amdgcn_mbcnt_hi((unsigned)(m >> 32), __builtin_amdgcn_mbcnt_lo((unsigned)m, 0u)); }

template <bool EXACT>
__device__ __forceinline__ unsigned compact(LAS unsigned* buf, int n, int lane, int& kept, LAS unsigned* dump) {
    unsigned e[NE]; unsigned mx = 0u, mn = 0xFFFFFFFFu;
#pragma unroll
    for (int j = 0; j < NE; ++j) { const int i = lane + 64 * j; const bool ok = i < n; e[j] = ok ? buf[i] : 0u; mx = max(mx, e[j]); mn = min(mn, ok ? e[j] : 0xFFFFFFFFu); }
#pragma unroll
    for (int o = 1; o < 64; o <<= 1) { mx = max(mx, (unsigned)__shfl_xor((int)mx, o)); mn = min(mn, (unsigned)__shfl_xor((int)mn, o)); }
    mx = __builtin_amdgcn_readfirstlane(mx); mn = __builtin_amdgcn_readfirstlane(mn);
    const int hb = 31 - __builtin_clz(mx ^ mn);
    const unsigned base = hb >= 31 ? 0u : (mx >> (hb + 1)) << (hb + 1);
    unsigned T = base; int cT = n; bool have = false;
    if (!EXACT) {
        const int ms = min(max(n, 0), 64) + min(max(n - 256, 0), 64) + min(max(n - 512, 0), 64);
        const int ks = max(1, (ms * 320) / n);
        unsigned Ts = base;
        for (int b = hb; b >= 0; --b) {
            const unsigned tr = Ts | (1u << b);
            const int c = __popcll(__ballot(e[0] >= tr)) + __popcll(__ballot(e[4] >= tr)) + __popcll(__ballot(e[8] >= tr));
            if (c >= ks) { Ts = tr; if (c == ks) break; }
        }
        int c = 0;
#pragma unroll
        for (int j = 0; j < NE; ++j) c += __popcll(__ballot(e[j] >= Ts));
        if (c >= TOPK) { T = Ts; cT = c; have = true; }
    }
    if (!have) {
        T = base; cT = n;
        for (int b = hb; b >= 0; --b) {
            const unsigned tr = T | (1u << b); int c = 0;
#pragma unroll
            for (int j = 0; j < NE; ++j) c += __popcll(__ballot(e[j] >= tr));
            if (c >= TOPK) { T = tr; cT = c; if (c == TOPK) break; }
        }
    }
    int bs = 0;
#pragma unroll
    for (int j = 0; j < NE; ++j) { const bool keep = e[j] >= T; const unsigned long long m = __ballot(keep); const int pos = bs + mbcnt64(m); LAS unsigned* d = keep ? buf + pos : dump; *d = e[j]; bs += __popcll(m); }
    kept = cT;
    return T;
}

__device__ __forceinline__ unsigned prune_given(LAS unsigned* buf, int n, int lane, int& kept, LAS unsigned* dump, unsigned Ts) {
    unsigned e[NE]; int c = 0;
#pragma unroll
    for (int j = 0; j < NE; ++j) { const int i = lane + 64 * j; e[j] = i < n ? buf[i] : 0u; }
#pragma unroll
    for (int j = 0; j < NE; ++j) c += __popcll(__ballot(e[j] >= Ts));
    if (c < TOPK || Ts == 0u) return compact<true>(buf, n, lane, kept, dump);
    int bs = 0;
#pragma unroll
    for (int j = 0; j < NE; ++j) { const bool keep = e[j] >= Ts; const unsigned long long m = __ballot(keep); const int pos = bs + mbcnt64(m); LAS unsigned* d = keep ? buf + pos : dump; *d = e[j]; bs += __popcll(m); }
    kept = c;
    return Ts;
}
constexpr int PRUNE_MIN = 448;
__device__ __forceinline__ void prune4(LAS unsigned* mybuf, int lane, int hi, int& cntA, int& cntB, unsigned& tauA, unsigned& tauB, LAS unsigned* dump) {
    int n[4]; n[0] = __builtin_amdgcn_readlane(cntA, 0); n[1] = __builtin_amdgcn_readlane(cntB, 0); n[2] = __builtin_amdgcn_readlane(cntA, 32); n[3] = __builtin_amdgcn_readlane(cntB, 32);
    unsigned s0[4], s1[4], s2[4], Ts[4]; int ks[4]; bool done[4];
#pragma unroll
    for (int q = 0; q < 4; ++q) { const bool act = n[q] > PRUNE_MIN; LAS unsigned* b = mybuf + q * CAP; const int nn = act ? n[q] : 0;
        s0[q] = lane < nn ? b[lane] : 0u; s1[q] = lane + 256 < nn ? b[lane + 256] : 0u; s2[q] = lane + 512 < nn ? b[lane + 512] : 0u;
        const int ms = min(nn, 64) + min(max(nn - 256, 0), 64) + min(max(nn - 512, 0), 64);
        ks[q] = act ? max(1, (ms * 320) / nn) : 0; Ts[q] = 0u; done[q] = !act; }
#pragma unroll 1
    for (int b = 31; b >= 13; --b) {
#pragma unroll
        for (int q = 0; q < 4; ++q) { const unsigned tr = Ts[q] | (1u << b);
            const int c = __popcll(__ballot(s0[q] >= tr)) + __popcll(__ballot(s1[q] >= tr)) + __popcll(__ballot(s2[q] >= tr));
            const bool take = !done[q] && c >= ks[q]; Ts[q] = take ? tr : Ts[q]; done[q] = done[q] || (take && c == ks[q]); }
        if (done[0] && done[1] && done[2] && done[3]) break;
    }
#pragma unroll
    for (int q = 0; q < 4; ++q) if (n[q] > PRUNE_MIN) { int kept; unsigned T = prune_given(mybuf + q * CAP, n[q], lane, kept, dump, Ts[q]);
        if (kept > CAP - 128) T = compact<true>(mybuf + q * CAP, kept, lane, kept, dump);
        if (hi == (q >> 1)) { if (q & 1) { cntB = kept; tauB = T; } else { cntA = kept; tauA = T; } } }
}

__device__ __forceinline__ void prompt_unit(Frame& F, int b, int blk) {
    const PArgs args = args_fresh(); const Tid TI = tid_fresh();
    LAS unsigned char* lds = F.lds;
    const int tid = TI.tid, lane = TI.lane, wave = TI.wave, r = lane & 31, hi = lane >> 5;
    const int q0 = blk * 32, qw = q0 + 4 * wave; const size_t rowbase = (size_t)b * SEQ;
    const bf16* QIb = WSP(bf16, WS_QI); const bf16* KIb = WSP(bf16, WS_KI); const float* WIb = WSP(float, WS_WI);
    const bf16* Qb = WSP(bf16, WS_Q); const bf16* Kb = WSP(bf16, WS_K); const bf16* Vb = WSP(bf16, WS_V); bf16* Ob = WSP(bf16, WS_O);
    bf16x8 qa[4];
    { const int ri = r & 3, rh = (r >> 2) & 1, rg = r >> 3, aq = 2 * rh + (rg >> 1), ah = 4 * (rg & 1) + ri;
      const bf16* p = QIb + (rowbase + qw + aq) * IQW + ah * 64 + 8 * hi;
#pragma unroll
      for (int s = 0; s < 4; ++s) qa[s] = *(const bf16x8*)(p + 16 * s); }
    float wA[8], wB[8];
    { const float* p = WIb + (rowbase + qw + 2 * hi) * 8; const f32x4 a0 = *(const f32x4*)p, a1 = *(const f32x4*)(p + 4), b0 = *(const f32x4*)(p + 8), b1 = *(const f32x4*)(p + 12);
#pragma unroll
      for (int i = 0; i < 4; ++i) { wA[i] = a0[i]; wA[4 + i] = a1[i]; wB[i] = b0[i]; wB[4 + i] = b1[i]; } }
    LAS unsigned* mybuf = (LAS unsigned*)(lds + LDS_BUF) + wave * 4 * CAP;
    LAS unsigned* bufA = mybuf + (2 * hi) * CAP; LAS unsigned* bufB = bufA + CAP;
    int cntA = 0, cntB = 0; unsigned tauA = 0u, tauB = 0u;
#ifndef PROBE_SC
#define PROBE_SC 1
#endif
#pragma unroll 1
    for (int rep_sc = 0; rep_sc < PROBE_SC; ++rep_sc) { cntA = 0; cntB = 0; tauA = 0u; tauB = 0u;
    const int qposA = qw + 2 * hi, qposB = qposA + 1;
    const int ntile = (q0 + 31) / KT + 1;
    const char* kbase = (const char*)(KIb + rowbase * IDIM);
    const int so0 = 16 * tid, so1 = so0 + 8192;
    const int sd0 = (so0 >> 7) * 128 + ((((so0 >> 4) & 7) ^ ((so0 >> 8) & 7)) << 4), sd1 = (so1 >> 7) * 128 + ((((so1 >> 4) & 7) ^ ((so1 >> 8) & 7)) << 4);
    auto compute_tile = [&](int t) __attribute__((always_inline)) {
        LAS unsigned char* kt = lds + LDS_KT + (t & 1) * 16384;
        LAS unsigned* flg = (LAS unsigned*)(lds + LDS_CNT + 128);
        const unsigned fl = flg[(t + 2) % 3];
        if (tid == 0) flg[(t + 1) % 3] = 0u;
        if (__builtin_amdgcn_readfirstlane(fl) != 0u) prune4(mybuf, lane, hi, cntA, cntB, tauA, tauB, (LAS unsigned*)(lds + LDS_CNT) + wave);
        if (t * KT > qw + 3) return;
        bf16x8 kf[4][4];
#pragma unroll
        for (int sub = 0; sub < 4; ++sub) { const int key = 32 * sub + r;
#pragma unroll
            for (int s = 0; s < 4; ++s) kf[sub][s] = *(const LAS bf16x8*)(kt + key * 128 + ((((2 * s + hi) ^ ((key >> 1) & 7))) << 4)); }
        f32x16 D[4];
#pragma unroll
        for (int sub = 0; sub < 4; ++sub) D[sub] = (f32x16){};
#pragma unroll
        for (int s = 0; s < 4; ++s)
#pragma unroll
            for (int sub = 0; sub < 4; ++sub) D[sub] = __builtin_amdgcn_mfma_f32_32x32x16_bf16(qa[s], kf[sub][s], D[sub], 0, 0, 0);
        unsigned uA[4], uB[4];
#pragma unroll
        for (int sub = 0; sub < 4; ++sub) {
            float sA = 0.f, sB = 0.f;
#pragma unroll
            for (int i = 0; i < 8; ++i) {
                const float ra = __int_as_float(max(__float_as_int(D[sub][i]), 0)), rb = __int_as_float(max(__float_as_int(D[sub][8 + i]), 0));
                sA = fmaf(wA[i], ra, sA); sB = fmaf(wB[i], rb, sB); }
            const int kidx = t * KT + 32 * sub + r; const unsigned ipart = (unsigned)(8191 - kidx);
            unsigned a = __float_as_uint(sA), b2 = __float_as_uint(sB);
            a ^= (unsigned)(((int)a >> 31) | (int)0x80000000); b2 ^= (unsigned)(((int)b2 >> 31) | (int)0x80000000);
            a = (a & 0xFFFFE000u) | ipart; b2 = (b2 & 0xFFFFE000u) | ipart;
            uA[sub] = kidx <= qposA ? a : 0u; uB[sub] = kidx <= qposB ? b2 : 0u;
        }
        LAS unsigned* dump = (LAS unsigned*)(lds + LDS_CNT) + wave;
#pragma unroll
        for (int sub = 0; sub < 4; ++sub) {
            const bool pA = uA[sub] > tauA, pB = uB[sub] > tauB;
            const unsigned long long mA = __builtin_amdgcn_ballot_w64(pA), mB = __builtin_amdgcn_ballot_w64(pB);
            const int loA = __popc((unsigned)mA), loB = __popc((unsigned)mB), hiA = __popc((unsigned)(mA >> 32)), hiB = __popc((unsigned)(mB >> 32));
            const int preA = mbcnt64(mA) - (hi ? loA : 0), preB = mbcnt64(mB) - (hi ? loB : 0);
            LAS unsigned* dA = pA ? bufA + cntA + preA : dump; LAS unsigned* dB = pB ? bufB + cntB + preB : dump;
            *dA = uA[sub]; *dB = uB[sub];
            cntA += hi ? hiA : loA; cntB += hi ? hiB : loB;
        }
        if (__builtin_amdgcn_ballot_w64(cntA > CAP - 128 || cntB > CAP - 128) != 0ull) { if (lane == 0) flg[t % 3] = 1u; }
    };
    v4u pa0, pa1, pb0, pb1;
    pa0 = *(const v4u*)(kbase + so0); pa1 = *(const v4u*)(kbase + so1);
    *(LAS v4u*)(lds + LDS_KT + sd0) = pa0; *(LAS v4u*)(lds + LDS_KT + sd1) = pa1;
    pb0 = pa0; pb1 = pa1;
    if (tid < 3) ((LAS unsigned*)(lds + LDS_CNT + 128))[tid] = 0u;
    if (ntile > 1) { pb0 = *(const v4u*)(kbase + 16384 + so0); pb1 = *(const v4u*)(kbase + 16384 + so1); }
    __syncthreads();
#pragma unroll 1
    for (int t = 0; t < ntile; t += 2) {
        if (t + 2 < ntile) { pa0 = *(const v4u*)(kbase + (size_t)(t + 2) * 16384 + so0); pa1 = *(const v4u*)(kbase + (size_t)(t + 2) * 16384 + so1); }
        compute_tile(t);
        if (t + 1 < ntile) { *(LAS v4u*)(lds + LDS_KT + 16384 + sd0) = pb0; *(LAS v4u*)(lds + LDS_KT + 16384 + sd1) = pb1; }
        __syncthreads();
        if (t + 1 < ntile) {
            if (t + 3 < ntile) { pb0 = *(const v4u*)(kbase + (size_t)(t + 3) * 16384 + so0); pb1 = *(const v4u*)(kbase + (size_t)(t + 3) * 16384 + so1); }
            compute_tile(t + 1);
            if (t + 2 < ntile) { *(LAS v4u*)(lds + LDS_KT + sd0) = pa0; *(LAS v4u*)(lds + LDS_KT + sd1) = pa1; }
            __syncthreads();
        }
    }
    }
    unsigned short* IDXg = WSP(unsigned short, WS_IDX); int* NSELg = WSP(int, WS_NSEL);
#pragma unroll
    for (int qq = 0; qq < 4; ++qq) { int n = __builtin_amdgcn_readlane((qq & 1) ? cntB : cntA, (qq >> 1) * 32);
        if (n > TOPK) { int kept; (void)compact<true>(mybuf + qq * CAP, n, lane, kept, (LAS unsigned*)(lds + LDS_CNT) + wave); n = TOPK; }
        const v4u e4 = *(const LAS v4u*)(mybuf + qq * CAP + 4 * lane);
        v2u o;
        { const unsigned i0 = 4 * lane < n ? 8191u - (e4.x & 8191u) : 0u, i1 = 4 * lane + 1 < n ? 8191u - (e4.y & 8191u) : 0u, i2 = 4 * lane + 2 < n ? 8191u - (e4.z & 8191u) : 0u, i3 = 4 * lane + 3 < n ? 8191u - (e4.w & 8191u) : 0u;
          o.x = i0 | (i1 << 16); o.y = i2 | (i3 << 16); }
        const size_t row = rowbase + qw + qq;
        *(v2u*)(IDXg + row * TOPK + 4 * lane) = o;
        if (lane == 0) NSELg[row] = n; }
    LDS_WAIT();
    __syncthreads();
}

__device__ __forceinline__ void attend_wave(Frame& F, int b, int g, int t0) {
    const PArgs args = args_fresh(); const Tid TI = tid_fresh();
    const int lane = TI.lane, wave = TI.wave;
    const bf16* Qb = WSP(bf16, WS_Q); const bf16* Kb = WSP(bf16, WS_K); const bf16* Vb = WSP(bf16, WS_V); bf16* Ob = WSP(bf16, WS_O);
    const unsigned short* IDXg = WSP(unsigned short, WS_IDX); const int* NSELg = WSP(int, WS_NSEL);
    LAS unsigned char* Ks = F.lds + wave * 16384;
    LAS unsigned char* Vs = Ks + 8192;
    const size_t rowbase = (size_t)b * SEQ;
    const bf16* Kg = Kb + (size_t)(b * 4 + g) * SEQ * 64; const bf16* Vg = Vb + (size_t)(b * 4 + g) * SEQ * 64;
#define AT_KIDX(K, H, G) ((int)((K[H][((G) & 7) >> 1] >> (16 * ((G) & 1))) & 0xffffu))
#define AT_GATHER(K, BASE, C, dst) do { _Pragma("unroll") for (int i_ = 0; i_ < 8; ++i_) dst[i_] = *(const v4u*)((const char*)(BASE) + (unsigned)(AT_KIDX(K, i_ & 1, 4 * (C) + (i_ >> 1)) * 128 + 16 * (c8 ^ ks))); } while (0)
    v4u kA[2], kB[2], nA[2], nB[2]; bf16x8 bq0 = {}, bq1 = {}, bqn0 = {}, bqn1 = {};
    v4u kr[2][8], vr[2][8];
    { const int j = lane & 15, fq = lane >> 4, ks = lane >> 3, c8 = lane & 7; const size_t row = rowbase + t0;
#pragma unroll
      for (int h = 0; h < 2; ++h) { kA[h] = *(const v4u*)(IDXg + row * TOPK + 16 * (8 * h + ks)); kB[h] = *(const v4u*)(IDXg + row * TOPK + 16 * (8 * h + ks) + 8); }
      if (j < 4) { const bf16* qp = Qb + row * DM + (4 * g + j) * 64 + 8 * fq; bq0 = *(const bf16x8*)qp; bq1 = *(const bf16x8*)(qp + 32); }
      AT_GATHER(kA, Kg, 0, kr[0]); AT_GATHER(kA, Kg, 1, kr[1]); }
#pragma unroll 1
    for (int qi = 0; qi < 32; ++qi) {
        int lq = lane; asm volatile("" : "+v"(lq));
        const int j = lq & 15, fq = lq >> 4, ks = lq >> 3, c8 = lq & 7;
        const size_t row = rowbase + t0 + qi; const int nsel = NSELg[row];
        const size_t rown = rowbase + t0 + min(qi + 1, 31);
        f32x4 lg[16];
#pragma unroll
        for (int C = 0; C < 4; ++C) {
#pragma unroll
            for (int i = 0; i < 8; ++i) *(LAS v4u*)(Ks + (8 * i + ks) * 128 + c8 * 16) = kr[C & 1][i];
            if (C + 2 < 4) AT_GATHER(kB, Kg, C + 2, kr[C & 1]);
            if (C == 2) AT_GATHER(kA, Vg, 0, vr[0]);
            if (C == 3) AT_GATHER(kA, Vg, 1, vr[1]);
#pragma unroll
            for (int gg = 0; gg < 4; ++gg) { const int G = 4 * C + gg; const int rr = 16 * gg + j;
                const bf16x8 a0 = *(const LAS bf16x8*)(Ks + rr * 128 + ((fq ^ (j & 7)) << 4)), a1 = *(const LAS bf16x8*)(Ks + rr * 128 + (((4 + fq) ^ (j & 7)) << 4));
                f32x4 acc = {0.f, 0.f, 0.f, 0.f};
                acc = __builtin_amdgcn_mfma_f32_16x16x32_bf16(a0, bq0, acc, 0, 0, 0);
                acc = __builtin_amdgcn_mfma_f32_16x16x32_bf16(a1, bq1, acc, 0, 0, 0);
                lg[G] = acc; }
        }
#pragma unroll
        for (int h = 0; h < 2; ++h) { nA[h] = *(const v4u*)(IDXg + rown * TOPK + 16 * (8 * h + ks)); nB[h] = *(const v4u*)(IDXg + rown * TOPK + 16 * (8 * h + ks) + 8); }
        if (j < 4) { const bf16* qp = Qb + rown * DM + (4 * g + j) * 64 + 8 * fq; bqn0 = *(const bf16x8*)qp; bqn1 = *(const bf16x8*)(qp + 32); }
        if (nsel < TOPK) {
#pragma unroll
            for (int G = 0; G < 16; ++G)
#pragma unroll
                for (int reg = 0; reg < 4; ++reg) if (16 * (4 * fq + reg) + G >= nsel) lg[G][reg] = -INFINITY;
        }
        float mx = -INFINITY, mx2 = -INFINITY;
#pragma unroll
        for (int G = 0; G < 16; ++G) { mx = fmaxf(fmaxf(mx, lg[G][0]), lg[G][1]); mx2 = fmaxf(fmaxf(mx2, lg[G][2]), lg[G][3]); }
        mx = fmaxf(mx, mx2);
        mx = fmaxf(mx, __shfl_xor(mx, 16)); mx = fmaxf(mx, __shfl_xor(mx, 32));
        h8 pb[8];
#pragma unroll
        for (int kk = 0; kk < 8; ++kk) { f32x8_t pv;
#pragma unroll
            for (int e = 0; e < 8; ++e) pv[e] = __builtin_amdgcn_exp2f(lg[2 * kk + (e >> 2)][e & 3] - mx);
            pb[kk] = __builtin_convertvector(pv, h8); }
        f32x4 osum = (f32x4){0.f, 0.f, 0.f, 0.f};
        { const _Float16 one = (_Float16)1.0f; h8 ones = {one, one, one, one, one, one, one, one}; asm volatile("" : "+v"(ones));
#pragma unroll
          for (int kk = 0; kk < 8; ++kk) osum = __builtin_amdgcn_mfma_f32_16x16x32_f16(ones, pb[kk], osum, 0, 0, 0); }
        f32x4 oacc[4];
#pragma unroll
        for (int db = 0; db < 4; ++db) oacc[db] = (f32x4){0.f, 0.f, 0.f, 0.f};
        const int tq_ = (lq >> 2) & 3, tp_ = lq & 3;
#pragma unroll
        for (int C = 0; C < 4; ++C) {
#pragma unroll
            for (int i = 0; i < 8; ++i) *(LAS v4u*)(Vs + (8 * i + ks) * 128 + c8 * 16) = vr[C & 1][i];
            if (C + 2 < 4) AT_GATHER(kB, Vg, C + 2, vr[C & 1]);
#pragma unroll
            for (int st = 0; st < 2; ++st) {
#pragma unroll
                for (int db = 0; db < 4; ++db) {
                    const int r0 = 16 * (2 * st) + 4 * fq + tq_, r1 = r0 + 16; const int ch = 2 * db + (tp_ >> 1);
                    const s16x4_t t0 = __builtin_amdgcn_ds_read_tr16_b64_v4i16((LAS s16x4_t*)(Vs + r0 * 128 + ((ch ^ (r0 & 7)) << 4) + 8 * (tp_ & 1)));
                    const s16x4_t t1 = __builtin_amdgcn_ds_read_tr16_b64_v4i16((LAS s16x4_t*)(Vs + r1 * 128 + ((ch ^ (r1 & 7)) << 4) + 8 * (tp_ & 1)));
                    const h8 va = __builtin_bit_cast(h8, (s16x8_t){t0[0], t0[1], t0[2], t0[3], t1[0], t1[1], t1[2], t1[3]});
                    oacc[db] = __builtin_amdgcn_mfma_f32_16x16x32_f16(va, pb[2 * C + st], oacc[db], 0, 0, 0);
                }
            }
            if (C == 0) { AT_GATHER(nA, Kg, 0, kr[0]); AT_GATHER(nA, Kg, 1, kr[1]); }
        }
        if (j < 4) { const float inv = 1.f / osum[0];
#pragma unroll
            for (int db = 0; db < 4; ++db) { v2u w; w.x = pk2(oacc[db][0] * inv, oacc[db][1] * inv); w.y = pk2(oacc[db][2] * inv, oacc[db][3] * inv);
                *(v2u*)(Ob + row * DM + (4 * g + j) * 64 + 16 * db + 4 * fq) = w; }
        }
        LDS_WAIT(); asm volatile("" ::: "memory");
#pragma unroll
        for (int h = 0; h < 2; ++h) { kA[h] = nA[h]; kB[h] = nB[h]; }
        bq0 = bqn0; bq1 = bqn1;
    }
#undef AT_GATHER
#undef AT_KIDX
}

__device__ __forceinline__ void sample_unit(Frame& F, int li, int s) {
    const PArgs args = args_fresh(); const Tid TI = tid_fresh();
    LAS unsigned char* lds = F.lds; const int tid = TI.tid, lane = TI.lane, wave = TI.wave;
    LAS float* qi = (LAS float*)lds;
    LAS float* qs = qi + 512;
    LAS int* sel = (LAS int*)(qs + 1024);
    LAS float* lg = (LAS float*)(sel + 256);
    LAS int* cnt3 = (LAS int*)(lg + 4096);
    LAS int* cw = cnt3 + 4;
    const int row = MP + s;
    const bf16* QIb = WSP(bf16, WS_QI); const bf16* Qb = WSP(bf16, WS_Q); const float* WIb = WSP(float, WS_WI); bf16* Ob = WSP(bf16, WS_O);
    const float* ckidx = args.in(4) + (size_t)li * NPOOL * PAGE * IDIM; const float* ck = args.in(2) + (size_t)li * NPOOL * PAGE * KVW; const float* cv = args.in(3) + (size_t)li * NPOOL * PAGE * KVW;
    const int* pt = (const int*)args.in(6) + s * NPG;
    const float* nk = args.out() + O_KS + ((size_t)li * NS + s) * KVW; const float* nv = args.out() + O_VS + ((size_t)li * NS + s) * KVW; const float* nki = args.out() + O_KIS + ((size_t)li * NS + s) * IDIM;
    { const bf16 v = QIb[(size_t)row * IQW + tid]; qi[tid] = __uint_as_float((unsigned)v << 16); }
    { const bf16 v0 = Qb[(size_t)row * DM + tid], v1 = Qb[(size_t)row * DM + 512 + tid]; qs[tid] = __uint_as_float((unsigned)v0 << 16); qs[512 + tid] = __uint_as_float((unsigned)v1 << 16); }
    if (tid < 4) cnt3[tid] = 0;
    float wv[8];
#pragma unroll
    for (int h = 0; h < 8; ++h) wv[h] = WIb[(size_t)row * 8 + h];
    __syncthreads();
    unsigned long long keys[17];
#pragma unroll
    for (int j = 0; j < 17; ++j) {
        const int kidx = tid + 512 * j;
        if (kidx <= SEQ) {
            const float* kp = kidx < SEQ ? ckidx + ((size_t)pt[kidx >> 7] * PAGE + (kidx & 127)) * IDIM : nki;
            float acc[8];
#pragma unroll
            for (int h = 0; h < 8; ++h) acc[h] = 0.f;
            f32x4 kv[16];
#pragma unroll
            for (int d = 0; d < 16; ++d) kv[d] = *(const f32x4*)(kp + 4 * d);
            asm volatile("" ::: "memory");
#pragma unroll
            for (int d = 0; d < 64; d += 4) { const f32x4 k4 = kv[d >> 2];
#pragma unroll
                for (int h = 0; h < 8; ++h) { const f32x4 q4 = *(const LAS f32x4*)(qi + h * 64 + d); acc[h] += (q4[0] * k4[0] + q4[1] * k4[1]) + (q4[2] * k4[2] + q4[3] * k4[3]); } }
            float sc = 0.f;
#pragma unroll
            for (int h = 0; h < 8; ++h) sc = fmaf(wv[h], fmaxf(acc[h], 0.f), sc);
            unsigned u = __float_as_uint(sc); u ^= (u >> 31) ? 0xFFFFFFFFu : 0x80000000u;
            keys[j] = ((unsigned long long)u << 32) | (unsigned long long)(0xFFFFFFFFu - (unsigned)kidx);
        } else keys[j] = 0ull;
    }
    unsigned long long T = 0ull;
#pragma unroll 1
    for (int step = 0; step < 46; ++step) {
        const int bit = step < 32 ? 63 - step : 45 - step;
        if (step == 32) T |= 0xFFFFC000ull;
        const unsigned long long tr = T | (1ull << bit); int c = 0;
#pragma unroll
        for (int j = 0; j < 17; ++j) c += __popcll(__ballot(keys[j] >= tr));
        if (lane == 0) atomicAdd((int*)&cnt3[step % 3], c);
        __syncthreads();
        if (cnt3[step % 3] >= TOPK) T = tr;
        if (tid == 0) cnt3[(step + 2) % 3] = 0;
    }
#pragma unroll
    for (int j = 0; j < 17; ++j) { const int c = __popcll(__ballot(keys[j] >= T)); if (lane == 0) cw[j * 8 + wave] = c; }
    __syncthreads();
    if (tid == 0) { int run = 0; for (int i = 0; i < 136; ++i) { const int c = cw[i]; cw[i] = run; run += c; } }
    __syncthreads();
#pragma unroll
    for (int j = 0; j < 17; ++j) { const bool keep = keys[j] >= T; const unsigned long long m = __ballot(keep); if (keep) { const int pos = cw[j * 8 + wave] + mbcnt64(m); if (pos < TOPK) sel[pos] = tid + 512 * j; } }
    __syncthreads();
    LAS int* phys = cw + 144;
    if (tid < TOPK) { const int idx = sel[tid]; phys[tid] = idx < SEQ ? pt[idx >> 7] * PAGE + (idx & 127) : -1; }
    __syncthreads();
#pragma unroll
    for (int ii = 0; ii < 2; ++ii) {
        const int it = tid + 512 * ii;
        const int n = it & 255, kvh = it >> 8; const int pr = phys[n];
        const float* kp = pr >= 0 ? ck + (size_t)pr * KVW + kvh * 64 : nk + kvh * 64;
        f32x4 k4[16];
#pragma unroll
        for (int d = 0; d < 16; ++d) k4[d] = *(const f32x4*)(kp + 4 * d);
        float acc[4] = {0.f, 0.f, 0.f, 0.f};
#pragma unroll
        for (int d = 0; d < 16; ++d) {
#pragma unroll
            for (int i = 0; i < 4; ++i) { const f32x4 q4 = *(const LAS f32x4*)(qs + (4 * kvh + i) * 64 + 4 * d); acc[i] += (q4[0] * k4[d][0] + q4[1] * k4[d][1]) + (q4[2] * k4[d][2] + q4[3] * k4[d][3]); } }
#pragma unroll
        for (int i = 0; i < 4; ++i) lg[(4 * kvh + i) * 256 + n] = acc[i];
    }
    __syncthreads();
#pragma unroll
    for (int hh = 0; hh < 2; ++hh) { LAS float* l = lg + (2 * wave + hh) * 256; float v[4]; float mx = -INFINITY;
#pragma unroll
        for (int i = 0; i < 4; ++i) { v[i] = l[lane + 64 * i]; mx = fmaxf(mx, v[i]); }
        mx = wave_max(mx); float sum = 0.f;
#pragma unroll
        for (int i = 0; i < 4; ++i) { v[i] = __builtin_amdgcn_exp2f(v[i] - mx); sum += v[i]; }
        sum = wave_sum(sum); const float inv = 1.f / sum;
#pragma unroll
        for (int i = 0; i < 4; ++i) l[lane + 64 * i] = v[i] * inv; }
    __syncthreads();
    { const int hd = tid >> 5, dp = tid & 31, kvh = hd >> 2; float o0 = 0.f, o1 = 0.f;
#pragma unroll 1
      for (int n0 = 0; n0 < TOPK; n0 += 16) {
          f32x2 v[16];
#pragma unroll
          for (int k = 0; k < 16; ++k) { const int pr = phys[n0 + k]; const float* vp = pr >= 0 ? cv + (size_t)pr * KVW + kvh * 64 : nv + kvh * 64; v[k] = *(const f32x2*)(vp + 2 * dp); }
#pragma unroll
          for (int k = 0; k < 16; ++k) { const float p = lg[hd * 256 + n0 + k]; o0 = fmaf(p, v[k][0], o0); o1 = fmaf(p, v[k][1], o1); } }
      *(unsigned*)(Ob + (size_t)row * DM + hd * 64 + 2 * dp) = pk2(o0, o1); }
    __syncthreads();
}
}

#ifndef MK_SINGLE
#define MK_SINGLE 1
#endif
#ifndef EN_MASK
#define EN_MASK 0xFFFF
#endif
#define EN(b) ((EN_MASK >> (b)) & 1)
constexpr int N_PHASES = 32;
template <int NB, int NSTEPS, class Fn>
__device__ __forceinline__ float small_item(Frame& F, const bf16* A, int K, const bf16* W0, const bf16* W1, Fn fn) {
    const Tid T = tid_fresh(); const int lane = T.lane, wave = T.wave;
    const int kper = K >> 3, kbeg = wave * kper; constexpr int nsteps = NSTEPS;
    const bf16* ap = A + (size_t)(lane & 15) * K + 8 * (lane >> 4) + kbeg;
    const bf16* wp0 = W0 + (size_t)(lane & 15) * K + 8 * (lane >> 4) + kbeg;
    const bf16* wp1 = (NB == 2 ? W1 : W0) + (size_t)(lane & 15) * K + 8 * (lane >> 4) + kbeg;
    f32x4 d[NB][2];
#pragma unroll
    for (int nb = 0; nb < NB; ++nb) { d[nb][0] = (f32x4){0.f, 0.f, 0.f, 0.f}; d[nb][1] = d[nb][0]; }
    bf16x8 av0[nsteps], av1[nsteps], wv0[nsteps], wv1[NB == 2 ? nsteps : 1];
#pragma unroll
    for (int s = 0; s < nsteps; ++s) { av0[s] = *(const bf16x8*)(ap + 32 * s); av1[s] = *(const bf16x8*)(ap + (size_t)16 * K + 32 * s); wv0[s] = *(const bf16x8*)(wp0 + 32 * s);
        if constexpr (NB == 2) wv1[s] = *(const bf16x8*)(wp1 + 32 * s); }
    asm volatile("" ::: "memory");
#pragma unroll
    for (int s = 0; s < nsteps; ++s) {
        d[0][0] = __builtin_amdgcn_mfma_f32_16x16x32_bf16(wv0[s], av0[s], d[0][0], 0, 0, 0); d[0][1] = __builtin_amdgcn_mfma_f32_16x16x32_bf16(wv0[s], av1[s], d[0][1], 0, 0, 0);
        if constexpr (NB == 2) { d[1][0] = __builtin_amdgcn_mfma_f32_16x16x32_bf16(wv1[s], av0[s], d[1][0], 0, 0, 0); d[1][1] = __builtin_amdgcn_mfma_f32_16x16x32_bf16(wv1[s], av1[s], d[1][1], 0, 0, 0); }
    }
    LAS float* red = (LAS float*)(F.lds + RING_OFF);
#pragma unroll
    for (int nb = 0; nb < NB; ++nb)
#pragma unroll
        for (int f = 0; f < 2; ++f)
#pragma unroll
            for (int r = 0; r < 4; ++r) red[((wave * NB + nb) * 8 + f * 4 + r) * 64 + lane] = d[nb][f][r];
    __syncthreads();
    { const int i = wave, f = i >> 2, r = i & 3; float v[NB];
#pragma unroll
      for (int nb = 0; nb < NB; ++nb) { float s = 0.f;
#pragma unroll
          for (int w = 0; w < 8; ++w) s += red[((w * NB + nb) * 8 + i) * 64 + lane];
          v[nb] = s; }
      const float ret = fn((lane & 15) + 16 * f, 4 * (lane >> 4) + r, v[0], v[NB - 1]);
      __syncthreads();
      return ret; }
}
template <class Epi>
__device__ __forceinline__ void run_gemm(Frame& F, const bf16* A, const bf16* Bt, int M, int N, int K, const Epi E) {
    pg8::Gemm g{A, Bt, M, N, K}; pg8::StaticOrder S; S.init(M, N, F.G, (int)blockIdx.x);
    pg8::gemm_phase<Epi, pg8::StaticOrder, true, true>(F.lds + RING_OFF, g, S, E);
}

__global__ void __launch_bounds__(NWAVES * 64, 2) mega_fwd(Args kargs) {
    extern __shared__ __attribute__((aligned(16))) unsigned char lds_raw[];
    Frame F;
    F.lds = (LAS unsigned char*)lds_raw;
    F.MISC = (volatile LAS unsigned*)(F.lds + MISC_OFF);
    F.G = gridDim.x; { const int bx = blockIdx.x; F.vcu = (F.G % 8 == 0) ? (bx % 8) * (F.G / 8) + bx / 8 : bx; }
    for (int u = threadIdx.x; u < (LDS_BYTES - LDSCTL_OFF) / 4; u += NWAVES * 64) ((LAS unsigned*)(F.lds + LDSCTL_OFF))[u] = 0u;
    __syncthreads();
    const int lo = kargs.ph_lo, hi = kargs.ph_hi;
    unsigned* const barw = (unsigned*)(kargs.ws + WS_CTL) + CW_BAR;
    XcdBarrier bar; bar.bar = barw; bar.x = 0; bar.st = nullptr;
    if (hi - lo > 1) bar = xcd_barrier_post(barw, F.MISC + 8);
    int ph = 0;
#define PH_ON() (ph >= lo && ph < hi)
#define PH_END() do { if (ph >= lo && ph + 1 < hi) xcd_barrier(bar); ++ph; } while (0)

#ifndef PROBE_P0
#define PROBE_P0 1
#endif
    if (EN(0) && PH_ON()) { for (int rep = 0; rep < PROBE_P0; ++rep) p0_prologue(F); }
    PH_END();

#pragma unroll 1
    for (int j = 0; j < 12; ++j) {
        const int layer = j / 3, kind = j - 3 * layer, li = layer >> 1; const bool is_attn = (layer & 1) == 0;
#ifndef PROBE_MOD
#define PROBE_MOD 1
#endif
        if (j == 0) { if (EN(1) && PH_ON()) mod_phase(F, layer, kind); PH_END(); }
        if (kind != 1) {
            if (EN(2) && PH_ON()) { const PArgs args = args_fresh(); const int sff = 2 * layer + (kind >> 1);
                EpiSwiglu E{WSP(bf16, WS_U)};
#ifndef PROBE_FI
#define PROBE_FI 1
#endif
#pragma unroll 1
                for (int rep = 0; rep < PROBE_FI; ++rep) run_gemm(F, WSP(bf16, WS_H), WSP(bf16, WS_WFI) + (size_t)sff * NFFIN * DM, MROWS, NFFIN, DM, E);
                { constexpr int NU = (MROWS / 256) * (NFFIN / 256); const int tail = NU % F.G;
                  const int code = sff == 0 ? 1 : sff == 1 ? 10 : sff == 2 ? 3 : sff == 3 ? 4 : sff == 4 ? 9 : sff == 5 ? 6 : sff == 6 ? 7 : -1;
                  if (tail != 0) convert_in_tail(F, code, tail); else if (code >= 0) convert_set(F, code, F.vcu * NWAVES + __builtin_amdgcn_readfirstlane((int)threadIdx.x >> 6), F.G * NWAVES); } }
            PH_END();
        } else if (is_attn) {
            if (EN(4) && PH_ON()) { const PArgs args = args_fresh();
                EpiAttnIn E{WSP(bf16, WS_Q), WSP(bf16, WS_K), WSP(bf16, WS_V), WSP(bf16, WS_QI), WSP(bf16, WS_KI), WSP(float, WS_WI), args.in(15) + li * HDIM, args.in(16) + li * HDIM,
                            args.out() + O_KP + (size_t)li * MP * KVW, args.out() + O_VP + (size_t)li * MP * KVW, args.out() + O_KIP + (size_t)li * MP * IDIM,
                            args.out() + O_KS + (size_t)li * NS * KVW, args.out() + O_VS + (size_t)li * NS * KVW, args.out() + O_KIS + (size_t)li * NS * IDIM};
                run_gemm(F, WSP(bf16, WS_H), WSP(bf16, WS_WAI) + (size_t)li * ATT_NP * DM, MROWS, ATT_NP, DM, E);
                { constexpr int NU = (MROWS / 256) * (ATT_NP / 256); const int tail = NU % F.G;
#pragma unroll 1
                  for (int q = 0; q < 2; ++q) { const int code = q == 0 ? (li == 0 ? 2 : 5) : (li == 0 ? -1 : 11);
                    if (tail != 0) convert_in_tail(F, code, tail); else if (code >= 0) convert_set(F, code, F.vcu * NWAVES + __builtin_amdgcn_readfirstlane((int)threadIdx.x >> 6), F.G * NWAVES); } }
            }
            PH_END();
#ifndef PROBE_A1
#define PROBE_A1 1
#endif
            if (EN(5) && PH_ON()) {
                const int qb = (2 * F.vcu) / F.G;
#pragma unroll 1
              for (int rep = 0; rep < PROBE_A1; ++rep) {
                gu32* qhead = (gu32*)(args_fresh().ws() + WS_CTL) + CW_Q + (li * 2 + qb + 4 * rep) * 64;
#pragma unroll 1
                for (;;) {
                    if (threadIdx.x == 0) F.MISC[4] = __hip_atomic_fetch_add(qhead, 1u, __ATOMIC_RELAXED, __HIP_MEMORY_SCOPE_AGENT);
                    __syncthreads();
                    const int t = (int)F.MISC[4];
                    __syncthreads();
                    if (t >= 16 + 256) break;
                    if (t < 16) { if (EN(6)) a1::sample_unit(F, li, qb * 16 + t); }
                    else a1::prompt_unit(F, qb, 255 - (t - 16));
                }
              }
            }
            PH_END();
            if (EN(5) && PH_ON()) {
                const int grp = (8 * F.vcu) / F.G, wgi = F.vcu - grp * (F.G / 8), per = SEQ / (F.G / 8);
                const int wv = __builtin_amdgcn_readfirstlane((int)threadIdx.x >> 6);
#pragma unroll 1
                for (int q0 = wgi * per + 32 * wv; q0 < (wgi + 1) * per; q0 += 256) a1::attend_wave(F, grp >> 2, grp & 3, q0);
            }
            PH_END();
        } else {
            if (EN(8) && PH_ON()) { const PArgs args = args_fresh(); const float* st = args.in(5) + (size_t)li * NS * 2 * DM;
                EpiConvCU E{WSP(bf16, WS_Z), args.out() + O_CVP + (size_t)li * NBP * 2 * DM, args.out() + O_CVS + (size_t)li * NS * 2 * DM, st};
                run_gemm(F, WSP(bf16, WS_H), WSP(bf16, WS_WCU) + (size_t)li * 2 * DM * DM, MP, 2 * DM, DM, E);
                if (blockIdx.x < 64) { const int zb = blockIdx.x; const bf16* w0 = WSP(bf16, WS_WCU) + (size_t)li * 2 * DM * DM + (size_t)(256 * (zb >> 3) + 16 * (zb & 7)) * DM;
                    bf16* Zb = WSP(bf16, WS_Z); float* ocvs = args.out() + O_CVS + (size_t)li * NS * 2 * DM;
                    small_item<2, 4>(F, WSP(bf16, WS_H) + (size_t)MP * DM, DM, w0, w0 + (size_t)128 * DM, [=](int m, int c, float vc, float vu) {
                        const int col = 16 * zb + c; const float z = vc * vu; Zb[(size_t)(MP + m) * DM + col] = (bf16)(pk2(z, 0.f) & 0xffffu);
                        ocvs[(size_t)(2 * m + 1) * DM + col] = z; ocvs[(size_t)(2 * m) * DM + col] = st[(size_t)(2 * m + 1) * DM + col]; return 0.f; }); } }
            PH_END();
            if (EN(9) && PH_ON()) { const PArgs args = args_fresh(); const float* st = args.in(5) + (size_t)li * NS * 2 * DM;
                EpiConvB E{WSP(bf16, WS_Z), WSP(bf16, WS_O), args.in(18) + (size_t)li * 3 * DM, st}; run_gemm(F, WSP(bf16, WS_H), WSP(bf16, WS_WCB) + (size_t)li * DM * DM, MP, DM, DM, E);
                if (blockIdx.x < 64) { const int nb = blockIdx.x; const bf16* Zb = WSP(bf16, WS_Z); bf16* A2 = WSP(bf16, WS_O); const float* cw = args.in(18) + (size_t)li * 3 * DM;
                    small_item<1, 4>(F, WSP(bf16, WS_H) + (size_t)MP * DM, DM, WSP(bf16, WS_WCB) + (size_t)li * DM * DM + (size_t)16 * nb * DM, nullptr, [=](int m, int c, float v, float) {
                        const int col = 16 * nb + c; const float zt = __uint_as_float((unsigned)Zb[(size_t)(MP + m) * DM + col] << 16);
                        const float y = cw[col] * st[(size_t)(2 * m) * DM + col] + cw[DM + col] * st[(size_t)(2 * m + 1) * DM + col] + cw[2 * DM + col] * zt;
                        A2[(size_t)(MP + m) * DM + col] = (bf16)(pk2(v * y, 0.f) & 0xffffu); return 0.f; }); } }
            PH_END();
        }
        if (EN(3) && PH_ON()) { const PArgs args = args_fresh();
            const bf16* ra; const bf16* rb; int rk; int rflags;
            if (kind != 1) { const int sff = 2 * layer + (kind >> 1); ra = WSP(bf16, WS_U); rb = WSP(bf16, WS_WFO) + (size_t)sff * DM * DFF; rk = DFF; rflags = 1; }
            else if (is_attn) { ra = WSP(bf16, WS_O); rb = WSP(bf16, WS_WAO) + (size_t)li * DM * DM; rk = DM; rflags = 0; }
            else { ra = WSP(bf16, WS_O); rb = WSP(bf16, WS_WCO) + (size_t)li * DM * DM; rk = DM; rflags = 0; }
            const bool fuse = j < 11; const int nl = (j + 1) / 3, nk = (j + 1) - 3 * nl;
            const float* modn = WSP(float, WS_MOD) + (size_t)nl * NBATCH * MODW + nk * 3 * DM;
            float* xslots = WSP(float, WS_XS) + (size_t)j * XS_STRIDE; unsigned* pcnt = (unsigned*)(args.ws() + WS_CTL) + CW_PC + (size_t)j * 65 * 64;
            EpiResidMod E{WSP(float, WS_X), WSP(float, WS_MOD) + (size_t)layer * NBATCH * MODW + (3 * kind + 2) * DM, args.out() + O_YP, rflags | (j == 11 ? 2 : 0) | (fuse ? 4 : 0),
                          xslots, pcnt, WSP(bf16, WS_H), modn};
            float xk = 0.f; const bool smp = blockIdx.x < 64; const int nb = blockIdx.x;
            float* ss = xslots + (size_t)MP * 4; unsigned* scn = pcnt + 64 * 64;
            if (smp) { float* X = WSP(float, WS_X); const float* gate = WSP(float, WS_MOD) + (size_t)layer * NBATCH * MODW + (3 * kind + 2) * DM;
                float* outp = args.out() + O_YP; const float coef = (rflags & 1) ? 0.5f : 1.0f; const bool mirror = j == 11;
                const Tid T0 = tid_fresh(); const int pm_ = (T0.lane & 15) + 16 * (T0.wave >> 2), pc_ = 4 * (T0.lane >> 4) + (T0.wave & 3);
                const float xpre = X[(size_t)(MP + pm_) * DM + 16 * nb + pc_], gpre = gate[(size_t)(2 + pm_) * MODW + 16 * nb + pc_];
                auto fin = [=](int m, int c, float v, float) -> float {
                    const int col = 16 * nb + c; const size_t o = (size_t)(MP + m) * DM + col;
                    const float x = xpre + coef * gpre * v; X[o] = x; if (mirror) outp[o] = x; return x; };
                if (rk == DFF) xk = small_item<1, DFF / 256>(F, ra + (size_t)MP * rk, rk, rb + (size_t)16 * nb * rk, nullptr, fin);
                else xk = small_item<1, DM / 256>(F, ra + (size_t)MP * rk, rk, rb + (size_t)16 * nb * rk, nullptr, fin);
                if (fuse) { const Tid T = tid_fresh(); const int m = (T.lane & 15) + 16 * (T.wave >> 2);
                    LAS float* part = (LAS float*)(F.lds + RING_OFF + 65536);
                    float s = xk * xk; s += __shfl_xor(s, 16); s += __shfl_xor(s, 32);
                    if (T.lane < 16) part[(T.wave & 3) * 32 + m] = s;
                    __syncthreads();
                    if (T.tid < 32) { const float t4 = (part[T.tid] + part[32 + T.tid]) + (part[64 + T.tid] + part[96 + T.tid]);
                        __hip_atomic_store((unsigned*)ss + T.tid * 64 + nb, __float_as_uint(t4), __ATOMIC_RELAXED, __HIP_MEMORY_SCOPE_AGENT); }
                    asm volatile("s_waitcnt vmcnt(0)" ::: "memory");
                    __syncthreads();
                    if (T.tid == 0) (void)__hip_atomic_fetch_add(scn, 1u, __ATOMIC_RELAXED, __HIP_MEMORY_SCOPE_AGENT);
                } }
            run_gemm(F, ra, rb, MP, DM, rk, E);
            if (smp && fuse) { const Tid T = tid_fresh(); const int tid = T.tid;
                LAS float* rsl = (LAS float*)(F.lds + RING_OFF + 65536);
                if (tid == 0) { unsigned sp = 0;
                    while (__hip_atomic_load(scn, __ATOMIC_RELAXED, __HIP_MEMORY_SCOPE_AGENT) < 64u) { __builtin_amdgcn_s_sleep(2); if (++sp > (1u << 20)) break; }
                    __builtin_amdgcn_fence(__ATOMIC_ACQUIRE, "agent"); asm volatile("s_waitcnt vmcnt(0)" ::: "memory"); }
                __syncthreads();
                { const int m = tid >> 4, k4 = (tid & 15) * 4; f32x4 q4;
                  asm volatile("global_load_dwordx4 %0, %1, off sc1\n\ts_waitcnt vmcnt(0)" : "=v"(q4) : "v"((const unsigned*)ss + m * 64 + k4) : "memory");
                  float q = (q4[0] + q4[1]) + (q4[2] + q4[3]);
                  q += __shfl_xor(q, 1); q += __shfl_xor(q, 2); q += __shfl_xor(q, 4); q += __shfl_xor(q, 8);
                  if ((tid & 15) == 0) rsl[m] = __builtin_amdgcn_rsqf(q * (1.f / DM) + RMS_EPS); }
                __syncthreads();
                { const int m = (T.lane & 15) + 16 * (T.wave >> 2), c = 4 * (T.lane >> 4) + (T.wave & 3), col = 16 * nb + c; const float* mb = modn + (size_t)(2 + m) * MODW + col;
                  const float h = xk * rsl[m] * (mb[DM] + 1.f) + mb[0];
                  WSP(bf16, WS_H)[(size_t)(MP + m) * DM + col] = (bf16)(pk2(h, 0.f) & 0xffffu); }
                __syncthreads();
            } }
        PH_END();
    }
#undef PH_ON
#undef PH_END
}

extern "C" void kernel_launch(void* const* d_in, const int* in_sizes, int n_in, void* d_out, int out_size, void* d_ws, size_t ws_size, hipStream_t stream) {
    static int grid = 0;
    if (grid == 0) {
        if (n_in != 20 || (size_t)out_size != O_END || ws_size < WS_END) { fprintf(stderr, "kernel_launch: unexpected problem shape (n_in %d, out %d, ws %zu); nothing launched\n", n_in, out_size, ws_size); grid = -1; return; }
        int dev = 0, cus = 0, per_cu = 0;
        if (hipGetDevice(&dev) != hipSuccess || hipDeviceGetAttribute(&cus, hipDeviceAttributeMultiprocessorCount, dev) != hipSuccess) { grid = -1; return; }
        if (hipFuncSetAttribute((const void*)mega_fwd, hipFuncAttributeMaxDynamicSharedMemorySize, LDS_BYTES) != hipSuccess) { fprintf(stderr, "kernel_launch: hipFuncSetAttribute failed\n"); grid = -1; return; }
        if (hipOccupancyMaxActiveBlocksPerMultiprocessor(&per_cu, (const void*)mega_fwd, NWAVES * 64, LDS_BYTES) != hipSuccess || per_cu < 1)
            fprintf(stderr, "kernel_launch: note: occupancy query reports %d workgroups per CU\n", per_cu);
        (void)hipGetLastError();
        grid = cus;
    }
    if (grid < 0) return;
    if (hipMemsetAsync((char*)d_ws + WS_CTL, 0, CTL_ZERO_BYTES, stream) != hipSuccess) return;
    Args a{};
    for (int i = 0; i < 20; ++i) a.in[i] = (const float*)d_in[i];
    a.out = (float*)d_out; a.ws = (unsigned char*)d_ws;
#if MK_SINGLE
    a.ph_lo = 0; a.ph_hi = N_PHASES;
    hipLaunchKernelGGL(mega_fwd, dim3(grid), dim3(NWAVES * 64), LDS_BYTES, stream, a);
#else
    for (int p = 0; p < N_PHASES; ++p) { a.ph_lo = p; a.ph_hi = p + 1; hipLaunchKernelGGL(mega_fwd, dim3(grid), dim3(NWAVES * 64), LDS_BYTES, stream, a); }
#endif
}
```

```cpp
#include <hip/hip_runtime.h>
#include <cstdio>
#include <cstdint>
namespace pg8 {
#define PG8_LAS __attribute__((address_space(3)))
typedef unsigned short bf16_t;
typedef short bf16x8 __attribute__((ext_vector_type(8)));
typedef float f32x4 __attribute__((ext_vector_type(4)));
typedef unsigned u32x4 __attribute__((ext_vector_type(4)));
constexpr int BM = 256, BK = 64, HALF = 128, HTB = HALF * BK * 2  , STAGE_BYTES = 8 * HTB, NXCD = 8, WGM = 8;

__host__ __device__ __forceinline__ int lds_byte(int r, int c) { const int st = (r >> 4) * 2 + (c >> 5), rr = r & 15, cc = c & 31, ob = rr * 64 + cc * 2; return st * 1024 + (ob ^ (((ob >> 9) & 1) << 5)); }
__host__ __device__ __forceinline__ void stage_rc(int b, int& R, int& C) { const int st = b / 1024, sb = b % 1024, swz = sb ^ (((sb >> 9) & 1) << 5); R = (st >> 1) * 16 + swz / 64; C = (st & 1) * 32 + (swz % 64) / 2; }
__host__ __device__ __forceinline__ int perm32(int rho) { const int n = rho >> 4, i = rho & 15; return 8 * (i >> 2) + 4 * n + (i & 3); }

struct Unit { int pm, pn; };
struct Gemm { const bf16_t* A; const bf16_t* Bt; int M, N, K; };

struct StaticOrder {
    int nM, nN, nwg, G, c;
    __host__ __device__ void init(int M, int N, int G_, int c_) { nM = M / BM; nN = N / BM; nwg = nM * nN; G = G_; c = c_; }
    __host__ __device__ __forceinline__ bool next(int i, Unit& u) const {
        const long L = (long)i * G + c; if (L >= nwg) return false;
        int wgid = (int)L; { const int q = nwg / NXCD, r = nwg % NXCD, xcd = wgid % NXCD, off = wgid / NXCD; wgid = (xcd < r ? xcd * (q + 1) : r * (q + 1) + (xcd - r) * q) + off; }
        const int nig = WGM * nN, gid = wgid / nig, fm = gid * WGM, gsz = (nM - fm) < WGM ? (nM - fm) : WGM;
        u.pm = fm + ((wgid % nig) % gsz); u.pn = (wgid % nig) / gsz; return true;
    }
    __device__ __forceinline__ void a_ready(const Unit&) const {}
    __device__ __forceinline__ void done(const Unit&) const {}
};

__device__ __forceinline__ unsigned cvt_pk_bf16(float lo, float hi) { unsigned r; asm volatile("v_cvt_pk_bf16_f32 %0, %1, %2" : "=v"(r) : "v"(lo), "v"(hi)); return r; }
typedef float f32x2 __attribute__((ext_vector_type(2)));
template <class Epi, class Sched, bool ALIGN_EPI = false, bool SP2 = false>
__device__ __forceinline__ void gemm_phase(PG8_LAS unsigned char* lds, const Gemm g, const Sched S, const Epi E) {
    int tid_ = threadIdx.x; asm volatile("" : "+v"(tid_));
    const int tid = tid_, wid = __builtin_amdgcn_readfirstlane(tid >> 6), lane = tid & 63, wr = wid >> 2, wc = wid & 3, fr = lane & 15, fq = lane >> 4;
    const int K = g.K, nt = K / BK;
    unsigned voffA[2], voffB[2];
#pragma unroll
    for (int i = 0; i < 2; ++i) { int R, C; stage_rc(tid * 16 + i * 8192, R, C); const int Rb = Epi::PERM ? ((R & ~31) + perm32(R & 31)) : R;
        voffA[i] = (unsigned)(R * K + C) * 2u; voffB[i] = (unsigned)(Rb * K + C) * 2u; }
    const size_t kstep = (size_t)(BK * 2);
    const size_t hstep = (size_t)HALF * K * 2;
    const size_t tstep = 2 * hstep;
    const unsigned ldsw = (unsigned)wid * 1024u;
    const int aoff = lds_byte(wr * 64 + fr, fq * 8), boff = lds_byte(wc * 32 + fr, fq * 8);
#define PG8_SA(b, h) (((b) * 2 + (h)) * HTB)
#define PG8_SB(b, h) ((4 + (b) * 2 + (h)) * HTB)
#define PG8_STAGE(bufoff, gbase, voff) do { _Pragma("unroll") for (int _i = 0; _i < 2; ++_i) \
        __builtin_amdgcn_global_load_lds((const unsigned*)((const char*)(gbase) + (voff)[_i]), (PG8_LAS unsigned*)(lds + (bufoff) + ldsw + _i * 8192), 16, 0, 0); } while (0)
#define PG8_LDA(dst, b, h) do { _Pragma("unroll") for (int m = 0; m < 4; ++m) _Pragma("unroll") for (int k = 0; k < 2; ++k) dst[m][k] = *(const PG8_LAS bf16x8*)(lds + PG8_SA(b, h) + aoff + m * 2048 + k * 1024); } while (0)
#define PG8_LDB(dst, b, h) do { _Pragma("unroll") for (int n = 0; n < 2; ++n) _Pragma("unroll") for (int k = 0; k < 2; ++k) dst[n][k] = *(const PG8_LAS bf16x8*)(lds + PG8_SB(b, h) + boff + n * 2048 + k * 1024); } while (0)
#define PG8_MMA(ai, bj, At, Bt) do { __builtin_amdgcn_s_setprio(1); _Pragma("unroll") for (int m = 0; m < 4; ++m) _Pragma("unroll") for (int n = 0; n < 2; ++n) _Pragma("unroll") for (int k = 0; k < 2; ++k) \
        acc[ai][bj][m][n] = __builtin_amdgcn_mfma_f32_16x16x32_bf16(Bt[n][k], At[m][k], acc[ai][bj][m][n], 0, 0, 0); __builtin_amdgcn_s_setprio(0); } while (0)
#define PG8_WAIT_V(n) asm volatile("s_waitcnt vmcnt(" #n ")" ::: "memory")
#define PG8_WAIT_L(n) asm volatile("s_waitcnt lgkmcnt(" #n ")" ::: "memory")
#define PG8_BAR __builtin_amdgcn_s_barrier()
#define PG8_SCHED __builtin_amdgcn_sched_barrier(0)
    Unit cur, nxt; int ui = 0;
    if (!S.next(0, cur)) return;
    f32x4 acc[2][2][4][2];
#pragma unroll
    for (int a = 0; a < 2; ++a)
#pragma unroll
        for (int b = 0; b < 2; ++b)
#pragma unroll
            for (int m = 0; m < 4; ++m)
#pragma unroll
                for (int n = 0; n < 2; ++n) acc[a][b][m][n] = (f32x4){0.f, 0.f, 0.f, 0.f};
    bf16x8 At[4][2], B0[2][2], B1[2][2];
    const char* cA = (const char*)g.A + (size_t)cur.pm * tstep; const char* cB = (const char*)g.Bt + (size_t)cur.pn * tstep;
    S.a_ready(cur);
    if constexpr (SP2) {
        PG8_STAGE(PG8_SB(0, 0), cB, voffB); PG8_STAGE(PG8_SB(0, 1), cB + hstep, voffB); PG8_STAGE(PG8_SA(0, 0), cA, voffA); PG8_STAGE(PG8_SA(0, 1), cA + hstep, voffA);
        if (wr == 1) PG8_BAR;
        PG8_WAIT_V(2); PG8_BAR;
        PG8_STAGE(PG8_SB(1, 0), cB + kstep, voffB); PG8_STAGE(PG8_SA(1, 0), cA + kstep, voffA); PG8_STAGE(PG8_SB(1, 1), cB + hstep + kstep, voffB);
        PG8_WAIT_V(6); PG8_BAR;
    } else {
        PG8_STAGE(PG8_SB(0, 0), cB, voffB); PG8_STAGE(PG8_SA(0, 0), cA, voffA); PG8_STAGE(PG8_SB(0, 1), cB + hstep, voffB); PG8_STAGE(PG8_SA(0, 1), cA + hstep, voffA);
        if (wr == 1) PG8_BAR;
        PG8_WAIT_V(4); PG8_BAR;
        PG8_STAGE(PG8_SB(1, 0), cB + kstep, voffB); PG8_STAGE(PG8_SA(1, 0), cA + kstep, voffA); PG8_STAGE(PG8_SB(1, 1), cB + hstep + kstep, voffB);
        PG8_WAIT_V(6); PG8_BAR;
    }
    for (;;) {
        const bool has_next = S.next(ui + 1, nxt);
        const char* nA = has_next ? (const char*)g.A + (size_t)nxt.pm * tstep : cA; const char* nB = has_next ? (const char*)g.Bt + (size_t)nxt.pn * tstep : cB;
        for (int t = 0; t < nt; t += 2) {
            const bool last = (t == nt - 2);
            const char* a1 = cA + (size_t)(t + 1) * kstep;
            const char* a2 = last ? nA : cA + (size_t)(t + 2) * kstep; const char* b2 = last ? nB : cB + (size_t)(t + 2) * kstep;
            const char* a3 = a2 + kstep; const char* b3 = b2 + kstep;
            if (last && has_next) S.a_ready(nxt);
            if constexpr (SP2) {
            PG8_LDB(B0, 0, 0); PG8_LDB(B1, 0, 1); PG8_SCHED; PG8_LDA(At, 0, 0); PG8_STAGE(PG8_SA(1, 1), a1 + hstep, voffA);
            PG8_WAIT_V(8); PG8_WAIT_L(0); PG8_BAR; PG8_MMA(0, 0, At, B0); PG8_MMA(0, 1, At, B1); PG8_BAR; PG8_SCHED;
            PG8_LDA(At, 0, 1); PG8_STAGE(PG8_SB(0, 0), b2, voffB); PG8_STAGE(PG8_SB(0, 1), b2 + hstep, voffB); PG8_STAGE(PG8_SA(0, 0), a2, voffA);
            PG8_WAIT_V(8); PG8_WAIT_L(0); PG8_BAR; PG8_MMA(1, 0, At, B0); PG8_MMA(1, 1, At, B1); PG8_BAR; PG8_SCHED;
            PG8_LDB(B0, 1, 0); PG8_LDB(B1, 1, 1); PG8_SCHED; PG8_LDA(At, 1, 0); PG8_STAGE(PG8_SA(0, 1), a2 + hstep, voffA);
            PG8_WAIT_V(8); PG8_WAIT_L(0); PG8_BAR; PG8_MMA(0, 0, At, B0); PG8_MMA(0, 1, At, B1); PG8_BAR; PG8_SCHED;
            PG8_LDA(At, 1, 1); PG8_STAGE(PG8_SB(1, 0), b3, voffB); PG8_STAGE(PG8_SB(1, 1), b3 + hstep, voffB); PG8_STAGE(PG8_SA(1, 0), a3, voffA);
            PG8_WAIT_V(8); PG8_WAIT_L(0); PG8_BAR; PG8_MMA(1, 0, At, B0); PG8_MMA(1, 1, At, B1); PG8_BAR; PG8_SCHED;
            } else {
            PG8_LDB(B0, 0, 0); PG8_SCHED; PG8_LDA(At, 0, 0); PG8_STAGE(PG8_SA(1, 1), a1 + hstep, voffA);
            PG8_WAIT_L(8); PG8_BAR; PG8_WAIT_L(0); PG8_MMA(0, 0, At, B0); PG8_BAR; PG8_SCHED;
            PG8_LDB(B1, 0, 1); PG8_STAGE(PG8_SB(0, 0), b2, voffB);
            PG8_BAR; PG8_WAIT_L(0); PG8_MMA(0, 1, At, B1); PG8_BAR;
            PG8_LDA(At, 0, 1); PG8_STAGE(PG8_SA(0, 0), a2, voffA);
            PG8_BAR; PG8_WAIT_L(0); PG8_MMA(1, 0, At, B0); PG8_BAR; PG8_SCHED;
            PG8_STAGE(PG8_SB(0, 1), b2 + hstep, voffB);
            PG8_WAIT_V(6); PG8_BAR; PG8_MMA(1, 1, At, B1); PG8_BAR;
            PG8_LDB(B0, 1, 0); PG8_SCHED; PG8_LDA(At, 1, 0); PG8_STAGE(PG8_SA(0, 1), a2 + hstep, voffA);
            PG8_WAIT_L(8); PG8_BAR; PG8_WAIT_L(0); PG8_MMA(0, 0, At, B0); PG8_BAR; PG8_SCHED;
            PG8_LDB(B1, 1, 1); PG8_STAGE(PG8_SB(1, 0), b3, voffB);
            PG8_BAR; PG8_WAIT_L(0); PG8_MMA(0, 1, At, B1); PG8_BAR;
            PG8_LDA(At, 1, 1); PG8_STAGE(PG8_SA(1, 0), a3, voffA);
            PG8_BAR; PG8_WAIT_L(0); PG8_MMA(1, 0, At, B0); PG8_BAR; PG8_SCHED;
            PG8_STAGE(PG8_SB(1, 1), b3 + hstep, voffB);
            PG8_WAIT_V(6); PG8_BAR; PG8_MMA(1, 1, At, B1); PG8_BAR;
            }
        }
        if constexpr (ALIGN_EPI) { if (wr == 0) PG8_BAR; }
        if constexpr (!Epi::AFTER_DRAIN) { E(acc, cur, wr, wc, fr, fq); S.done(cur); }
        if (!has_next) break;
#pragma unroll
        for (int a = 0; a < 2; ++a)
#pragma unroll
            for (int b = 0; b < 2; ++b)
#pragma unroll
                for (int m = 0; m < 4; ++m)
#pragma unroll
                    for (int n = 0; n < 2; ++n) acc[a][b][m][n] = (f32x4){0.f, 0.f, 0.f, 0.f};
        cur = nxt; cA = nA; cB = nB; ++ui;
        if constexpr (ALIGN_EPI) { if (wr == 1) PG8_BAR; }
    }
    PG8_WAIT_V(0);
    if constexpr (!ALIGN_EPI) { if (wr == 0) PG8_BAR; }
    PG8_BAR;
    if constexpr (Epi::AFTER_DRAIN) { E.fused(acc, cur, wr, wc, fr, fq, lds, wid, lane); S.done(cur); }
#undef PG8_SA
#undef PG8_SB
#undef PG8_STAGE
#undef PG8_LDA
#undef PG8_LDB
#undef PG8_MMA
#undef PG8_WAIT_V
#undef PG8_WAIT_L
#undef PG8_BAR
#undef PG8_SCHED
}
}

constexpr int DM = 1024, SEQ = 8192, NBP = 2, MP = NBP * SEQ, NS = 32;
constexpr int MROWS = 16640, MVALID = MP + NS;
constexpr int DFF = 2816, NFFIN = 2 * DFF;
constexpr int NHEAD = 16, HDIM = 64, KVW = 256, IQW = 512, IDIM = 64, IHEADS = 8, TOPK = 256;
constexpr int ATT_COLS = 2120, ATT_NP = 2304;
constexpr int MODW = 9 * DM, NBATCH = 34;
constexpr int NPG = 64, PAGE = 128, NPOOL = 2560;
constexpr float RMS_EPS = 1e-6f;
constexpr float QSCALE = 0.125f * 1.4426950408889634f;
constexpr float WISCALE = 0.35355339059327373f * 0.125f;
constexpr size_t O_YP = 0, O_YS = 16777216, O_KP = 16809984, O_VP = 25198592, O_KIP = 33587200, O_CVP = 35684352,
                 O_KS = 35692544, O_VS = 35708928, O_KIS = 35725312, O_CVS = 35729408, O_END = 35860480;
constexpr size_t MiB = 1u << 20;
constexpr size_t WS_CTL = 0, CTL_ZERO_BYTES = 1 * MiB;
constexpr size_t WS_MOD = 1 * MiB;
constexpr size_t WS_WFI = 8 * MiB;
constexpr size_t WS_WFO = 96 * MiB;
constexpr size_t WS_WAI = 140 * MiB;
constexpr size_t WS_WAO = 150 * MiB;
constexpr size_t WS_WCU = 154 * MiB;
constexpr size_t WS_WCB = 162 * MiB;
constexpr size_t WS_WCO = 166 * MiB;
constexpr size_t WS_X = 176 * MiB;
constexpr size_t WS_H = 242 * MiB;
constexpr size_t WS_U = 276 * MiB;
constexpr size_t WS_Q = 366 * MiB;
constexpr size_t WS_K = 399 * MiB;
constexpr size_t WS_V = 408 * MiB;
constexpr size_t WS_QI = 417 * MiB;
constexpr size_t WS_KI = 434 * MiB;
constexpr size_t WS_WI = 437 * MiB;
constexpr size_t WS_O = 438 * MiB;
constexpr size_t WS_Z = 471 * MiB;
constexpr size_t WS_IDX = 504 * MiB;
constexpr size_t WS_NSEL = 512 * MiB;
constexpr size_t WS_XS = 513 * MiB;
constexpr size_t XS_STRIDE = (size_t)MP * 4 + 32 * 64;
constexpr size_t WS_END = 517 * MiB;
static_assert(WS_MOD + (size_t)4 * 34 * 9216 * 4 <= WS_WFI && WS_WFI + (size_t)8 * 5632 * 1024 * 2 <= WS_WFO && WS_WFO + (size_t)8 * 1024 * 2816 * 2 <= WS_WAI &&
              WS_WAI + (size_t)2 * 2304 * 1024 * 2 <= WS_WAO && WS_X + (size_t)MROWS * DM * 4 <= WS_H && WS_H + (size_t)MROWS * DM * 2 <= WS_U &&
              WS_U + (size_t)MROWS * DFF * 2 <= WS_Q && WS_Q + (size_t)MROWS * DM * 2 <= WS_K && WS_K + (size_t)MROWS * KVW * 2 <= WS_V && WS_V + (size_t)MROWS * KVW * 2 <= WS_QI &&
              WS_QI + (size_t)MROWS * IQW * 2 <= WS_KI && WS_KI + (size_t)MROWS * IDIM * 2 <= WS_WI && WS_WI + (size_t)MROWS * 8 * 4 <= WS_O && WS_O + (size_t)MROWS * DM * 2 <= WS_Z &&
              WS_Z + (size_t)MROWS * DM * 2 <= WS_IDX && WS_IDX + (size_t)MP * TOPK * 2 <= WS_NSEL && WS_NSEL + (size_t)MP * 4 <= WS_XS && WS_XS + 12 * XS_STRIDE * 4 <= WS_END, "d_ws map");
constexpr int CW_TMO = 0, CW_BAR = 4096, CW_Q = 8192, CW_PC = 16384;
constexpr int RING_OFF = 0, RING_BYTES = 131072;
constexpr int LDSCTL_OFF = RING_BYTES, MISC_OFF = LDSCTL_OFF + 320;
constexpr int LDS_BYTES = 147456;
constexpr int NWAVES = 8;

#define GAS __attribute__((address_space(1)))
#define LAS __attribute__((address_space(3)))
typedef unsigned short bf16;
typedef unsigned v4u __attribute__((ext_vector_type(4)));
typedef unsigned v2u __attribute__((ext_vector_type(2)));
typedef float f32x4 __attribute__((ext_vector_type(4)));
typedef float f32x2 __attribute__((ext_vector_type(2)));
typedef float f32x16 __attribute__((ext_vector_type(16)));
typedef short bf16x8 __attribute__((ext_vector_type(8)));
typedef GAS unsigned gu32;
#define LDS_WAIT() asm volatile("s_waitcnt lgkmcnt(0)" ::: "memory")
#define VM_WAIT() asm volatile("s_waitcnt vmcnt(0)" ::: "memory")
__device__ __forceinline__ unsigned pk2(float lo, float hi) { return pg8::cvt_pk_bf16(lo, hi); }
__device__ __forceinline__ float bflo(unsigned u) { return __uint_as_float(u << 16); }
__device__ __forceinline__ float bfhi(unsigned u) { return __uint_as_float(u & 0xffff0000u); }
__device__ __forceinline__ float silu1(float a) { return a * __builtin_amdgcn_rcpf(1.f + __builtin_amdgcn_exp2f(-1.4426950408889634f * a)); }
__device__ __forceinline__ int batch_of(int row) { const int b = row < MP ? (row >> 13) : (2 + row - MP); return b > 33 ? 33 : b; }
__device__ __forceinline__ float wave_sum(float v) {
#pragma unroll
    for (int o = 1; o < 64; o <<= 1) v += __shfl_xor(v, o);
    return v;
}
__device__ __forceinline__ float wave_max(float v) {
#pragma unroll
    for (int o = 1; o < 64; o <<= 1) v = fmaxf(v, __shfl_xor(v, o));
    return v;
}
#define XB_TMO      128
#define XB_XCNT(j)  (256  + 64 * (j))
#define XB_XSUB(j)  (1280 + 64 * (j))
#define XB_XGEN(j)  (2304 + 64 * (j))
#define XB_TOP      3328
#define XB_TOPGEN   3392
#define XCD_BAR_WORDS 3456
#define XB_SPIN_CAP (1u << 18)

__device__ __forceinline__ unsigned xb_ld(unsigned* p)              { return __hip_atomic_load(p, __ATOMIC_RELAXED, __HIP_MEMORY_SCOPE_AGENT); }
__device__ __forceinline__ unsigned xb_add(unsigned* p, unsigned v) { return __hip_atomic_fetch_add(p, v, __ATOMIC_RELAXED, __HIP_MEMORY_SCOPE_AGENT); }
__device__ __forceinline__ unsigned xb_xcc_id() { return (unsigned)__builtin_amdgcn_s_getreg((3 << 11) | 20) & 0xFu; }
#define XB_SPIN(cond, bar) do { unsigned _sp = 0; while (cond) { __builtin_amdgcn_s_sleep(1); \
    if ((++_sp & 255u) == 0u) { if (xb_ld(&(bar)[XB_TMO])) break; if (_sp > XB_SPIN_CAP) { atomicAdd(&(bar)[XB_TMO], 1u); break; } } } } while (0)

struct XcdBarrier {
    unsigned* bar; unsigned x;
    volatile LAS unsigned* st;
};

__device__ __forceinline__ XcdBarrier xcd_barrier_post(unsigned* bar, volatile LAS unsigned* st) {
    XcdBarrier b; b.bar = bar; b.x = xb_xcc_id(); b.st = st;
    if (threadIdx.x == 0) (void)xb_add(&bar[XB_XCNT(b.x)], 1u);
    return b;
}
__device__ __forceinline__ void xcd_barrier_complete(unsigned* bar, unsigned x, unsigned& nloc, unsigned& nx) {
    const unsigned G = gridDim.x * gridDim.y * gridDim.z;
    unsigned sum, cnt, mine, sp = 0u;
    for (;;) {
        sum = 0u; cnt = 0u; mine = 0u;
#pragma unroll
        for (unsigned j = 0; j < 16; ++j) { const unsigned c = xb_ld(&bar[XB_XCNT(j)]); sum += c; cnt += (c > 0u) ? 1u : 0u; mine = (j == x) ? c : mine; }
        if (sum == G) break;
        __builtin_amdgcn_s_sleep(1);
        if ((++sp & 255u) == 0u) { if (xb_ld(&bar[XB_TMO])) break; if (sp > XB_SPIN_CAP) { atomicAdd(&bar[XB_TMO], 1u); break; } }
    }
    nloc = mine > 0u ? mine : 1u; nx = cnt > 0u ? cnt : 1u;
}

__device__ __forceinline__ void xcd_barrier(const XcdBarrier& b) {
    asm volatile("s_waitcnt vmcnt(0)" ::: "memory");
    __syncthreads();
    if (threadIdx.x == 0) {
        unsigned* bar = b.bar;
        __builtin_amdgcn_s_waitcnt(0);
        unsigned nloc = b.st[0], nx = b.st[1];
        if (nloc == 0u) { xcd_barrier_complete(bar, b.x, nloc, nx); b.st[0] = nloc; b.st[1] = nx; }
        const unsigned old = xb_add(&bar[XB_XSUB(b.x)], 1u);
        const unsigned gen = old / nloc;
        if (old + 1u == (gen + 1u) * nloc) {
            __builtin_amdgcn_fence(__ATOMIC_RELEASE, "agent");
            asm volatile("s_waitcnt vmcnt(0)" ::: "memory");
            const unsigned og = xb_add(&bar[XB_TOP], 1u);
            const unsigned tg = og / nx;
            if (og + 1u == (tg + 1u) * nx) xb_add(&bar[XB_TOPGEN], 1u);
            else XB_SPIN(xb_ld(&bar[XB_TOPGEN]) == tg, bar);
            __builtin_amdgcn_fence(__ATOMIC_ACQUIRE, "agent");
            asm volatile("s_waitcnt vmcnt(0)" ::: "memory");
        } else {
            XB_SPIN(xb_ld(&bar[XB_TOPGEN]) == gen, bar);
            __builtin_amdgcn_fence(__ATOMIC_ACQUIRE, "agent");
            asm volatile("s_waitcnt vmcnt(0)" ::: "memory");
        }
    }
    __syncthreads();
}

using pg8::Unit;
typedef _Float16 h2e __attribute__((ext_vector_type(2)));
__device__ __forceinline__ unsigned pkh2(float a, float b) { const h2e t = __builtin_convertvector((f32x2){a, b}, h2e); return __builtin_bit_cast(unsigned, t); }

struct EpiSwiglu {
    static constexpr bool PERM = true, AFTER_DRAIN = false;
    bf16* U;
    __device__ __forceinline__ void operator()(const f32x4 (&acc)[2][2][4][2], const Unit& u, int wr, int wc, int fr, int fq) const {
        const int row0 = u.pm * 256 + wr * 64 + fr, col0 = u.pn * 128 + wc * 32 + 8 * fq;
#pragma unroll
        for (int ai = 0; ai < 2; ++ai)
#pragma unroll
            for (int m = 0; m < 4; ++m) {
                const f32x4 a0 = acc[ai][0][m][0], a1 = acc[ai][0][m][1], g0 = acc[ai][1][m][0], g1 = acc[ai][1][m][1];
                v4u w;
                w.x = pk2(silu1(a0[0]) * g0[0], silu1(a0[1]) * g0[1]); w.y = pk2(silu1(a0[2]) * g0[2], silu1(a0[3]) * g0[3]);
                w.z = pk2(silu1(a1[0]) * g1[0], silu1(a1[1]) * g1[1]); w.w = pk2(silu1(a1[2]) * g1[2], silu1(a1[3]) * g1[3]);
                *(v4u*)(U + (size_t)(row0 + ai * 128 + m * 16) * DFF + col0) = w;
            }
    }
};

struct EpiResid {
    static constexpr bool PERM = false, AFTER_DRAIN = false;
    float* X; const float* gate; float* outp; int flags;
    __device__ __forceinline__ void operator()(const f32x4 (&acc)[2][2][4][2], const Unit& u, int wr, int wc, int fr, int fq) const {
        const int row0 = u.pm * 256 + wr * 64 + fr, colb = u.pn * 256 + wc * 32 + 4 * fq;
        const float coef = (flags & 1) ? 0.5f : 1.0f; const bool mirror = (flags & 2) != 0;
#pragma unroll
        for (int ai = 0; ai < 2; ++ai)
#pragma unroll
            for (int m = 0; m < 4; ++m) {
                const int row = row0 + ai * 128 + m * 16; const int b = batch_of(row);
                const float* gp = gate + (size_t)b * MODW + colb; float* xp = X + (size_t)row * DM + colb;
#pragma unroll
                for (int bj = 0; bj < 2; ++bj)
#pragma unroll
                    for (int n = 0; n < 2; ++n) { const int off = bj * 128 + n * 16;
                        const f32x4 g = *(const f32x4*)(gp + off); f32x4 x = *(const f32x4*)(xp + off);
                        x = x + (g * coef) * acc[ai][bj][m][n]; *(f32x4*)(xp + off) = x;
                        if (mirror && row < MVALID) *(f32x4*)(outp + (size_t)row * DM + colb + off) = x; }
            }
    }
};

struct EpiResidMod {
    static constexpr bool PERM = false, AFTER_DRAIN = true;
    float* X; const float* gate; float* outp; int flags;
    float* xbuf; unsigned* cnt; bf16* H; const float* modn;
    __device__ __forceinline__ void fused(f32x4 (&acc)[2][2][4][2], const Unit& u, int wr, int wc, int fr, int fq, LAS unsigned char* lds, int wid, int lane) const {
        asm volatile("" : "+v"(fr), "+v"(fq));
        const int row0 = u.pm * 256 + wr * 64 + fr, colb = u.pn * 256 + wc * 32 + 4 * fq;
        const float coef = (flags & 1) ? 0.5f : 1.0f; const bool mirror = (flags & 2) != 0;
        const int b = u.pm >> 5;
        const float* gp = gate + (size_t)b * MODW + colb;
        f32x4 gv[2][2];
#pragma unroll
        for (int bj = 0; bj < 2; ++bj)
#pragma unroll
            for (int n = 0; n < 2; ++n) gv[bj][n] = *(const f32x4*)(gp + bj * 128 + n * 16);
#pragma unroll
        for (int ai = 0; ai < 2; ++ai) {
            float* xp = X + (size_t)(row0 + ai * 128) * DM + colb;
            f32x4 xv[4][2][2];
#pragma unroll
            for (int m = 0; m < 4; ++m)
#pragma unroll
                for (int bj = 0; bj < 2; ++bj)
#pragma unroll
                    for (int n = 0; n < 2; ++n) xv[m][bj][n] = *(const f32x4*)(xp + (size_t)m * 16 * DM + bj * 128 + n * 16);
            asm volatile("" ::: "memory");
            if (ai == 0) {
#pragma unroll
                for (int bj = 0; bj < 2; ++bj)
#pragma unroll
                    for (int n = 0; n < 2; ++n) gv[bj][n] = gv[bj][n] * coef; }
#pragma unroll
            for (int m = 0; m < 4; ++m)
#pragma unroll
                for (int bj = 0; bj < 2; ++bj)
#pragma unroll
                    for (int n = 0; n < 2; ++n) { const f32x4 x = xv[m][bj][n] + gv[bj][n] * acc[ai][bj][m][n]; acc[ai][bj][m][n] = x; *(f32x4*)(xp + (size_t)m * 16 * DM + bj * 128 + n * 16) = x; }
            if (mirror) { float* op = outp + (size_t)(row0 + ai * 128) * DM + colb;
#pragma unroll
                for (int m = 0; m < 4; ++m)
#pragma unroll
                    for (int bj = 0; bj < 2; ++bj)
#pragma unroll
                        for (int n = 0; n < 2; ++n) *(f32x4*)(op + (size_t)m * 16 * DM + bj * 128 + n * 16) = acc[ai][bj][m][n]; }
        }
        if (!(flags & 4)) return;
        const float* mb = modn + (size_t)b * MODW + colb;
        f32x4 shv[2][2], scv[2][2];
#pragma unroll
        for (int bj = 0; bj < 2; ++bj)
#pragma unroll
            for (int n = 0; n < 2; ++n) { shv[bj][n] = *(const f32x4*)(mb + bj * 128 + n * 16); scv[bj][n] = *(const f32x4*)(mb + DM + bj * 128 + n * 16); }
        LAS float* P = (LAS float*)lds;
        LAS float* S = (LAS float*)(lds + 8192);
        LAS unsigned* flag = (LAS unsigned*)(lds + 8192 + 2048);
#pragma unroll
        for (int ai = 0; ai < 2; ++ai)
#pragma unroll
            for (int m = 0; m < 4; ++m) { float s = 0.f;
#pragma unroll
                for (int bj = 0; bj < 2; ++bj)
#pragma unroll
                    for (int n = 0; n < 2; ++n) { const f32x4 x = acc[ai][bj][m][n]; s += (x[0] * x[0] + x[1] * x[1]) + (x[2] * x[2] + x[3] * x[3]); }
                s += __shfl_xor(s, 16); s += __shfl_xor(s, 32);
                if (fq == 0) P[(ai * 128 + wr * 64 + m * 16 + fr) * 4 + wc] = s; }
        asm volatile("s_waitcnt lgkmcnt(0)" ::: "memory"); __builtin_amdgcn_s_barrier(); asm volatile("" ::: "memory");
        const int prow = wid * 32 + (lane & 31);
        if (lane < 32) { const f32x4 p4 = *(const LAS f32x4*)(P + prow * 4); const float t = (p4[0] + p4[1]) + (p4[2] + p4[3]);
            __hip_atomic_store((unsigned*)xbuf + ((size_t)(u.pm * 256 + prow) * 4 + u.pn), __float_as_uint(t), __ATOMIC_RELAXED, __HIP_MEMORY_SCOPE_AGENT); }
        asm volatile("s_waitcnt vmcnt(0)" ::: "memory");
        if (lane == 0) __hip_atomic_fetch_add(cnt + 64 * u.pm, 1u, __ATOMIC_RELAXED, __HIP_MEMORY_SCOPE_AGENT);
        if (wid == 0) {
            unsigned sp = 0;
            while ((unsigned)__builtin_amdgcn_readfirstlane(__hip_atomic_load(cnt + 64 * u.pm, __ATOMIC_RELAXED, __HIP_MEMORY_SCOPE_AGENT)) < 32u) { __builtin_amdgcn_s_sleep(2); if (++sp > (1u << 20)) break; }
            __builtin_amdgcn_fence(__ATOMIC_ACQUIRE, "agent");
            if (lane == 0) flag[0] = 1u;
        }
        asm volatile("s_waitcnt vmcnt(0) lgkmcnt(0)" ::: "memory"); __builtin_amdgcn_s_barrier(); asm volatile("" ::: "memory");
        if (lane < 32) { const unsigned* sl = (const unsigned*)xbuf + (size_t)(u.pm * 256 + prow) * 4; f32x4 q4;
            asm volatile("global_load_dwordx4 %0, %1, off sc1\n\ts_waitcnt vmcnt(0)" : "=v"(q4) : "v"(sl) : "memory");
            const float q = (q4[0] + q4[1]) + (q4[2] + q4[3]);
            S[prow] = __builtin_amdgcn_rsqf(q * (1.f / DM) + RMS_EPS); }
        asm volatile("s_waitcnt lgkmcnt(0)" ::: "memory"); __builtin_amdgcn_s_barrier(); asm volatile("" ::: "memory");
#pragma unroll
        for (int bj = 0; bj < 2; ++bj)
#pragma unroll
            for (int n = 0; n < 2; ++n) { const int off = bj * 128 + n * 16;
                const f32x4 sh = shv[bj][n], sc = scv[bj][n] + 1.f;
#pragma unroll
                for (int ai = 0; ai < 2; ++ai)
#pragma unroll
                    for (int m = 0; m < 4; ++m) { const int r = ai * 128 + wr * 64 + m * 16 + fr; const float rs = S[r];
                        const f32x4 h = acc[ai][bj][m][n] * rs * sc + sh; v2u o; o.x = pk2(h[0], h[1]); o.y = pk2(h[2], h[3]);
                        *(v2u*)(H + (size_t)(u.pm * 256 + r) * DM + colb + off) = o; } }
    }
};

struct EpiAttnIn {
    static constexpr bool PERM = true, AFTER_DRAIN = false;
    bf16 *Qb, *Kb, *Vb, *QIb, *KIb; float* WIb; const float *qg, *kg; float *okp, *ovp, *okip, *oks, *ovs, *okis;
    __device__ __forceinline__ void operator()(const f32x4 (&acc)[2][2][4][2], const Unit& u, int wr, int wc, int fr, int fq) const {
        const int tile = u.pn; const int row0 = u.pm * 256 + wr * 64 + fr;
        if (tile < 5) {
            const float* gain = tile < 4 ? qg : kg; const float post = tile < 4 ? QSCALE : 1.f;
            f32x4 gv[2][2];
#pragma unroll
            for (int bj = 0; bj < 2; ++bj)
#pragma unroll
                for (int n = 0; n < 2; ++n) gv[bj][n] = *(const f32x4*)(gain + 32 * bj + 8 * fq + 4 * n);
#pragma unroll
            for (int ai = 0; ai < 2; ++ai)
#pragma unroll
                for (int m = 0; m < 4; ++m) {
                    const int row = row0 + ai * 128 + m * 16; float ss = 0.f;
#pragma unroll
                    for (int bj = 0; bj < 2; ++bj)
#pragma unroll
                        for (int n = 0; n < 2; ++n) { const f32x4 v = acc[ai][bj][m][n]; ss += (v[0] * v[0] + v[1] * v[1]) + (v[2] * v[2] + v[3] * v[3]); }
                    ss += __shfl_xor(ss, 16); ss += __shfl_xor(ss, 32);
                    const float r = __builtin_amdgcn_rsqf(ss * (1.f / 64.f) + RMS_EPS);
#pragma unroll
                    for (int bj = 0; bj < 2; ++bj) {
                        const f32x4 v0 = acc[ai][bj][m][0] * r * gv[bj][0], v1 = acc[ai][bj][m][1] * r * gv[bj][1];
                        const int hc = 32 * bj + 8 * fq;
                        if (tile < 4) { v4u w; w.x = pk2(v0[0] * post, v0[1] * post); w.y = pk2(v0[2] * post, v0[3] * post); w.z = pk2(v1[0] * post, v1[1] * post); w.w = pk2(v1[2] * post, v1[3] * post);
                            *(v4u*)(Qb + (size_t)row * DM + (4 * tile + wc) * 64 + hc) = w; }
                        else { v4u w; w.x = pk2(v0[0], v0[1]); w.y = pk2(v0[2], v0[3]); w.z = pk2(v1[0], v1[1]); w.w = pk2(v1[2], v1[3]);
                            if (row < MP) *(v4u*)(Kb + ((size_t)((row >> 13) * 4 + wc) * SEQ + (row & (SEQ - 1))) * 64 + hc) = w;
                            float* o = row < MP ? okp + (size_t)row * KVW : (row < MVALID ? oks + (size_t)(row - MP) * KVW : nullptr);
                            if (o) { *(f32x4*)(o + wc * 64 + hc) = v0; *(f32x4*)(o + wc * 64 + hc + 4) = v1; } }
                    }
                }
        } else if (tile == 5) {
#pragma unroll
            for (int ai = 0; ai < 2; ++ai)
#pragma unroll
                for (int m = 0; m < 4; ++m) {
                    const int row = row0 + ai * 128 + m * 16;
                    float* o = row < MP ? ovp + (size_t)row * KVW : (row < MVALID ? ovs + (size_t)(row - MP) * KVW : nullptr);
#pragma unroll
                    for (int bj = 0; bj < 2; ++bj) { const f32x4 v0 = acc[ai][bj][m][0], v1 = acc[ai][bj][m][1]; const int hc = 32 * bj + 8 * fq;
                        v4u w; w.x = pkh2(v0[0], v0[1]); w.y = pkh2(v0[2], v0[3]); w.z = pkh2(v1[0], v1[1]); w.w = pkh2(v1[2], v1[3]);
                        if (row < MP) *(v4u*)(Vb + ((size_t)((row >> 13) * 4 + wc) * SEQ + (row & (SEQ - 1))) * 64 + hc) = w;
                        if (o) { *(f32x4*)(o + wc * 64 + hc) = v0; *(f32x4*)(o + wc * 64 + hc + 4) = v1; } }
                }
        } else if (tile < 8) {
#pragma unroll
            for (int ai = 0; ai < 2; ++ai)
#pragma unroll
                for (int m = 0; m < 4; ++m) {
                    const int row = row0 + ai * 128 + m * 16;
#pragma unroll
                    for (int bj = 0; bj < 2; ++bj) { const f32x4 v0 = acc[ai][bj][m][0], v1 = acc[ai][bj][m][1]; const int hc = 32 * bj + 8 * fq;
                        v4u w; w.x = pk2(v0[0], v0[1]); w.y = pk2(v0[2], v0[3]); w.z = pk2(v1[0], v1[1]); w.w = pk2(v1[2], v1[3]);
                        *(v4u*)(QIb + (size_t)row * IQW + (4 * (tile - 6) + wc) * 64 + hc) = w; }
                }
        } else {
#pragma unroll
            for (int ai = 0; ai < 2; ++ai)
#pragma unroll
                for (int m = 0; m < 4; ++m) {
                    const int row = row0 + ai * 128 + m * 16;
                    if (wc == 0) {
                        float* o = row < MP ? okip + (size_t)row * IDIM : (row < MVALID ? okis + (size_t)(row - MP) * IDIM : nullptr);
#pragma unroll
                        for (int bj = 0; bj < 2; ++bj) { const f32x4 v0 = acc[ai][bj][m][0], v1 = acc[ai][bj][m][1]; const int hc = 32 * bj + 8 * fq;
                            v4u w; w.x = pk2(v0[0], v0[1]); w.y = pk2(v0[2], v0[3]); w.z = pk2(v1[0], v1[1]); w.w = pk2(v1[2], v1[3]);
                            *(v4u*)(KIb + (size_t)row * IDIM + hc) = w;
                            if (o) { *(f32x4*)(o + hc) = v0; *(f32x4*)(o + hc + 4) = v1; } }
                    } else if (wc == 1 && fq == 0) {
                        *(f32x4*)(WIb + (size_t)row * 8) = acc[ai][0][m][0] * WISCALE; *(f32x4*)(WIb + (size_t)row * 8 + 4) = acc[ai][0][m][1] * WISCALE;
                    }
                }
        }
    }
};

struct EpiConvCU {
    static constexpr bool PERM = true, AFTER_DRAIN = false;
    bf16* Zb; float* ocvp; float* ocvs; const float* state;
    __device__ __forceinline__ void operator()(const f32x4 (&acc)[2][2][4][2], const Unit& u, int wr, int wc, int fr, int fq) const {
        const int row0 = u.pm * 256 + wr * 64 + fr, col0 = u.pn * 128 + wc * 32 + 8 * fq;
#pragma unroll
        for (int ai = 0; ai < 2; ++ai)
#pragma unroll
            for (int m = 0; m < 4; ++m) {
                const int row = row0 + ai * 128 + m * 16;
                const f32x4 z0 = acc[ai][0][m][0] * acc[ai][1][m][0], z1 = acc[ai][0][m][1] * acc[ai][1][m][1];
                v4u w; w.x = pk2(z0[0], z0[1]); w.y = pk2(z0[2], z0[3]); w.z = pk2(z1[0], z1[1]); w.w = pk2(z1[2], z1[3]);
                *(v4u*)(Zb + (size_t)row * DM + col0) = w;
                { const int t = row & (SEQ - 1);
                    if (t >= SEQ - 2) { float* o = ocvp + ((size_t)(row >> 13) * 2 + (t - (SEQ - 2))) * DM + col0; *(f32x4*)o = z0; *(f32x4*)(o + 4) = z1; } }
            }
    }
};

struct EpiConvB {
    static constexpr bool PERM = true, AFTER_DRAIN = false;
    const bf16* Zb; bf16* A2; const float* cw; const float* state;
    __device__ __forceinline__ void operator()(const f32x4 (&acc)[2][2][4][2], const Unit& u, int wr, int wc, int fr, int fq) const {
        const int row0 = u.pm * 256 + wr * 64 + fr;
#pragma unroll
        for (int bj = 0; bj < 2; ++bj) {
            const int col0 = u.pn * 256 + bj * 128 + wc * 32 + 8 * fq;
            f32x4 w0[2], w1[2], w2[2];
#pragma unroll
            for (int n = 0; n < 2; ++n) { w0[n] = *(const f32x4*)(cw + col0 + 4 * n); w1[n] = *(const f32x4*)(cw + DM + col0 + 4 * n); w2[n] = *(const f32x4*)(cw + 2 * DM + col0 + 4 * n); }
#pragma unroll
            for (int am = 0; am < 4; ++am) { const int ai = am >> 1, mb = (am & 1) * 2;
                v4u zt[2], q1[2], q2[2];
#pragma unroll
                for (int mm = 0; mm < 2; ++mm) { const int row = row0 + ai * 128 + (mb + mm) * 16, t = row & (SEQ - 1); const bf16* zp = Zb + (size_t)row * DM + col0;
                    zt[mm] = *(const v4u*)zp; q1[mm] = *(const v4u*)(zp - (t >= 1 ? DM : 0)); q2[mm] = *(const v4u*)(zp - (t >= 2 ? 2 * DM : 0)); }
                asm volatile("" ::: "memory");
#pragma unroll
                for (int mm = 0; mm < 2; ++mm) { const int m = mb + mm; const int row = row0 + ai * 128 + m * 16, t = row & (SEQ - 1);
                    const v4u z0 = (v4u){0u, 0u, 0u, 0u}; const v4u p1 = t >= 1 ? q1[mm] : z0, p2 = t >= 2 ? q2[mm] : z0, pt = zt[mm];
                    const f32x4 a1[2] = {(f32x4){bflo(p1.x), bfhi(p1.x), bflo(p1.y), bfhi(p1.y)}, (f32x4){bflo(p1.z), bfhi(p1.z), bflo(p1.w), bfhi(p1.w)}};
                    const f32x4 a2[2] = {(f32x4){bflo(p2.x), bfhi(p2.x), bflo(p2.y), bfhi(p2.y)}, (f32x4){bflo(p2.z), bfhi(p2.z), bflo(p2.w), bfhi(p2.w)}};
                    const f32x4 c0 = (f32x4){bflo(pt.x), bfhi(pt.x), bflo(pt.y), bfhi(pt.y)}, c1 = (f32x4){bflo(pt.z), bfhi(pt.z), bflo(pt.w), bfhi(pt.w)};
                    const f32x4 y0 = (w0[0] * a2[0] + w1[0] * a1[0] + w2[0] * c0) * acc[ai][bj][m][0], y1 = (w0[1] * a2[1] + w1[1] * a1[1] + w2[1] * c1) * acc[ai][bj][m][1];
                    v4u w; w.x = pk2(y0[0], y0[1]); w.y = pk2(y0[2], y0[3]); w.z = pk2(y1[0], y1[1]); w.w = pk2(y1[2], y1[3]);
                    *(v4u*)(A2 + (size_t)row * DM + col0) = w;
                }
            }
        }
    }
};

struct Args { const float* in[20]; float* out; unsigned char* ws; int ph_lo, ph_hi; };
typedef __attribute__((address_space(4))) const unsigned char* kaptr_t;
struct PArgs {
    kaptr_t p;
    __device__ __forceinline__ const float* in(int i) const { return *(const float* const __attribute__((address_space(4)))*)(p + 8 * i); }
    __device__ __forceinline__ float* out() const { return *(float* const __attribute__((address_space(4)))*)(p + 160); }
    __device__ __forceinline__ unsigned char* ws() const { return *(unsigned char* const __attribute__((address_space(4)))*)(p + 168); }
};
static_assert(sizeof(Args) == 184, "kernarg layout");
__device__ __forceinline__ PArgs args_fresh() { kaptr_t p = (kaptr_t)__builtin_amdgcn_kernarg_segment_ptr(); asm volatile("" : "+s"(p)); PArgs a; a.p = p; return a; }
struct Frame {
    LAS unsigned char* lds; volatile LAS unsigned* MISC;
    int vcu, G;
};
struct Tid { int tid, lane, wave; };
__device__ __forceinline__ Tid tid_fresh() { int t = threadIdx.x; asm volatile("" : "+v"(t)); Tid r; r.tid = t; r.lane = t & 63; r.wave = __builtin_amdgcn_readfirstlane(t >> 6); return r; }
#define WSP(T, off) ((T*)(args.ws() + (off)))

__device__ __forceinline__ f32x4 silu4(f32x4 c) { f32x4 r; r[0] = c[0] / (1.f + __expf(-c[0])); r[1] = c[1] / (1.f + __expf(-c[1])); r[2] = c[2] / (1.f + __expf(-c[2])); r[3] = c[3] / (1.f + __expf(-c[3])); return r; }
__device__ __forceinline__ f32x4 silu4f(f32x4 c) { f32x4 r;
#pragma unroll
    for (int e = 0; e < 4; ++e) r[e] = c[e] * __builtin_amdgcn_rcpf(1.f + __builtin_amdgcn_exp2f(-1.4426950408889634f * c[e]));
    return r; }
__device__ __forceinline__ void ada_item16(const float* w_ada, const float* b_ada, const float* c_prompt, const float* c_sample, float* MOD, int item, int lane) {
    const int layer = item / 576, c0 = (item % 576) * 16; const int li = lane & 15, kk = lane >> 4;
    const float* W = w_ada + (size_t)layer * DM * MODW + c0 + li;
    f32x4 acc[2]; float pa[2] = {0.f, 0.f};
    acc[0] = acc[1] = (f32x4){0.f, 0.f, 0.f, 0.f};
#pragma unroll 4
    for (int k0 = 0; k0 < DM; k0 += 16) {
        float w[4]; f32x4 cs[2], cp[2];
#pragma unroll
        for (int st = 0; st < 4; ++st) w[st] = W[(size_t)(k0 + 4 * kk + st) * MODW];
#pragma unroll
        for (int rb = 0; rb < 2; ++rb) cs[rb] = silu4f(*(const f32x4*)(c_sample + (size_t)(16 * rb + li) * DM + k0 + 4 * kk));
#pragma unroll
        for (int b = 0; b < 2; ++b) cp[b] = silu4f(*(const f32x4*)(c_prompt + (size_t)b * DM + k0 + 4 * kk));
#pragma unroll
        for (int st = 0; st < 4; ++st) {
            acc[0] = __builtin_amdgcn_mfma_f32_16x16x4f32(cs[0][st], w[st], acc[0], 0, 0, 0);
            acc[1] = __builtin_amdgcn_mfma_f32_16x16x4f32(cs[1][st], w[st], acc[1], 0, 0, 0);
            pa[0] = fmaf(cp[0][st], w[st], pa[0]); pa[1] = fmaf(cp[1][st], w[st], pa[1]);
        }
    }
    const float bias = b_ada[(size_t)layer * MODW + c0 + li];
    float* Mo = MOD + (size_t)layer * NBATCH * MODW + c0 + li;
#pragma unroll
    for (int rb = 0; rb < 2; ++rb)
#pragma unroll
        for (int reg = 0; reg < 4; ++reg) Mo[(size_t)(2 + 16 * rb + 4 * kk + reg) * MODW] = acc[rb][reg] + bias;
#pragma unroll
    for (int b = 0; b < 2; ++b) { float v = pa[b]; v += __shfl_xor(v, 16); v += __shfl_xor(v, 32); if (kk == 0) Mo[(size_t)b * MODW] = v + bias; }
}
__device__ __forceinline__ void ada_item_wg(Frame& F, const float* w_ada, const float* b_ada, const float* c_prompt, const float* c_sample, float* MOD, int item, const Tid T) {
    const int lane = T.lane, wave = T.wave;
    const int layer = item / 576, c0 = (item % 576) * 16; const int li = lane & 15, kk = lane >> 4;
    const float* W = w_ada + (size_t)layer * DM * MODW + c0 + li;
    f32x4 acc[2]; float pa[2] = {0.f, 0.f};
    acc[0] = acc[1] = (f32x4){0.f, 0.f, 0.f, 0.f};
    const int kb = wave * 128;
    float w[8][4]; f32x4 cs[8][2], cp[8][2];
#pragma unroll
    for (int i = 0; i < 8; ++i) { const int k0 = kb + 16 * i;
#pragma unroll
        for (int st = 0; st < 4; ++st) w[i][st] = W[(size_t)(k0 + 4 * kk + st) * MODW];
#pragma unroll
        for (int rb = 0; rb < 2; ++rb) cs[i][rb] = *(const f32x4*)(c_sample + (size_t)(16 * rb + li) * DM + k0 + 4 * kk);
#pragma unroll
        for (int b = 0; b < 2; ++b) cp[i][b] = *(const f32x4*)(c_prompt + (size_t)b * DM + k0 + 4 * kk); }
    asm volatile("" ::: "memory");
#pragma unroll
    for (int i = 0; i < 8; ++i) { const f32x4 s0 = silu4f(cs[i][0]), s1 = silu4f(cs[i][1]), p0 = silu4f(cp[i][0]), p1 = silu4f(cp[i][1]);
#pragma unroll
        for (int st = 0; st < 4; ++st) {
            acc[0] = __builtin_amdgcn_mfma_f32_16x16x4f32(s0[st], w[i][st], acc[0], 0, 0, 0);
            acc[1] = __builtin_amdgcn_mfma_f32_16x16x4f32(s1[st], w[i][st], acc[1], 0, 0, 0);
            pa[0] = fmaf(p0[st], w[i][st], pa[0]); pa[1] = fmaf(p1[st], w[i][st], pa[1]);
        } }
    LAS float* red = (LAS float*)(F.lds + RING_OFF);
#pragma unroll
    for (int r = 0; r < 8; ++r) red[(wave * 10 + r) * 64 + lane] = acc[r >> 2][r & 3];
    red[(wave * 10 + 8) * 64 + lane] = pa[0]; red[(wave * 10 + 9) * 64 + lane] = pa[1];
    __syncthreads();
    const float bias = b_ada[(size_t)layer * MODW + c0 + li];
    float* Mo = MOD + (size_t)layer * NBATCH * MODW + c0 + li;
    { float s = 0.f;
#pragma unroll
      for (int ww = 0; ww < 8; ++ww) s += red[(ww * 10 + wave) * 64 + lane];
      Mo[(size_t)(2 + 16 * (wave >> 2) + 4 * kk + (wave & 3)) * MODW] = s + bias; }
    if (wave < 2) { float v = 0.f;
#pragma unroll
      for (int ww = 0; ww < 8; ++ww) v += red[(ww * 10 + 8 + wave) * 64 + lane];
      v += __shfl_xor(v, 16); v += __shfl_xor(v, 32); if (kk == 0) Mo[(size_t)wave * MODW] = v + bias; }
    __syncthreads();
}
__device__ __forceinline__ void titem_load(const float* W, int ldn, int nvalid, int sc0, int k0, int lane, f32x4 (&v)[8]) {
    const int rr = lane >> 3, c4 = 4 * (lane & 7); const bool ok = sc0 + c4 < nvalid;
    const float* src = W + (size_t)(k0 + rr) * ldn + sc0 + c4;
#pragma unroll
    for (int i = 0; i < 8; ++i) v[i] = ok ? *(const f32x4*)(src + (size_t)(8 * i) * ldn) : (f32x4){0.f, 0.f, 0.f, 0.f};
}
__device__ __forceinline__ void titem_store(const f32x4 (&v)[8], int K, bf16* WT, int n0, int k0, LAS float* scr, int lane) {
    const int rr = lane >> 3, c4 = 4 * (lane & 7);
#pragma unroll
    for (int i = 0; i < 8; ++i) { LAS float* d = scr + (8 * i + rr) * 33 + c4; d[0] = v[i][0]; d[1] = v[i][1]; d[2] = v[i][2]; d[3] = v[i][3]; }
    LDS_WAIT(); asm volatile("" ::: "memory");
    const int c = lane & 7;
#pragma unroll
    for (int j = 0; j < 4; ++j) { const int n = (lane >> 3) + 8 * j; const LAS float* s = scr + (8 * c) * 33 + n;
        v4u o; o.x = pk2(s[0 * 33], s[1 * 33]); o.y = pk2(s[2 * 33], s[3 * 33]); o.z = pk2(s[4 * 33], s[5 * 33]); o.w = pk2(s[6 * 33], s[7 * 33]);
        *(GAS v4u*)(WT + (size_t)(n0 + n) * K + k0 + 8 * c) = o; }
    LDS_WAIT(); asm volatile("" ::: "memory");
}
__device__ __forceinline__ int src_col_ffn(int nb) { const int p = 32 * nb, tile = p >> 8, w = p & 255; return w < 128 ? 128 * tile + w : DFF + 128 * tile + (w - 128); }
__device__ __forceinline__ int src_col_att(int nb) { const int p = 32 * nb, tile = p >> 8, w = p & 255; return 256 * tile + 64 * ((w >> 5) & 3) + 32 * (w >> 7); }
__device__ __forceinline__ int src_col_ccu(int nb) { const int p = 32 * nb, tile = p >> 8, w = p & 255; return w < 128 ? DM + 128 * tile + w : 2 * DM + 128 * tile + (w - 128); }

namespace wc {
constexpr int I_FI = 16 * 176, I_FO = 44 * 32, I_AI = 16 * 72, I_SQ = 16 * 32, I_CU = 16 * 64;
constexpr int OFF_FI = 0, OFF_FO = OFF_FI + 8 * I_FI, OFF_AI = OFF_FO + 8 * I_FO, OFF_AO = OFF_AI + 2 * I_AI, OFF_CU = OFF_AO + 2 * I_SQ, OFF_CB = OFF_CU + 2 * I_CU, OFF_CO = OFF_CB + 2 * I_SQ;
}
__device__ __forceinline__ void convert_set(Frame& F, int code, int w, int nw) {
    using namespace wc;
    const PArgs args = args_fresh(); const Tid T = tid_fresh();
    LAS float* scr = (LAS float*)(F.lds + RING_OFF + T.wave * 16384);
    int lo0, n0, lo1, n1, lo2 = 0, n2 = 0;
    if (code < 8) { lo0 = OFF_FI + code * I_FI; n0 = I_FI; lo1 = OFF_FO + code * I_FO; n1 = I_FO; }
    else if (code < 10) { const int li = code - 8; lo0 = OFF_AI + li * I_AI; n0 = I_AI; lo1 = OFF_AO + li * I_SQ; n1 = I_SQ; }
    else { const int li = code - 10; lo0 = OFF_CU + li * I_CU; n0 = I_CU; lo1 = OFF_CB + li * I_SQ; n1 = I_SQ; lo2 = OFF_CO + li * I_SQ; n2 = I_SQ; }
    const int ntot = n0 + n1 + n2;
    struct TD { const float* W; bf16* WT; int K, ldn, nvalid, n0, sc0, k0; };
    auto decode = [&](int v) __attribute__((always_inline)) -> TD {
        int r = v < n0 ? lo0 + v : (v < n0 + n1 ? lo1 + (v - n0) : lo2 + (v - n0 - n1)); TD t;
        if (r < 8 * I_FI) { const int s = r / I_FI, q = r % I_FI, nb = q % 176, kb = q / 176;
            t = TD{args.in(11) + (size_t)s * DM * NFFIN, WSP(bf16, WS_WFI) + (size_t)s * NFFIN * DM, DM, NFFIN, NFFIN, 32 * nb, src_col_ffn(nb), 64 * kb}; return t; } r -= 8 * I_FI;
        if (r < 8 * I_FO) { const int s = r / I_FO, q = r % I_FO, nb = q % 32, kb = q / 32;
            t = TD{args.in(12) + (size_t)s * DFF * DM, WSP(bf16, WS_WFO) + (size_t)s * DM * DFF, DFF, DM, DM, 32 * nb, 32 * nb, 64 * kb}; return t; } r -= 8 * I_FO;
        if (r < 2 * I_AI) { const int s = r / I_AI, q = r % I_AI, nb = q % 72, kb = q / 72;
            t = TD{args.in(13) + (size_t)s * DM * ATT_COLS, WSP(bf16, WS_WAI) + (size_t)s * ATT_NP * DM, DM, ATT_COLS, ATT_COLS, 32 * nb, src_col_att(nb), 64 * kb}; return t; } r -= 2 * I_AI;
        if (r < 2 * I_SQ) { const int s = r / I_SQ, q = r % I_SQ, nb = q % 32, kb = q / 32;
            t = TD{args.in(14) + (size_t)s * DM * DM, WSP(bf16, WS_WAO) + (size_t)s * DM * DM, DM, DM, DM, 32 * nb, 32 * nb, 64 * kb}; return t; } r -= 2 * I_SQ;
        if (r < 2 * I_CU) { const int s = r / I_CU, q = r % I_CU, nb = q % 64, kb = q / 64;
            t = TD{args.in(17) + (size_t)s * DM * 3 * DM, WSP(bf16, WS_WCU) + (size_t)s * 2 * DM * DM, DM, 3 * DM, 3 * DM, 32 * nb, src_col_ccu(nb), 64 * kb}; return t; } r -= 2 * I_CU;
        if (r < 2 * I_SQ) { const int s = r / I_SQ, q = r % I_SQ, nb = q % 32, kb = q / 32;
            t = TD{args.in(17) + (size_t)s * DM * 3 * DM, WSP(bf16, WS_WCB) + (size_t)s * DM * DM, DM, 3 * DM, 3 * DM, 32 * nb, 32 * nb, 64 * kb}; return t; } r -= 2 * I_SQ;
        { const int s = r / I_SQ, q = r % I_SQ, nb = q % 32, kb = q / 32;
            t = TD{args.in(19) + (size_t)s * DM * DM, WSP(bf16, WS_WCO) + (size_t)s * DM * DM, DM, DM, DM, 32 * nb, 32 * nb, 64 * kb}; return t; }
    };
    f32x4 va[8], vb[8], vc[8], vd[8];
    const int npair = (ntot + 1) >> 1;
#define CV_LOAD(P, X, Y) do { const TD t_ = decode(2 * (P)); titem_load(t_.W, t_.ldn, t_.nvalid, t_.sc0, t_.k0, T.lane, X); \
        if (2 * (P) + 1 < ntot) { const TD u_ = decode(2 * (P) + 1); titem_load(u_.W, u_.ldn, u_.nvalid, u_.sc0, u_.k0, T.lane, Y); } } while (0)
#define CV_STORE(P, X, Y) do { const TD t_ = decode(2 * (P)); titem_store(X, t_.K, t_.WT, t_.n0, t_.k0, scr, T.lane); \
        if (2 * (P) + 1 < ntot) { const TD u_ = decode(2 * (P) + 1); titem_store(Y, u_.K, u_.WT, u_.n0, u_.k0, scr, T.lane); } } while (0)
    if (w < npair) CV_LOAD(w, va, vb);
#pragma unroll 1
    for (int p = w; p < npair; p += 2 * nw) {
        const bool hb = p + nw < npair, hc = p + 2 * nw < npair;
        if (hb) CV_LOAD(p + nw, vc, vd);
        CV_STORE(p, va, vb);
        if (hc) CV_LOAD(p + 2 * nw, va, vb);
        if (hb) CV_STORE(p + nw, vc, vd);
    }
#undef CV_LOAD
#undef CV_STORE
}
__device__ __forceinline__ void convert_in_tail(Frame& F, int code, int first_idle) {
    if (code < 0 || (int)blockIdx.x < first_idle) return;
    const int wv = __builtin_amdgcn_readfirstlane((int)threadIdx.x >> 6);
    convert_set(F, code, ((int)blockIdx.x - first_idle) * NWAVES + wv, (F.G - first_idle) * NWAVES);
}

__device__ __forceinline__ void p0_prologue(Frame& F) {
    const PArgs args = args_fresh(); const Tid T = tid_fresh();
    const int gw = F.vcu * NWAVES + T.wave, NGW = F.G * NWAVES;
    if (gw < 2304) ada_item16(args.in(9), args.in(10), args.in(7), args.in(8), WSP(float, WS_MOD), gw, T.lane);
#pragma unroll 1
    for (int it = NGW + F.vcu; it < 2304; it += F.G) ada_item_wg(F, args.in(9), args.in(10), args.in(7), args.in(8), WSP(float, WS_MOD), it, tid_fresh());
#pragma unroll 1
    for (int k = 0; k < 3; ++k) { const int rot = k == 0 ? 0 : (k == 1 ? NGW - 128 : NGW - 64); convert_set(F, k == 0 ? 0 : (k == 1 ? 8 : 1), (gw + rot) % NGW, NGW); }
}

__device__ __forceinline__ void mod_phase(Frame& F, int layer, int which) {
    const PArgs args = args_fresh(); const Tid T = tid_fresh();
    const int gw = F.vcu * NWAVES + T.wave, NGW = F.G * NWAVES;
    float* X = WSP(float, WS_X); bf16* H = WSP(bf16, WS_H);
    const float* mod = WSP(float, WS_MOD) + (size_t)layer * NBATCH * MODW + which * 3 * DM;
    for (int m = gw; m < MROWS; m += NGW) {
        const float* mb = mod + (size_t)batch_of(m) * MODW + 4 * T.lane;
        f32x4 v[4]; float s = 0.f;
        const float* src = m < MP ? args.in(0) + (size_t)m * DM : (m < MVALID ? args.in(1) + (size_t)(m - MP) * DM : nullptr);
        f32x4 shv[4], scv[4];
#pragma unroll
        for (int j = 0; j < 4; ++j) { v[j] = src ? *(const f32x4*)(src + 4 * T.lane + 256 * j) : (f32x4){0.f, 0.f, 0.f, 0.f}; shv[j] = *(const f32x4*)(mb + 256 * j); scv[j] = *(const f32x4*)(mb + DM + 256 * j); }
        asm volatile("" ::: "memory");
#pragma unroll
        for (int j = 0; j < 4; ++j) { *(f32x4*)(X + (size_t)m * DM + 4 * T.lane + 256 * j) = v[j];
            s += (v[j][0] * v[j][0] + v[j][1] * v[j][1]) + (v[j][2] * v[j][2] + v[j][3] * v[j][3]); }
        const float rstd = __builtin_amdgcn_rsqf(wave_sum(s) * (1.f / DM) + RMS_EPS);
#pragma unroll
        for (int j = 0; j < 4; ++j) { const f32x4 sh = shv[j], sc = scv[j];
            const f32x4 h = v[j] * rstd * (sc + 1.f) + sh; v2u o; o.x = pk2(h[0], h[1]); o.y = pk2(h[2], h[3]);
            *(v2u*)(H + (size_t)m * DM + 4 * T.lane + 256 * j) = o; }
    }
}


namespace a1 {
constexpr int CAP = 768, NE = CAP / 64;
constexpr int KT = 128;
constexpr int LDS_KT = 0, LDS_BUF = 32768;
constexpr int LDS_CNT = LDS_BUF + 8 * 4 * CAP * 4;
typedef _Float16 h2 __attribute__((ext_vector_type(2)));
typedef _Float16 h8 __attribute__((ext_vector_type(8)));
typedef _Float16 h4 __attribute__((ext_vector_type(4)));
typedef float f32x8_t __attribute__((ext_vector_type(8)));
typedef short s16x4_t __attribute__((ext_vector_type(4)));
typedef short s16x8_t __attribute__((ext_vector_type(8)));
__device__ __forceinline__ unsigned pkh(float a, float b) { const h2 t = __builtin_convertvector((f32x2){a, b}, h2); return __builtin_bit_cast(unsigned, t); }
__device__ __forceinline__ int mbcnt64(unsigned long long m) { return (int)__builtin_amdgcn_mbcnt_hi((unsigned)(m >> 32), __builtin_amdgcn_mbcnt_lo((unsigned)m, 0u)); }

template <bool EXACT>
__device__ __forceinline__ unsigned compact(LAS unsigned* buf, int n, int lane, int& kept, LAS unsigned* dump) {
    unsigned e[NE]; unsigned mx = 0u, mn = 0xFFFFFFFFu;
#pragma unroll
    for (int j = 0; j < NE; ++j) { const int i = lane + 64 * j; const bool ok = i < n; e[j] = ok ? buf[i] : 0u; mx = max(mx, e[j]); mn = min(mn, ok ? e[j] : 0xFFFFFFFFu); }
#pragma unroll
    for (int o = 1; o < 64; o <<= 1) { mx = max(mx, (unsigned)__shfl_xor((int)mx, o)); mn = min(mn, (unsigned)__shfl_xor((int)mn, o)); }
    mx = __builtin_amdgcn_readfirstlane(mx); mn = __builtin_amdgcn_readfirstlane(mn);
    const int hb = 31 - __builtin_clz(mx ^ mn);
    const unsigned base = hb >= 31 ? 0u : (mx >> (hb + 1)) << (hb + 1);
    unsigned T = base; int cT = n; bool have = false;
    if (!EXACT) {
        const int ms = min(max(n, 0), 64) + min(max(n - 256, 0), 64) + min(max(n - 512, 0), 64);
        const int ks = max(1, (ms * 320) / n);
        unsigned Ts = base;
        for (int b = hb; b >= 0; --b) {
            const unsigned tr = Ts | (1u << b);
            const int c = __popcll(__ballot(e[0] >= tr)) + __popcll(__ballot(e[4] >= tr)) + __popcll(__ballot(e[8] >= tr));
            if (c >= ks) { Ts = tr; if (c == ks) break; }
        }
        int c = 0;
#pragma unroll
        for (int j = 0; j < NE; ++j) c += __popcll(__ballot(e[j] >= Ts));
        if (c >= TOPK) { T = Ts; cT = c; have = true; }
    }
    if (!have) {
        T = base; cT = n;
        for (int b = hb; b >= 0; --b) {
            const unsigned tr = T | (1u << b); int c = 0;
#pragma unroll
            for (int j = 0; j < NE; ++j) c += __popcll(__ballot(e[j] >= tr));
            if (c >= TOPK) { T = tr; cT = c; if (c == TOPK) break; }
        }
    }
    int bs = 0;
#pragma unroll
    for (int j = 0; j < NE; ++j) { const bool keep = e[j] >= T; const unsigned long long m = __ballot(keep); const int pos = bs + mbcnt64(m); LAS unsigned* d = keep ? buf + pos : dump; *d = e[j]; bs += __popcll(m); }
    kept = cT;
    return T;
}

__device__ __forceinline__ unsigned prune_given(LAS unsigned* buf, int n, int lane, int& kept, LAS unsigned* dump, unsigned Ts) {
    unsigned e[NE]; int c = 0;
#pragma unroll
    for (int j = 0; j < NE; ++j) { const int i = lane + 64 * j; e[j] = i < n ? buf[i] : 0u; }
#pragma unroll
    for (int j = 0; j < NE; ++j) c += __popcll(__ballot(e[j] >= Ts));
    if (c < TOPK || Ts == 0u) return compact<true>(buf, n, lane, kept, dump);
    int bs = 0;
#pragma unroll
    for (int j = 0; j < NE; ++j) { const bool keep = e[j] >= Ts; const unsigned long long m = __ballot(keep); const int pos = bs + mbcnt64(m); LAS unsigned* d = keep ? buf + pos : dump; *d = e[j]; bs += __popcll(m); }
    kept = c;
    return Ts;
}
constexpr int PRUNE_MIN = 448;
__device__ __forceinline__ void prune4(LAS unsigned* mybuf, int lane, int hi, int& cntA, int& cntB, unsigned& tauA, unsigned& tauB, LAS unsigned* dump) {
    int n[4]; n[0] = __builtin_amdgcn_readlane(cntA, 0); n[1] = __builtin_amdgcn_readlane(cntB, 0); n[2] = __builtin_amdgcn_readlane(cntA, 32); n[3] = __builtin_amdgcn_readlane(cntB, 32);
    unsigned s0[4], s1[4], s2[4], Ts[4]; int ks[4]; bool done[4];
#pragma unroll
    for (int q = 0; q < 4; ++q) { const bool act = n[q] > PRUNE_MIN; LAS unsigned* b = mybuf + q * CAP; const int nn = act ? n[q] : 0;
        s0[q] = lane < nn ? b[lane] : 0u; s1[q] = lane + 256 < nn ? b[lane + 256] : 0u; s2[q] = lane + 512 < nn ? b[lane + 512] : 0u;
        const int ms = min(nn, 64) + min(max(nn - 256, 0), 64) + min(max(nn - 512, 0), 64);
        ks[q] = act ? max(1, (ms * 320) / nn) : 0; Ts[q] = 0u; done[q] = !act; }
#pragma unroll 1
    for (int b = 31; b >= 13; --b) {
#pragma unroll
        for (int q = 0; q < 4; ++q) { const unsigned tr = Ts[q] | (1u << b);
            const int c = __popcll(__ballot(s0[q] >= tr)) + __popcll(__ballot(s1[q] >= tr)) + __popcll(__ballot(s2[q] >= tr));
            const bool take = !done[q] && c >= ks[q]; Ts[q] = take ? tr : Ts[q]; done[q] = done[q] || (take && c == ks[q]); }
        if (done[0] && done[1] && done[2] && done[3]) break;
    }
#pragma unroll
    for (int q = 0; q < 4; ++q) if (n[q] > PRUNE_MIN) { int kept; unsigned T = prune_given(mybuf + q * CAP, n[q], lane, kept, dump, Ts[q]);
        if (kept > CAP - 128) T = compact<true>(mybuf + q * CAP, kept, lane, kept, dump);
        if (hi == (q >> 1)) { if (q & 1) { cntB = kept; tauB = T; } else { cntA = kept; tauA = T; } } }
}

__device__ __forceinline__ void prompt_unit(Frame& F, int b, int blk) {
    const PArgs args = args_fresh(); const Tid TI = tid_fresh();
    LAS unsigned char* lds = F.lds;
    const int tid = TI.tid, lane = TI.lane, wave = TI.wave, r = lane & 31, hi = lane >> 5;
    const int q0 = blk * 32, qw = q0 + 4 * wave; const size_t rowbase = (size_t)b * SEQ;
    const bf16* QIb = WSP(bf16, WS_QI); const bf16* KIb = WSP(bf16, WS_KI); const float* WIb = WSP(float, WS_WI);
    const bf16* Qb = WSP(bf16, WS_Q); const bf16* Kb = WSP(bf16, WS_K); const bf16* Vb = WSP(bf16, WS_V); bf16* Ob = WSP(bf16, WS_O);
    bf16x8 qa[4];
    { const int ri = r & 3, rh = (r >> 2) & 1, rg = r >> 3, aq = 2 * rh + (rg >> 1), ah = 4 * (rg & 1) + ri;
      const bf16* p = QIb + (rowbase + qw + aq) * IQW + ah * 64 + 8 * hi;
#pragma unroll
      for (int s = 0; s < 4; ++s) qa[s] = *(const bf16x8*)(p + 16 * s); }
    float wA[8], wB[8];
    { const float* p = WIb + (rowbase + qw + 2 * hi) * 8; const f32x4 a0 = *(const f32x4*)p, a1 = *(const f32x4*)(p + 4), b0 = *(const f32x4*)(p + 8), b1 = *(const f32x4*)(p + 12);
#pragma unroll
      for (int i = 0; i < 4; ++i) { wA[i] = a0[i]; wA[4 + i] = a1[i]; wB[i] = b0[i]; wB[4 + i] = b1[i]; } }
    LAS unsigned* mybuf = (LAS unsigned*)(lds + LDS_BUF) + wave * 4 * CAP;
    LAS unsigned* bufA = mybuf + (2 * hi) * CAP; LAS unsigned* bufB = bufA + CAP;
    int cntA = 0, cntB = 0; unsigned tauA = 0u, tauB = 0u;
#ifndef PROBE_SC
#define PROBE_SC 1
#endif
#pragma unroll 1
    for (int rep_sc = 0; rep_sc < PROBE_SC; ++rep_sc) { cntA = 0; cntB = 0; tauA = 0u; tauB = 0u;
    const int qposA = qw + 2 * hi, qposB = qposA + 1;
    const int ntile = (q0 + 31) / KT + 1;
    const char* kbase = (const char*)(KIb + rowbase * IDIM);
    const int so0 = 16 * tid, so1 = so0 + 8192;
    const int sd0 = (so0 >> 7) * 128 + ((((so0 >> 4) & 7) ^ ((so0 >> 8) & 7)) << 4), sd1 = (so1 >> 7) * 128 + ((((so1 >> 4) & 7) ^ ((so1 >> 8) & 7)) << 4);
    auto compute_tile = [&](int t) __attribute__((always_inline)) {
        LAS unsigned char* kt = lds + LDS_KT + (t & 1) * 16384;
        LAS unsigned* flg = (LAS unsigned*)(lds + LDS_CNT + 128);
        const unsigned fl = flg[(t + 2) % 3];
        if (tid == 0) flg[(t + 1) % 3] = 0u;
        if (__builtin_amdgcn_readfirstlane(fl) != 0u) prune4(mybuf, lane, hi, cntA, cntB, tauA, tauB, (LAS unsigned*)(lds + LDS_CNT) + wave);
        if (t * KT > qw + 3) return;
        bf16x8 kf[4][4];
#pragma unroll
        for (int sub = 0; sub < 4; ++sub) { const int key = 32 * sub + r;
#pragma unroll
            for (int s = 0; s < 4; ++s) kf[sub][s] = *(const LAS bf16x8*)(kt + key * 128 + ((((2 * s + hi) ^ ((key >> 1) & 7))) << 4)); }
        f32x16 D[4];
#pragma unroll
        for (int sub = 0; sub < 4; ++sub) D[sub] = (f32x16){};
#pragma unroll
        for (int s = 0; s < 4; ++s)
#pragma unroll
            for (int sub = 0; sub < 4; ++sub) D[sub] = __builtin_amdgcn_mfma_f32_32x32x16_bf16(qa[s], kf[sub][s], D[sub], 0, 0, 0);
        unsigned uA[4], uB[4];
#pragma unroll
        for (int sub = 0; sub < 4; ++sub) {
            float sA = 0.f, sB = 0.f;
#pragma unroll
            for (int i = 0; i < 8; ++i) {
                const float ra = __int_as_float(max(__float_as_int(D[sub][i]), 0)), rb = __int_as_float(max(__float_as_int(D[sub][8 + i]), 0));
                sA = fmaf(wA[i], ra, sA); sB = fmaf(wB[i], rb, sB); }
            const int kidx = t * KT + 32 * sub + r; const unsigned ipart = (unsigned)(8191 - kidx);
            unsigned a = __float_as_uint(sA), b2 = __float_as_uint(sB);
            a ^= (unsigned)(((int)a >> 31) | (int)0x80000000); b2 ^= (unsigned)(((int)b2 >> 31) | (int)0x80000000);
            a = (a & 0xFFFFE000u) | ipart; b2 = (b2 & 0xFFFFE000u) | ipart;
            uA[sub] = kidx <= qposA ? a : 0u; uB[sub] = kidx <= qposB ? b2 : 0u;
        }
        LAS unsigned* dump = (LAS unsigned*)(lds + LDS_CNT) + wave;
#pragma unroll
        for (int sub = 0; sub < 4; ++sub) {
            const bool pA = uA[sub] > tauA, pB = uB[sub] > tauB;
            const unsigned long long mA = __builtin_amdgcn_ballot_w64(pA), mB = __builtin_amdgcn_ballot_w64(pB);
            const int loA = __popc((unsigned)mA), loB = __popc((unsigned)mB), hiA = __popc((unsigned)(mA >> 32)), hiB = __popc((unsigned)(mB >> 32));
            const int preA = mbcnt64(mA) - (hi ? loA : 0), preB = mbcnt64(mB) - (hi ? loB : 0);
            LAS unsigned* dA = pA ? bufA + cntA + preA : dump; LAS unsigned* dB = pB ? bufB + cntB + preB : dump;
            *dA = uA[sub]; *dB = uB[sub];
            cntA += hi ? hiA : loA; cntB += hi ? hiB : loB;
        }
        if (__builtin_amdgcn_ballot_w64(cntA > CAP - 128 || cntB > CAP - 128) != 0ull) { if (lane == 0) flg[t % 3] = 1u; }
    };
    v4u pa0, pa1, pb0, pb1;
    pa0 = *(const v4u*)(kbase + so0); pa1 = *(const v4u*)(kbase + so1);
    *(LAS v4u*)(lds + LDS_KT + sd0) = pa0; *(LAS v4u*)(lds + LDS_KT + sd1) = pa1;
    pb0 = pa0; pb1 = pa1;
    if (tid < 3) ((LAS unsigned*)(lds + LDS_CNT + 128))[tid] = 0u;
    if (ntile > 1) { pb0 = *(const v4u*)(kbase + 16384 + so0); pb1 = *(const v4u*)(kbase + 16384 + so1); }
    __syncthreads();
#pragma unroll 1
    for (int t = 0; t < ntile; t += 2) {
        if (t + 2 < ntile) { pa0 = *(const v4u*)(kbase + (size_t)(t + 2) * 16384 + so0); pa1 = *(const v4u*)(kbase + (size_t)(t + 2) * 16384 + so1); }
        compute_tile(t);
        if (t + 1 < ntile) { *(LAS v4u*)(lds + LDS_KT + 16384 + sd0) = pb0; *(LAS v4u*)(lds + LDS_KT + 16384 + sd1) = pb1; }
        __syncthreads();
        if (t + 1 < ntile) {
            if (t + 3 < ntile) { pb0 = *(const v4u*)(kbase + (size_t)(t + 3) * 16384 + so0); pb1 = *(const v4u*)(kbase + (size_t)(t + 3) * 16384 + so1); }
            compute_tile(t + 1);
            if (t + 2 < ntile) { *(LAS v4u*)(lds + LDS_KT + sd0) = pa0; *(LAS v4u*)(lds + LDS_KT + sd1) = pa1; }
            __syncthreads();
        }
    }
    }
    unsigned short* IDXg = WSP(unsigned short, WS_IDX); int* NSELg = WSP(int, WS_NSEL);
#pragma unroll
    for (int qq = 0; qq < 4; ++qq) { int n = __builtin_amdgcn_readlane((qq & 1) ? cntB : cntA, (qq >> 1) * 32);
        if (n > TOPK) { int kept; (void)compact<true>(mybuf + qq * CAP, n, lane, kept, (LAS unsigned*)(lds + LDS_CNT) + wave); n = TOPK; }
        const v4u e4 = *(const LAS v4u*)(mybuf + qq * CAP + 4 * lane);
        v2u o;
        { const unsigned i0 = 4 * lane < n ? 8191u - (e4.x & 8191u) : 0u, i1 = 4 * lane + 1 < n ? 8191u - (e4.y & 8191u) : 0u, i2 = 4 * lane + 2 < n ? 8191u - (e4.z & 8191u) : 0u, i3 = 4 * lane + 3 < n ? 8191u - (e4.w & 8191u) : 0u;
          o.x = i0 | (i1 << 16); o.y = i2 | (i3 << 16); }
        const size_t row = rowbase + qw + qq;
        *(v2u*)(IDXg + row * TOPK + 4 * lane) = o;
        if (lane == 0) NSELg[row] = n; }
    LDS_WAIT();
    __syncthreads();
}

__device__ __forceinline__ void attend_wave(Frame& F, int b, int g, int t0) {
    const PArgs args = args_fresh(); const Tid TI = tid_fresh();
    const int lane = TI.lane, wave = TI.wave;
    const bf16* Qb = WSP(bf16, WS_Q); const bf16* Kb = WSP(bf16, WS_K); const bf16* Vb = WSP(bf16, WS_V); bf16* Ob = WSP(bf16, WS_O);
    const unsigned short* IDXg = WSP(unsigned short, WS_IDX); const int* NSELg = WSP(int, WS_NSEL);
    LAS unsigned char* Ks = F.lds + wave * 16384;
    LAS unsigned char* Vs = Ks + 8192;
    const size_t rowbase = (size_t)b * SEQ;
    const bf16* Kg = Kb + (size_t)(b * 4 + g) * SEQ * 64; const bf16* Vg = Vb + (size_t)(b * 4 + g) * SEQ * 64;
#define AT_KIDX(K, H, G) ((int)((K[H][((G) & 7) >> 1] >> (16 * ((G) & 1))) & 0xffffu))
#define AT_GATHER(K, BASE, C, dst) do { _Pragma("unroll") for (int i_ = 0; i_ < 8; ++i_) dst[i_] = *(const v4u*)((const char*)(BASE) + (unsigned)(AT_KIDX(K, i_ & 1, 4 * (C) + (i_ >> 1)) * 128 + 16 * (c8 ^ ks))); } while (0)
    v4u kA[2], kB[2], nA[2], nB[2]; bf16x8 bq0 = {}, bq1 = {}, bqn0 = {}, bqn1 = {};
    v4u kr[2][8], vr[2][8];
    { const int j = lane & 15, fq = lane >> 4, ks = lane >> 3, c8 = lane & 7; const size_t row = rowbase + t0;
#pragma unroll
      for (int h = 0; h < 2; ++h) { kA[h] = *(const v4u*)(IDXg + row * TOPK + 16 * (8 * h + ks)); kB[h] = *(const v4u*)(IDXg + row * TOPK + 16 * (8 * h + ks) + 8); }
      if (j < 4) { const bf16* qp = Qb + row * DM + (4 * g + j) * 64 + 8 * fq; bq0 = *(const bf16x8*)qp; bq1 = *(const bf16x8*)(qp + 32); }
      AT_GATHER(kA, Kg, 0, kr[0]); AT_GATHER(kA, Kg, 1, kr[1]); }
#pragma unroll 1
    for (int qi = 0; qi < 32; ++qi) {
        int lq = lane; asm volatile("" : "+v"(lq));
        const int j = lq & 15, fq = lq >> 4, ks = lq >> 3, c8 = lq & 7;
        const size_t row = rowbase + t0 + qi; const int nsel = NSELg[row];
        const size_t rown = rowbase + t0 + min(qi + 1, 31);
        f32x4 lg[16];
#pragma unroll
        for (int C = 0; C < 4; ++C) {
#pragma unroll
            for (int i = 0; i < 8; ++i) *(LAS v4u*)(Ks + (8 * i + ks) * 128 + c8 * 16) = kr[C & 1][i];
            if (C + 2 < 4) AT_GATHER(kB, Kg, C + 2, kr[C & 1]);
            if (C == 2) AT_GATHER(kA, Vg, 0, vr[0]);
            if (C == 3) AT_GATHER(kA, Vg, 1, vr[1]);
#pragma unroll
            for (int gg = 0; gg < 4; ++gg) { const int G = 4 * C + gg; const int rr = 16 * gg + j;
                const bf16x8 a0 = *(const LAS bf16x8*)(Ks + rr * 128 + ((fq ^ (j & 7)) << 4)), a1 = *(const LAS bf16x8*)(Ks + rr * 128 + (((4 + fq) ^ (j & 7)) << 4));
                f32x4 acc = {0.f, 0.f, 0.f, 0.f};
                acc = __builtin_amdgcn_mfma_f32_16x16x32_bf16(a0, bq0, acc, 0, 0, 0);
                acc = __builtin_amdgcn_mfma_f32_16x16x32_bf16(a1, bq1, acc, 0, 0, 0);
                lg[G] = acc; }
        }
#pragma unroll
        for (int h = 0; h < 2; ++h) { nA[h] = *(const v4u*)(IDXg + rown * TOPK + 16 * (8 * h + ks)); nB[h] = *(const v4u*)(IDXg + rown * TOPK + 16 * (8 * h + ks) + 8); }
        if (j < 4) { const bf16* qp = Qb + rown * DM + (4 * g + j) * 64 + 8 * fq; bqn0 = *(const bf16x8*)qp; bqn1 = *(const bf16x8*)(qp + 32); }
        if (nsel < TOPK) {
#pragma unroll
            for (int G = 0; G < 16; ++G)
#pragma unroll
                for (int reg = 0; reg < 4; ++reg) if (16 * (4 * fq + reg) + G >= nsel) lg[G][reg] = -INFINITY;
        }
        float mx = -INFINITY, mx2 = -INFINITY;
#pragma unroll
        for (int G = 0; G < 16; ++G) { mx = fmaxf(fmaxf(mx, lg[G][0]), lg[G][1]); mx2 = fmaxf(fmaxf(mx2, lg[G][2]), lg[G][3]); }
        mx = fmaxf(mx, mx2);
        mx = fmaxf(mx, __shfl_xor(mx, 16)); mx = fmaxf(mx, __shfl_xor(mx, 32));
        h8 pb[8];
#pragma unroll
        for (int kk = 0; kk < 8; ++kk) { f32x8_t pv;
#pragma unroll
            for (int e = 0; e < 8; ++e) pv[e] = __builtin_amdgcn_exp2f(lg[2 * kk + (e >> 2)][e & 3] - mx);
            pb[kk] = __builtin_convertvector(pv, h8); }
        f32x4 osum = (f32x4){0.f, 0.f, 0.f, 0.f};
        { const _Float16 one = (_Float16)1.0f; h8 ones = {one, one, one, one, one, one, one, one}; asm volatile("" : "+v"(ones));
#pragma unroll
          for (int kk = 0; kk < 8; ++kk) osum = __builtin_amdgcn_mfma_f32_16x16x32_f16(ones, pb[kk], osum, 0, 0, 0); }
        f32x4 oacc[4];
#pragma unroll
        for (int db = 0; db < 4; ++db) oacc[db] = (f32x4){0.f, 0.f, 0.f, 0.f};
        const int tq_ = (lq >> 2) & 3, tp_ = lq & 3;
#pragma unroll
        for (int C = 0; C < 4; ++C) {
#pragma unroll
            for (int i = 0; i < 8; ++i) *(LAS v4u*)(Vs + (8 * i + ks) * 128 + c8 * 16) = vr[C & 1][i];
            if (C + 2 < 4) AT_GATHER(kB, Vg, C + 2, vr[C & 1]);
#pragma unroll
            for (int st = 0; st < 2; ++st) {
#pragma unroll
                for (int db = 0; db < 4; ++db) {
                    const int r0 = 16 * (2 * st) + 4 * fq + tq_, r1 = r0 + 16; const int ch = 2 * db + (tp_ >> 1);
                    const s16x4_t t0 = __builtin_amdgcn_ds_read_tr16_b64_v4i16((LAS s16x4_t*)(Vs + r0 * 128 + ((ch ^ (r0 & 7)) << 4) + 8 * (tp_ & 1)));
                    const s16x4_t t1 = __builtin_amdgcn_ds_read_tr16_b64_v4i16((LAS s16x4_t*)(Vs + r1 * 128 + ((ch ^ (r1 & 7)) << 4) + 8 * (tp_ & 1)));
                    const h8 va = __builtin_bit_cast(h8, (s16x8_t){t0[0], t0[1], t0[2], t0[3], t1[0], t1[1], t1[2], t1[3]});
                    oacc[db] = __builtin_amdgcn_mfma_f32_16x16x32_f16(va, pb[2 * C + st], oacc[db], 0, 0, 0);
                }
            }
            if (C == 0) { AT_GATHER(nA, Kg, 0, kr[0]); AT_GATHER(nA, Kg, 1, kr[1]); }
        }
        if (j < 4) { const float inv = 1.f / osum[0];
#pragma unroll
            for (int db = 0; db < 4; ++db) { v2u w; w.x = pk2(oacc[db][0] * inv, oacc[db][1] * inv); w.y = pk2(oacc[db][2] * inv, oacc[db][3] * inv);
                *(v2u*)(Ob + row * DM + (4 * g + j) * 64 + 16 * db + 4 * fq) = w; }
        }
        LDS_WAIT(); asm volatile("" ::: "memory");
#pragma unroll
        for (int h = 0; h < 2; ++h) { kA[h] = nA[h]; kB[h] = nB[h]; }
        bq0 = bqn0; bq1 = bqn1;
    }
#undef AT_GATHER
#undef AT_KIDX
}

__device__ __forceinline__ void sample_unit(Frame& F, int li, int s) {
    const PArgs args = args_fresh(); const Tid TI = tid_fresh();
    LAS unsigned char* lds = F.lds; const int tid = TI.tid, lane = TI.lane, wave = TI.wave;
    LAS float* qi = (LAS float*)lds;
    LAS float* qs = qi + 512;
    LAS int* sel = (LAS int*)(qs + 1024);
    LAS float* lg = (LAS float*)(sel + 256);
    LAS int* cnt3 = (LAS int*)(lg + 4096);
    LAS int* cw = cnt3 + 4;
    const int row = MP + s;
    const bf16* QIb = WSP(bf16, WS_QI); const bf16* Qb = WSP(bf16, WS_Q); const float* WIb = WSP(float, WS_WI); bf16* Ob = WSP(bf16, WS_O);
    const float* ckidx = args.in(4) + (size_t)li * NPOOL * PAGE * IDIM; const float* ck = args.in(2) + (size_t)li * NPOOL * PAGE * KVW; const float* cv = args.in(3) + (size_t)li * NPOOL * PAGE * KVW;
    const int* pt = (const int*)args.in(6) + s * NPG;
    const float* nk = args.out() + O_KS + ((size_t)li * NS + s) * KVW; const float* nv = args.out() + O_VS + ((size_t)li * NS + s) * KVW; const float* nki = args.out() + O_KIS + ((size_t)li * NS + s) * IDIM;
    { const bf16 v = QIb[(size_t)row * IQW + tid]; qi[tid] = __uint_as_float((unsigned)v << 16); }
    { const bf16 v0 = Qb[(size_t)row * DM + tid], v1 = Qb[(size_t)row * DM + 512 + tid]; qs[tid] = __uint_as_float((unsigned)v0 << 16); qs[512 + tid] = __uint_as_float((unsigned)v1 << 16); }
    if (tid < 4) cnt3[tid] = 0;
    float wv[8];
#pragma unroll
    for (int h = 0; h < 8; ++h) wv[h] = WIb[(size_t)row * 8 + h];
    __syncthreads();
    unsigned long long keys[17];
#pragma unroll
    for (int j = 0; j < 17; ++j) {
        const int kidx = tid + 512 * j;
        if (kidx <= SEQ) {
            const float* kp = kidx < SEQ ? ckidx + ((size_t)pt[kidx >> 7] * PAGE + (kidx & 127)) * IDIM : nki;
            float acc[8];
#pragma unroll
            for (int h = 0; h < 8; ++h) acc[h] = 0.f;
            f32x4 kv[16];
#pragma unroll
            for (int d = 0; d < 16; ++d) kv[d] = *(const f32x4*)(kp + 4 * d);
            asm volatile("" ::: "memory");
#pragma unroll
            for (int d = 0; d < 64; d += 4) { const f32x4 k4 = kv[d >> 2];
#pragma unroll
                for (int h = 0; h < 8; ++h) { const f32x4 q4 = *(const LAS f32x4*)(qi + h * 64 + d); acc[h] += (q4[0] * k4[0] + q4[1] * k4[1]) + (q4[2] * k4[2] + q4[3] * k4[3]); } }
            float sc = 0.f;
#pragma unroll
            for (int h = 0; h < 8; ++h) sc = fmaf(wv[h], fmaxf(acc[h], 0.f), sc);
            unsigned u = __float_as_uint(sc); u ^= (u >> 31) ? 0xFFFFFFFFu : 0x80000000u;
            keys[j] = ((unsigned long long)u << 32) | (unsigned long long)(0xFFFFFFFFu - (unsigned)kidx);
        } else keys[j] = 0ull;
    }
    unsigned long long T = 0ull;
#pragma unroll 1
    for (int step = 0; step < 46; ++step) {
        const int bit = step < 32 ? 63 - step : 45 - step;
        if (step == 32) T |= 0xFFFFC000ull;
        const unsigned long long tr = T | (1ull << bit); int c = 0;
#pragma unroll
        for (int j = 0; j < 17; ++j) c += __popcll(__ballot(keys[j] >= tr));
        if (lane == 0) atomicAdd((int*)&cnt3[step % 3], c);
        __syncthreads();
        if (cnt3[step % 3] >= TOPK) T = tr;
        if (tid == 0) cnt3[(step + 2) % 3] = 0;
    }
#pragma unroll
    for (int j = 0; j < 17; ++j) { const int c = __popcll(__ballot(keys[j] >= T)); if (lane == 0) cw[j * 8 + wave] = c; }
    __syncthreads();
    if (tid == 0) { int run = 0; for (int i = 0; i < 136; ++i) { const int c = cw[i]; cw[i] = run; run += c; } }
    __syncthreads();
#pragma unroll
    for (int j = 0; j < 17; ++j) { const bool keep = keys[j] >= T; const unsigned long long m = __ballot(keep); if (keep) { const int pos = cw[j * 8 + wave] + mbcnt64(m); if (pos < TOPK) sel[pos] = tid + 512 * j; } }
    __syncthreads();
    LAS int* phys = cw + 144;
    if (tid < TOPK) { const int idx = sel[tid]; phys[tid] = idx < SEQ ? pt[idx >> 7] * PAGE + (idx & 127) : -1; }
    __syncthreads();
#pragma unroll
    for (int ii = 0; ii < 2; ++ii) {
        const int it = tid + 512 * ii;
        const int n = it & 255, kvh = it >> 8; const int pr = phys[n];
        const float* kp = pr >= 0 ? ck + (size_t)pr * KVW + kvh * 64 : nk + kvh * 64;
        f32x4 k4[16];
#pragma unroll
        for (int d = 0; d < 16; ++d) k4[d] = *(const f32x4*)(kp + 4 * d);
        float acc[4] = {0.f, 0.f, 0.f, 0.f};
#pragma unroll
        for (int d = 0; d < 16; ++d) {
#pragma unroll
            for (int i = 0; i < 4; ++i) { const f32x4 q4 = *(const LAS f32x4*)(qs + (4 * kvh + i) * 64 + 4 * d); acc[i] += (q4[0] * k4[d][0] + q4[1] * k4[d][1]) + (q4[2] * k4[d][2] + q4[3] * k4[d][3]); } }
#pragma unroll
        for (int i = 0; i < 4; ++i) lg[(4 * kvh + i) * 256 + n] = acc[i];
    }
    __syncthreads();
#pragma unroll
    for (int hh = 0; hh < 2; ++hh) { LAS float* l = lg + (2 * wave + hh) * 256; float v[4]; float mx = -INFINITY;
#pragma unroll
        for (int i = 0; i < 4; ++i) { v[i] = l[lane + 64 * i]; mx = fmaxf(mx, v[i]); }
        mx = wave_max(mx); float sum = 0.f;
#pragma unroll
        for (int i = 0; i < 4; ++i) { v[i] = __builtin_amdgcn_exp2f(v[i] - mx); sum += v[i]; }
        sum = wave_sum(sum); const float inv = 1.f / sum;
#pragma unroll
        for (int i = 0; i < 4; ++i) l[lane + 64 * i] = v[i] * inv; }
    __syncthreads();
    { const int hd = tid >> 5, dp = tid & 31, kvh = hd >> 2; float o0 = 0.f, o1 = 0.f;
#pragma unroll 1
      for (int n0 = 0; n0 < TOPK; n0 += 16) {
          f32x2 v[16];
#pragma unroll
          for (int k = 0; k < 16; ++k) { const int pr = phys[n0 + k]; const float* vp = pr >= 0 ? cv + (size_t)pr * KVW + kvh * 64 : nv + kvh * 64; v[k] = *(const f32x2*)(vp + 2 * dp); }
#pragma unroll
          for (int k = 0; k < 16; ++k) { const float p = lg[hd * 256 + n0 + k]; o0 = fmaf(p, v[k][0], o0); o1 = fmaf(p, v[k][1], o1); } }
      *(unsigned*)(Ob + (size_t)row * DM + hd * 64 + 2 * dp) = pk2(o0, o1); }
    __syncthreads();
}
}

#ifndef MK_SINGLE
#define MK_SINGLE 1
#endif
#ifndef EN_MASK
#define EN_MASK 0xFFFF
#endif
#define EN(b) ((EN_MASK >> (b)) & 1)
constexpr int N_PHASES = 32;
template <int NB, int NSTEPS, class Fn>
__device__ __forceinline__ float small_item(Frame& F, const bf16* A, int K, const bf16* W0, const bf16* W1, Fn fn) {
    const Tid T = tid_fresh(); const int lane = T.lane, wave = T.wave;
    const int kper = K >> 3, kbeg = wave * kper; constexpr int nsteps = NSTEPS;
    const bf16* ap = A + (size_t)(lane & 15) * K + 8 * (lane >> 4) + kbeg;
    const bf16* wp0 = W0 + (size_t)(lane & 15) * K + 8 * (lane >> 4) + kbeg;
    const bf16* wp1 = (NB == 2 ? W1 : W0) + (size_t)(lane & 15) * K + 8 * (lane >> 4) + kbeg;
    f32x4 d[NB][2];
#pragma unroll
    for (int nb = 0; nb < NB; ++nb) { d[nb][0] = (f32x4){0.f, 0.f, 0.f, 0.f}; d[nb][1] = d[nb][0]; }
    bf16x8 av0[nsteps], av1[nsteps], wv0[nsteps], wv1[NB == 2 ? nsteps : 1];
#pragma unroll
    for (int s = 0; s < nsteps; ++s) { av0[s] = *(const bf16x8*)(ap + 32 * s); av1[s] = *(const bf16x8*)(ap + (size_t)16 * K + 32 * s); wv0[s] = *(const bf16x8*)(wp0 + 32 * s);
        if constexpr (NB == 2) wv1[s] = *(const bf16x8*)(wp1 + 32 * s); }
    asm volatile("" ::: "memory");
#pragma unroll
    for (int s = 0; s < nsteps; ++s) {
        d[0][0] = __builtin_amdgcn_mfma_f32_16x16x32_bf16(wv0[s], av0[s], d[0][0], 0, 0, 0); d[0][1] = __builtin_amdgcn_mfma_f32_16x16x32_bf16(wv0[s], av1[s], d[0][1], 0, 0, 0);
        if constexpr (NB == 2) { d[1][0] = __builtin_amdgcn_mfma_f32_16x16x32_bf16(wv1[s], av0[s], d[1][0], 0, 0, 0); d[1][1] = __builtin_amdgcn_mfma_f32_16x16x32_bf16(wv1[s], av1[s], d[1][1], 0, 0, 0); }
    }
    LAS float* red = (LAS float*)(F.lds + RING_OFF);
#pragma unroll
    for (int nb = 0; nb < NB; ++nb)
#pragma unroll
        for (int f = 0; f < 2; ++f)
#pragma unroll
            for (int r = 0; r < 4; ++r) red[((wave * NB + nb) * 8 + f * 4 + r) * 64 + lane] = d[nb][f][r];
    __syncthreads();
    { const int i = wave, f = i >> 2, r = i & 3; float v[NB];
#pragma unroll
      for (int nb = 0; nb < NB; ++nb) { float s = 0.f;
#pragma unroll
          for (int w = 0; w < 8; ++w) s += red[((w * NB + nb) * 8 + i) * 64 + lane];
          v[nb] = s; }
      const float ret = fn((lane & 15) + 16 * f, 4 * (lane >> 4) + r, v[0], v[NB - 1]);
      __syncthreads();
      return ret; }
}
template <class Epi>
__device__ __forceinline__ void run_gemm(Frame& F, const bf16* A, const bf16* Bt, int M, int N, int K, const Epi E) {
    pg8::Gemm g{A, Bt, M, N, K}; pg8::StaticOrder S; S.init(M, N, F.G, (int)blockIdx.x);
    pg8::gemm_phase<Epi, pg8::StaticOrder, true, true>(F.lds + RING_OFF, g, S, E);
}

__global__ void __launch_bounds__(NWAVES * 64, 2) mega_fwd(Args kargs) {
    extern __shared__ __attribute__((aligned(16))) unsigned char lds_raw[];
    Frame F;
    F.lds = (LAS unsigned char*)lds_raw;
    F.MISC = (volatile LAS unsigned*)(F.lds + MISC_OFF);
    F.G = gridDim.x; { const int bx = blockIdx.x; F.vcu = (F.G % 8 == 0) ? (bx % 8) * (F.G / 8) + bx / 8 : bx; }
    for (int u = threadIdx.x; u < (LDS_BYTES - LDSCTL_OFF) / 4; u += NWAVES * 64) ((LAS unsigned*)(F.lds + LDSCTL_OFF))[u] = 0u;
    __syncthreads();
    const int lo = kargs.ph_lo, hi = kargs.ph_hi;
    unsigned* const barw = (unsigned*)(kargs.ws + WS_CTL) + CW_BAR;
    XcdBarrier bar; bar.bar = barw; bar.x = 0; bar.st = nullptr;
    if (hi - lo > 1) bar = xcd_barrier_post(barw, F.MISC + 8);
    int ph = 0;
#define PH_ON() (ph >= lo && ph < hi)
#define PH_END() do { if (ph >= lo && ph + 1 < hi) xcd_barrier(bar); ++ph; } while (0)

#ifndef PROBE_P0
#define PROBE_P0 1
#endif
    if (EN(0) && PH_ON()) { for (int rep = 0; rep < PROBE_P0; ++rep) p0_prologue(F); }
    PH_END();

#pragma unroll 1
    for (int j = 0; j < 12; ++j) {
        const int layer = j / 3, kind = j - 3 * layer, li = layer >> 1; const bool is_attn = (layer & 1) == 0;
#ifndef PROBE_MOD
#define PROBE_MOD 1
#endif
        if (j == 0) { if (EN(1) && PH_ON()) mod_phase(F, layer, kind); PH_END(); }
        if (kind != 1) {
            if (EN(2) && PH_ON()) { const PArgs args = args_fresh(); const int sff = 2 * layer + (kind >> 1);
                EpiSwiglu E{WSP(bf16, WS_U)};
#ifndef PROBE_FI
#define PROBE_FI 1
#endif
#pragma unroll 1
                for (int rep = 0; rep < PROBE_FI; ++rep) run_gemm(F, WSP(bf16, WS_H), WSP(bf16, WS_WFI) + (size_t)sff * NFFIN * DM, MROWS, NFFIN, DM, E);
                { constexpr int NU = (MROWS / 256) * (NFFIN / 256); const int tail = NU % F.G;
                  const int code = sff == 0 ? 2 : sff == 1 ? 3 : sff == 2 ? 4 : sff == 3 ? 9 : sff == 4 ? 5 : sff == 5 ? 11 : sff == 6 ? 7 : -1;
                  if (tail != 0) convert_in_tail(F, code, tail); else if (code >= 0) convert_set(F, code, F.vcu * NWAVES + __builtin_amdgcn_readfirstlane((int)threadIdx.x >> 6), F.G * NWAVES); } }
            PH_END();
        } else if (is_attn) {
            if (EN(4) && PH_ON()) { const PArgs args = args_fresh();
                EpiAttnIn E{WSP(bf16, WS_Q), WSP(bf16, WS_K), WSP(bf16, WS_V), WSP(bf16, WS_QI), WSP(bf16, WS_KI), WSP(float, WS_WI), args.in(15) + li * HDIM, args.in(16) + li * HDIM,
                            args.out() + O_KP + (size_t)li * MP * KVW, args.out() + O_VP + (size_t)li * MP * KVW, args.out() + O_KIP + (size_t)li * MP * IDIM,
                            args.out() + O_KS + (size_t)li * NS * KVW, args.out() + O_VS + (size_t)li * NS * KVW, args.out() + O_KIS + (size_t)li * NS * IDIM};
                run_gemm(F, WSP(bf16, WS_H), WSP(bf16, WS_WAI) + (size_t)li * ATT_NP * DM, MROWS, ATT_NP, DM, E);
                { constexpr int NU = (MROWS / 256) * (ATT_NP / 256); const int tail = NU % F.G; const int code = li == 0 ? 10 : 6;
                  if (tail != 0) convert_in_tail(F, code, tail); else convert_set(F, code, F.vcu * NWAVES + __builtin_amdgcn_readfirstlane((int)threadIdx.x >> 6), F.G * NWAVES); }
            }
            PH_END();
#ifndef PROBE_A1
#define PROBE_A1 1
#endif
            if (EN(5) && PH_ON()) {
                const int qb = (2 * F.vcu) / F.G;
#pragma unroll 1
              for (int rep = 0; rep < PROBE_A1; ++rep) {
                gu32* qhead = (gu32*)(args_fresh().ws() + WS_CTL) + CW_Q + (li * 2 + qb + 4 * rep) * 64;
#pragma unroll 1
                for (;;) {
                    if (threadIdx.x == 0) F.MISC[4] = __hip_atomic_fetch_add(qhead, 1u, __ATOMIC_RELAXED, __HIP_MEMORY_SCOPE_AGENT);
                    __syncthreads();
                    const int t = (int)F.MISC[4];
                    __syncthreads();
                    if (t >= 16 + 256) break;
                    if (t < 16) { if (EN(6)) a1::sample_unit(F, li, qb * 16 + t); }
                    else a1::prompt_unit(F, qb, 255 - (t - 16));
                }
              }
            }
            PH_END();
            if (EN(5) && PH_ON()) {
                const int grp = (8 * F.vcu) / F.G, wgi = F.vcu - grp * (F.G / 8), per = SEQ / (F.G / 8);
                const int wv = __builtin_amdgcn_readfirstlane((int)threadIdx.x >> 6);
#pragma unroll 1
                for (int q0 = wgi * per + 32 * wv; q0 < (wgi + 1) * per; q0 += 256) a1::attend_wave(F, grp >> 2, grp & 3, q0);
            }
            PH_END();
        } else {
            if (EN(8) && PH_ON()) { const PArgs args = args_fresh(); const float* st = args.in(5) + (size_t)li * NS * 2 * DM;
                EpiConvCU E{WSP(bf16, WS_Z), args.out() + O_CVP + (size_t)li * NBP * 2 * DM, args.out() + O_CVS + (size_t)li * NS * 2 * DM, st};
                run_gemm(F, WSP(bf16, WS_H), WSP(bf16, WS_WCU) + (size_t)li * 2 * DM * DM, MP, 2 * DM, DM, E);
                if (blockIdx.x < 64) { const int zb = blockIdx.x; const bf16* w0 = WSP(bf16, WS_WCU) + (size_t)li * 2 * DM * DM + (size_t)(256 * (zb >> 3) + 16 * (zb & 7)) * DM;
                    bf16* Zb = WSP(bf16, WS_Z); float* ocvs = args.out() + O_CVS + (size_t)li * NS * 2 * DM;
                    small_item<2, 4>(F, WSP(bf16, WS_H) + (size_t)MP * DM, DM, w0, w0 + (size_t)128 * DM, [=](int m, int c, float vc, float vu) {
                        const int col = 16 * zb + c; const float z = vc * vu; Zb[(size_t)(MP + m) * DM + col] = (bf16)(pk2(z, 0.f) & 0xffffu);
                        ocvs[(size_t)(2 * m + 1) * DM + col] = z; ocvs[(size_t)(2 * m) * DM + col] = st[(size_t)(2 * m + 1) * DM + col]; return 0.f; }); } }
            PH_END();
            if (EN(9) && PH_ON()) { const PArgs args = args_fresh(); const float* st = args.in(5) + (size_t)li * NS * 2 * DM;
                EpiConvB E{WSP(bf16, WS_Z), WSP(bf16, WS_O), args.in(18) + (size_t)li * 3 * DM, st}; run_gemm(F, WSP(bf16, WS_H), WSP(bf16, WS_WCB) + (size_t)li * DM * DM, MP, DM, DM, E);
                if (blockIdx.x < 64) { const int nb = blockIdx.x; const bf16* Zb = WSP(bf16, WS_Z); bf16* A2 = WSP(bf16, WS_O); const float* cw = args.in(18) + (size_t)li * 3 * DM;
                    small_item<1, 4>(F, WSP(bf16, WS_H) + (size_t)MP * DM, DM, WSP(bf16, WS_WCB) + (size_t)li * DM * DM + (size_t)16 * nb * DM, nullptr, [=](int m, int c, float v, float) {
                        const int col = 16 * nb + c; const float zt = __uint_as_float((unsigned)Zb[(size_t)(MP + m) * DM + col] << 16);
                        const float y = cw[col] * st[(size_t)(2 * m) * DM + col] + cw[DM + col] * st[(size_t)(2 * m + 1) * DM + col] + cw[2 * DM + col] * zt;
                        A2[(size_t)(MP + m) * DM + col] = (bf16)(pk2(v * y, 0.f) & 0xffffu); return 0.f; }); } }
            PH_END();
        }
        if (EN(3) && PH_ON()) { const PArgs args = args_fresh();
            const bf16* ra; const bf16* rb; int rk; int rflags;
            if (kind != 1) { const int sff = 2 * layer + (kind >> 1); ra = WSP(bf16, WS_U); rb = WSP(bf16, WS_WFO) + (size_t)sff * DM * DFF; rk = DFF; rflags = 1; }
            else if (is_attn) { ra = WSP(bf16, WS_O); rb = WSP(bf16, WS_WAO) + (size_t)li * DM * DM; rk = DM; rflags = 0; }
            else { ra = WSP(bf16, WS_O); rb = WSP(bf16, WS_WCO) + (size_t)li * DM * DM; rk = DM; rflags = 0; }
            const bool fuse = j < 11; const int nl = (j + 1) / 3, nk = (j + 1) - 3 * nl;
            const float* modn = WSP(float, WS_MOD) + (size_t)nl * NBATCH * MODW + nk * 3 * DM;
            float* xslots = WSP(float, WS_XS) + (size_t)j * XS_STRIDE; unsigned* pcnt = (unsigned*)(args.ws() + WS_CTL) + CW_PC + (size_t)j * 65 * 64;
            EpiResidMod E{WSP(float, WS_X), WSP(float, WS_MOD) + (size_t)layer * NBATCH * MODW + (3 * kind + 2) * DM, args.out() + O_YP, rflags | (j == 11 ? 2 : 0) | (fuse ? 4 : 0),
                          xslots, pcnt, WSP(bf16, WS_H), modn};
            float xk = 0.f; const bool smp = blockIdx.x < 64; const int nb = blockIdx.x;
            float* ss = xslots + (size_t)MP * 4; unsigned* scn = pcnt + 64 * 64;
            if (smp) { float* X = WSP(float, WS_X); const float* gate = WSP(float, WS_MOD) + (size_t)layer * NBATCH * MODW + (3 * kind + 2) * DM;
                float* outp = args.out() + O_YP; const float coef = (rflags & 1) ? 0.5f : 1.0f; const bool mirror = j == 11;
                const Tid T0 = tid_fresh(); const int pm_ = (T0.lane & 15) + 16 * (T0.wave >> 2), pc_ = 4 * (T0.lane >> 4) + (T0.wave & 3);
                const float xpre = X[(size_t)(MP + pm_) * DM + 16 * nb + pc_], gpre = gate[(size_t)(2 + pm_) * MODW + 16 * nb + pc_];
                auto fin = [=](int m, int c, float v, float) -> float {
                    const int col = 16 * nb + c; const size_t o = (size_t)(MP + m) * DM + col;
                    const float x = xpre + coef * gpre * v; X[o] = x; if (mirror) outp[o] = x; return x; };
                if (rk == DFF) xk = small_item<1, DFF / 256>(F, ra + (size_t)MP * rk, rk, rb + (size_t)16 * nb * rk, nullptr, fin);
                else xk = small_item<1, DM / 256>(F, ra + (size_t)MP * rk, rk, rb + (size_t)16 * nb * rk, nullptr, fin);
                if (fuse) { const Tid T = tid_fresh(); const int m = (T.lane & 15) + 16 * (T.wave >> 2);
                    LAS float* part = (LAS float*)(F.lds + RING_OFF + 65536);
                    float s = xk * xk; s += __shfl_xor(s, 16); s += __shfl_xor(s, 32);
                    if (T.lane < 16) part[(T.wave & 3) * 32 + m] = s;
                    __syncthreads();
                    if (T.tid < 32) { const float t4 = (part[T.tid] + part[32 + T.tid]) + (part[64 + T.tid] + part[96 + T.tid]);
                        __hip_atomic_store((unsigned*)ss + T.tid * 64 + nb, __float_as_uint(t4), __ATOMIC_RELAXED, __HIP_MEMORY_SCOPE_AGENT); }
                    asm volatile("s_waitcnt vmcnt(0)" ::: "memory");
                    __syncthreads();
                    if (T.tid == 0) (void)__hip_atomic_fetch_add(scn, 1u, __ATOMIC_RELAXED, __HIP_MEMORY_SCOPE_AGENT);
                } }
            run_gemm(F, ra, rb, MP, DM, rk, E);
            if (smp && fuse) { const Tid T = tid_fresh(); const int tid = T.tid;
                LAS float* rsl = (LAS float*)(F.lds + RING_OFF + 65536);
                if (tid == 0) { unsigned sp = 0;
                    while (__hip_atomic_load(scn, __ATOMIC_RELAXED, __HIP_MEMORY_SCOPE_AGENT) < 64u) { __builtin_amdgcn_s_sleep(2); if (++sp > (1u << 20)) break; }
                    __builtin_amdgcn_fence(__ATOMIC_ACQUIRE, "agent"); asm volatile("s_waitcnt vmcnt(0)" ::: "memory"); }
                __syncthreads();
                { const int m = tid >> 4, k4 = (tid & 15) * 4; f32x4 q4;
                  asm volatile("global_load_dwordx4 %0, %1, off sc1\n\ts_waitcnt vmcnt(0)" : "=v"(q4) : "v"((const unsigned*)ss + m * 64 + k4) : "memory");
                  float q = (q4[0] + q4[1]) + (q4[2] + q4[3]);
                  q += __shfl_xor(q, 1); q += __shfl_xor(q, 2); q += __shfl_xor(q, 4); q += __shfl_xor(q, 8);
                  if ((tid & 15) == 0) rsl[m] = __builtin_amdgcn_rsqf(q * (1.f / DM) + RMS_EPS); }
                __syncthreads();
                { const int m = (T.lane & 15) + 16 * (T.wave >> 2), c = 4 * (T.lane >> 4) + (T.wave & 3), col = 16 * nb + c; const float* mb = modn + (size_t)(2 + m) * MODW + col;
                  const float h = xk * rsl[m] * (mb[DM] + 1.f) + mb[0];
                  WSP(bf16, WS_H)[(size_t)(MP + m) * DM + col] = (bf16)(pk2(h, 0.f) & 0xffffu); }
                __syncthreads();
            } }
        PH_END();
    }
#undef PH_ON
#undef PH_END
}

extern "C" void kernel_launch(void* const* d_in, const int* in_sizes, int n_in, void* d_out, int out_size, void* d_ws, size_t ws_size, hipStream_t stream) {
    static int grid = 0;
    if (grid == 0) {
        if (n_in != 20 || (size_t)out_size != O_END || ws_size < WS_END) { fprintf(stderr, "kernel_launch: unexpected problem shape (n_in %d, out %d, ws %zu); nothing launched\n", n_in, out_size, ws_size); grid = -1; return; }
        int dev = 0, cus = 0, per_cu = 0;
        if (hipGetDevice(&dev) != hipSuccess || hipDeviceGetAttribute(&cus, hipDeviceAttributeMultiprocessorCount, dev) != hipSuccess) { grid = -1; return; }
        if (hipFuncSetAttribute((const void*)mega_fwd, hipFuncAttributeMaxDynamicSharedMemorySize, LDS_BYTES) != hipSuccess) { fprintf(stderr, "kernel_launch: hipFuncSetAttribute failed\n"); grid = -1; return; }
        if (hipOccupancyMaxActiveBlocksPerMultiprocessor(&per_cu, (const void*)mega_fwd, NWAVES * 64, LDS_BYTES) != hipSuccess || per_cu < 1)
            fprintf(stderr, "kernel_launch: note: occupancy query reports %d workgroups per CU\n", per_cu);
        (void)hipGetLastError();
        grid = cus;
    }
    if (grid < 0) return;
    if (hipMemsetAsync((char*)d_ws + WS_CTL, 0, CTL_ZERO_BYTES, stream) != hipSuccess) return;
    Args a{};
    for (int i = 0; i < 20; ++i) a.in[i] = (const float*)d_in[i];
    a.out = (float*)d_out; a.ws = (unsigned char*)d_ws;
#if MK_SINGLE
    a.ph_lo = 0; a.ph_hi = N_PHASES;
    hipLaunchKernelGGL(mega_fwd, dim3(grid), dim3(NWAVES * 64), LDS_BYTES, stream, a);
#else
    for (int p = 0; p < N_PHASES; ++p) { a.ph_lo = p; a.ph_hi = p + 1; hipLaunchKernelGGL(mega_fwd, dim3(grid), dim3(NWAVES * 64), LDS_BYTES, stream, a); }
#endif
}
```

```cpp
#include <hip/hip_runtime.h>
#include <cstdio>
#include <cstdint>
namespace pg8 {
#define PG8_LAS __attribute__((address_space(3)))
typedef unsigned short bf16_t;
typedef short bf16x8 __attribute__((ext_vector_type(8)));
typedef float f32x4 __attribute__((ext_vector_type(4)));
typedef unsigned u32x4 __attribute__((ext_vector_type(4)));
constexpr int BM = 256, BK = 64, HALF = 128, HTB = HALF * BK * 2  , STAGE_BYTES = 8 * HTB, NXCD = 8, WGM = 8;

__host__ __device__ __forceinline__ int lds_byte(int r, int c) { const int st = (r >> 4) * 2 + (c >> 5), rr = r & 15, cc = c & 31, ob = rr * 64 + cc * 2; return st * 1024 + (ob ^ (((ob >> 9) & 1) << 5)); }
__host__ __device__ __forceinline__ void stage_rc(int b, int& R, int& C) { const int st = b / 1024, sb = b % 1024, swz = sb ^ (((sb >> 9) & 1) << 5); R = (st >> 1) * 16 + swz / 64; C = (st & 1) * 32 + (swz % 64) / 2; }
__host__ __device__ __forceinline__ int perm32(int rho) { const int n = rho >> 4, i = rho & 15; return 8 * (i >> 2) + 4 * n + (i & 3); }

struct Unit { int pm, pn; };
struct Gemm { const bf16_t* A; const bf16_t* Bt; int M, N, K; };

struct StaticOrder {
    int nM, nN, nwg, G, c;
    __host__ __device__ void init(int M, int N, int G_, int c_) { nM = M / BM; nN = N / BM; nwg = nM * nN; G = G_; c = c_; }
    __host__ __device__ __forceinline__ bool next(int i, Unit& u) const {
        const long L = (long)i * G + c; if (L >= nwg) return false;
        int wgid = (int)L; { const int q = nwg / NXCD, r = nwg % NXCD, xcd = wgid % NXCD, off = wgid / NXCD; wgid = (xcd < r ? xcd * (q + 1) : r * (q + 1) + (xcd - r) * q) + off; }
        const int nig = WGM * nN, gid = wgid / nig, fm = gid * WGM, gsz = (nM - fm) < WGM ? (nM - fm) : WGM;
        u.pm = fm + ((wgid % nig) % gsz); u.pn = (wgid % nig) / gsz; return true;
    }
    __device__ __forceinline__ void a_ready(const Unit&) const {}
    __device__ __forceinline__ void done(const Unit&) const {}
};

__device__ __forceinline__ unsigned cvt_pk_bf16(float lo, float hi) { unsigned r; asm volatile("v_cvt_pk_bf16_f32 %0, %1, %2" : "=v"(r) : "v"(lo), "v"(hi)); return r; }
typedef float f32x2 __attribute__((ext_vector_type(2)));
template <class Epi, class Sched, bool ALIGN_EPI = false, bool SP2 = false>
__device__ __forceinline__ void gemm_phase(PG8_LAS unsigned char* lds, const Gemm g, const Sched S, const Epi E) {
    int tid_ = threadIdx.x; asm volatile("" : "+v"(tid_));
    const int tid = tid_, wid = __builtin_amdgcn_readfirstlane(tid >> 6), lane = tid & 63, wr = wid >> 2, wc = wid & 3, fr = lane & 15, fq = lane >> 4;
    const int K = g.K, nt = K / BK;
    unsigned voffA[2], voffB[2];
#pragma unroll
    for (int i = 0; i < 2; ++i) { int R, C; stage_rc(tid * 16 + i * 8192, R, C); const int Rb = Epi::PERM ? ((R & ~31) + perm32(R & 31)) : R;
        voffA[i] = (unsigned)(R * K + C) * 2u; voffB[i] = (unsigned)(Rb * K + C) * 2u; }
    const size_t kstep = (size_t)(BK * 2);
    const size_t hstep = (size_t)HALF * K * 2;
    const size_t tstep = 2 * hstep;
    const unsigned ldsw = (unsigned)wid * 1024u;
    const int aoff = lds_byte(wr * 64 + fr, fq * 8), boff = lds_byte(wc * 32 + fr, fq * 8);
#define PG8_SA(b, h) (((b) * 2 + (h)) * HTB)
#define PG8_SB(b, h) ((4 + (b) * 2 + (h)) * HTB)
#define PG8_STAGE(bufoff, gbase, voff) do { _Pragma("unroll") for (int _i = 0; _i < 2; ++_i) \
        __builtin_amdgcn_global_load_lds((const unsigned*)((const char*)(gbase) + (voff)[_i]), (PG8_LAS unsigned*)(lds + (bufoff) + ldsw + _i * 8192), 16, 0, 0); } while (0)
#define PG8_LDA(dst, b, h) do { _Pragma("unroll") for (int m = 0; m < 4; ++m) _Pragma("unroll") for (int k = 0; k < 2; ++k) dst[m][k] = *(const PG8_LAS bf16x8*)(lds + PG8_SA(b, h) + aoff + m * 2048 + k * 1024); } while (0)
#define PG8_LDB(dst, b, h) do { _Pragma("unroll") for (int n = 0; n < 2; ++n) _Pragma("unroll") for (int k = 0; k < 2; ++k) dst[n][k] = *(const PG8_LAS bf16x8*)(lds + PG8_SB(b, h) + boff + n * 2048 + k * 1024); } while (0)
#define PG8_MMA(ai, bj, At, Bt) do { __builtin_amdgcn_s_setprio(1); _Pragma("unroll") for (int m = 0; m < 4; ++m) _Pragma("unroll") for (int n = 0; n < 2; ++n) _Pragma("unroll") for (int k = 0; k < 2; ++k) \
        acc[ai][bj][m][n] = __builtin_amdgcn_mfma_f32_16x16x32_bf16(Bt[n][k], At[m][k], acc[ai][bj][m][n], 0, 0, 0); __builtin_amdgcn_s_setprio(0); } while (0)
#define PG8_WAIT_V(n) asm volatile("s_waitcnt vmcnt(" #n ")" ::: "memory")
#define PG8_WAIT_L(n) asm volatile("s_waitcnt lgkmcnt(" #n ")" ::: "memory")
#define PG8_BAR __builtin_amdgcn_s_barrier()
#define PG8_SCHED __builtin_amdgcn_sched_barrier(0)
    Unit cur, nxt; int ui = 0;
    if (!S.next(0, cur)) return;
    f32x4 acc[2][2][4][2];
#pragma unroll
    for (int a = 0; a < 2; ++a)
#pragma unroll
        for (int b = 0; b < 2; ++b)
#pragma unroll
            for (int m = 0; m < 4; ++m)
#pragma unroll
                for (int n = 0; n < 2; ++n) acc[a][b][m][n] = (f32x4){0.f, 0.f, 0.f, 0.f};
    bf16x8 At[4][2], B0[2][2], B1[2][2];
    const char* cA = (const char*)g.A + (size_t)cur.pm * tstep; const char* cB = (const char*)g.Bt + (size_t)cur.pn * tstep;
    S.a_ready(cur);
    if constexpr (SP2) {
        PG8_STAGE(PG8_SB(0, 0), cB, voffB); PG8_STAGE(PG8_SB(0, 1), cB + hstep, voffB); PG8_STAGE(PG8_SA(0, 0), cA, voffA); PG8_STAGE(PG8_SA(0, 1), cA + hstep, voffA);
        if (wr == 1) PG8_BAR;
        PG8_WAIT_V(2); PG8_BAR;
        PG8_STAGE(PG8_SB(1, 0), cB + kstep, voffB); PG8_STAGE(PG8_SA(1, 0), cA + kstep, voffA); PG8_STAGE(PG8_SB(1, 1), cB + hstep + kstep, voffB);
        PG8_WAIT_V(6); PG8_BAR;
    } else {
        PG8_STAGE(PG8_SB(0, 0), cB, voffB); PG8_STAGE(PG8_SA(0, 0), cA, voffA); PG8_STAGE(PG8_SB(0, 1), cB + hstep, voffB); PG8_STAGE(PG8_SA(0, 1), cA + hstep, voffA);
        if (wr == 1) PG8_BAR;
        PG8_WAIT_V(4); PG8_BAR;
        PG8_STAGE(PG8_SB(1, 0), cB + kstep, voffB); PG8_STAGE(PG8_SA(1, 0), cA + kstep, voffA); PG8_STAGE(PG8_SB(1, 1), cB + hstep + kstep, voffB);
        PG8_WAIT_V(6); PG8_BAR;
    }
    for (;;) {
        const bool has_next = S.next(ui + 1, nxt);
        const char* nA = has_next ? (const char*)g.A + (size_t)nxt.pm * tstep : cA; const char* nB = has_next ? (const char*)g.Bt + (size_t)nxt.pn * tstep : cB;
        for (int t = 0; t < nt; t += 2) {
            const bool last = (t == nt - 2);
            const char* a1 = cA + (size_t)(t + 1) * kstep;
            const char* a2 = last ? nA : cA + (size_t)(t + 2) * kstep; const char* b2 = last ? nB : cB + (size_t)(t + 2) * kstep;
            const char* a3 = a2 + kstep; const char* b3 = b2 + kstep;
            if (last && has_next) S.a_ready(nxt);
            if constexpr (SP2) {
            PG8_LDB(B0, 0, 0); PG8_LDB(B1, 0, 1); PG8_SCHED; PG8_LDA(At, 0, 0); PG8_STAGE(PG8_SA(1, 1), a1 + hstep, voffA);
            PG8_WAIT_V(8); PG8_WAIT_L(0); PG8_BAR; PG8_MMA(0, 0, At, B0); PG8_MMA(0, 1, At, B1); PG8_BAR; PG8_SCHED;
            PG8_LDA(At, 0, 1); PG8_STAGE(PG8_SB(0, 0), b2, voffB); PG8_STAGE(PG8_SB(0, 1), b2 + hstep, voffB); PG8_STAGE(PG8_SA(0, 0), a2, voffA);
            PG8_WAIT_V(8); PG8_WAIT_L(0); PG8_BAR; PG8_MMA(1, 0, At, B0); PG8_MMA(1, 1, At, B1); PG8_BAR; PG8_SCHED;
            PG8_LDB(B0, 1, 0); PG8_LDB(B1, 1, 1); PG8_SCHED; PG8_LDA(At, 1, 0); PG8_STAGE(PG8_SA(0, 1), a2 + hstep, voffA);
            PG8_WAIT_V(8); PG8_WAIT_L(0); PG8_BAR; PG8_MMA(0, 0, At, B0); PG8_MMA(0, 1, At, B1); PG8_BAR; PG8_SCHED;
            PG8_LDA(At, 1, 1); PG8_STAGE(PG8_SB(1, 0), b3, voffB); PG8_STAGE(PG8_SB(1, 1), b3 + hstep, voffB); PG8_STAGE(PG8_SA(1, 0), a3, voffA);
            PG8_WAIT_V(8); PG8_WAIT_L(0); PG8_BAR; PG8_MMA(1, 0, At, B0); PG8_MMA(1, 1, At, B1); PG8_BAR; PG8_SCHED;
            } else {
            PG8_LDB(B0, 0, 0); PG8_SCHED; PG8_LDA(At, 0, 0); PG8_STAGE(PG8_SA(1, 1), a1 + hstep, voffA);
            PG8_WAIT_L(8); PG8_BAR; PG8_WAIT_L(0); PG8_MMA(0, 0, At, B0); PG8_BAR; PG8_SCHED;
            PG8_LDB(B1, 0, 1); PG8_STAGE(PG8_SB(0, 0), b2, voffB);
            PG8_BAR; PG8_WAIT_L(0); PG8_MMA(0, 1, At, B1); PG8_BAR;
            PG8_LDA(At, 0, 1); PG8_STAGE(PG8_SA(0, 0), a2, voffA);
            PG8_BAR; PG8_WAIT_L(0); PG8_MMA(1, 0, At, B0); PG8_BAR; PG8_SCHED;
            PG8_STAGE(PG8_SB(0, 1), b2 + hstep, voffB);
            PG8_WAIT_V(6); PG8_BAR; PG8_MMA(1, 1, At, B1); PG8_BAR;
            PG8_LDB(B0, 1, 0); PG8_SCHED; PG8_LDA(At, 1, 0); PG8_STAGE(PG8_SA(0, 1), a2 + hstep, voffA);
            PG8_WAIT_L(8); PG8_BAR; PG8_WAIT_L(0); PG8_MMA(0, 0, At, B0); PG8_BAR; PG8_SCHED;
            PG8_LDB(B1, 1, 1); PG8_STAGE(PG8_SB(1, 0), b3, voffB);
            PG8_BAR; PG8_WAIT_L(0); PG8_MMA(0, 1, At, B1); PG8_BAR;
            PG8_LDA(At, 1, 1); PG8_STAGE(PG8_SA(1, 0), a3, voffA);
            PG8_BAR; PG8_WAIT_L(0); PG8_MMA(1, 0, At, B0); PG8_BAR; PG8_SCHED;
            PG8_STAGE(PG8_SB(1, 1), b3 + hstep, voffB);
            PG8_WAIT_V(6); PG8_BAR; PG8_MMA(1, 1, At, B1); PG8_BAR;
            }
        }
        if constexpr (ALIGN_EPI) { if (wr == 0) PG8_BAR; }
        if constexpr (!Epi::AFTER_DRAIN) { E(acc, cur, wr, wc, fr, fq); S.done(cur); }
        if (!has_next) break;
#pragma unroll
        for (int a = 0; a < 2; ++a)
#pragma unroll
            for (int b = 0; b < 2; ++b)
#pragma unroll
                for (int m = 0; m < 4; ++m)
#pragma unroll
                    for (int n = 0; n < 2; ++n) acc[a][b][m][n] = (f32x4){0.f, 0.f, 0.f, 0.f};
        cur = nxt; cA = nA; cB = nB; ++ui;
        if constexpr (ALIGN_EPI) { if (wr == 1) PG8_BAR; }
    }
    PG8_WAIT_V(0);
    if constexpr (!ALIGN_EPI) { if (wr == 0) PG8_BAR; }
    PG8_BAR;
    if constexpr (Epi::AFTER_DRAIN) { E.fused(acc, cur, wr, wc, fr, fq, lds, wid, lane); S.done(cur); }
#undef PG8_SA
#undef PG8_SB
#undef PG8_STAGE
#undef PG8_LDA
#undef PG8_LDB
#undef PG8_MMA
#undef PG8_WAIT_V
#undef PG8_WAIT_L
#undef PG8_BAR
#undef PG8_SCHED
}
}

constexpr int DM = 1024, SEQ = 8192, NBP = 2, MP = NBP * SEQ, NS = 32;
constexpr int MROWS = 16640, MVALID = MP + NS;
constexpr int DFF = 2816, NFFIN = 2 * DFF;
constexpr int NHEAD = 16, HDIM = 64, KVW = 256, IQW = 512, IDIM = 64, IHEADS = 8, TOPK = 256;
constexpr int ATT_COLS = 2120, ATT_NP = 2304;
constexpr int MODW = 9 * DM, NBATCH = 34;
constexpr int NPG = 64, PAGE = 128, NPOOL = 2560;
constexpr float RMS_EPS = 1e-6f;
constexpr float QSCALE = 0.125f * 1.4426950408889634f;
constexpr float WISCALE = 0.35355339059327373f * 0.125f;
constexpr size_t O_YP = 0, O_YS = 16777216, O_KP = 16809984, O_VP = 25198592, O_KIP = 33587200, O_CVP = 35684352,
                 O_KS = 35692544, O_VS = 35708928, O_KIS = 35725312, O_CVS = 35729408, O_END = 35860480;
constexpr size_t MiB = 1u << 20;
constexpr size_t WS_CTL = 0, CTL_ZERO_BYTES = 1 * MiB;
constexpr size_t WS_MOD = 1 * MiB;
constexpr size_t WS_WFI = 8 * MiB;
constexpr size_t WS_WFO = 96 * MiB;
constexpr size_t WS_WAI = 140 * MiB;
constexpr size_t WS_WAO = 150 * MiB;
constexpr size_t WS_WCU = 154 * MiB;
constexpr size_t WS_WCB = 162 * MiB;
constexpr size_t WS_WCO = 166 * MiB;
constexpr size_t WS_X = 176 * MiB;
constexpr size_t WS_H = 242 * MiB;
constexpr size_t WS_U = 276 * MiB;
constexpr size_t WS_Q = 366 * MiB;
constexpr size_t WS_K = 399 * MiB;
constexpr size_t WS_V = 408 * MiB;
constexpr size_t WS_QI = 417 * MiB;
constexpr size_t WS_KI = 434 * MiB;
constexpr size_t WS_WI = 437 * MiB;
constexpr size_t WS_O = 438 * MiB;
constexpr size_t WS_Z = 471 * MiB;
constexpr size_t WS_IDX = 504 * MiB;
constexpr size_t WS_NSEL = 512 * MiB;
constexpr size_t WS_XS = 513 * MiB;
constexpr size_t XS_STRIDE = (size_t)MP * 4 + 32 * 64;
constexpr size_t WS_END = 517 * MiB;
static_assert(WS_MOD + (size_t)4 * 34 * 9216 * 4 <= WS_WFI && WS_WFI + (size_t)8 * 5632 * 1024 * 2 <= WS_WFO && WS_WFO + (size_t)8 * 1024 * 2816 * 2 <= WS_WAI &&
              WS_WAI + (size_t)2 * 2304 * 1024 * 2 <= WS_WAO && WS_X + (size_t)MROWS * DM * 4 <= WS_H && WS_H + (size_t)MROWS * DM * 2 <= WS_U &&
              WS_U + (size_t)MROWS * DFF * 2 <= WS_Q && WS_Q + (size_t)MROWS * DM * 2 <= WS_K && WS_K + (size_t)MROWS * KVW * 2 <= WS_V && WS_V + (size_t)MROWS * KVW * 2 <= WS_QI &&
              WS_QI + (size_t)MROWS * IQW * 2 <= WS_KI && WS_KI + (size_t)MROWS * IDIM * 2 <= WS_WI && WS_WI + (size_t)MROWS * 8 * 4 <= WS_O && WS_O + (size_t)MROWS * DM * 2 <= WS_Z &&
              WS_Z + (size_t)MROWS * DM * 2 <= WS_IDX && WS_IDX + (size_t)MP * TOPK * 2 <= WS_NSEL && WS_NSEL + (size_t)MP * 4 <= WS_XS && WS_XS + 12 * XS_STRIDE * 4 <= WS_END, "d_ws map");
constexpr int CW_TMO = 0, CW_BAR = 4096, CW_Q = 8192, CW_PC = 16384;
constexpr int RING_OFF = 0, RING_BYTES = 131072;
constexpr int LDSCTL_OFF = RING_BYTES, MISC_OFF = LDSCTL_OFF + 320;
constexpr int LDS_BYTES = 147456;
constexpr int NWAVES = 8;

#define GAS __attribute__((address_space(1)))
#define LAS __attribute__((address_space(3)))
typedef unsigned short bf16;
typedef unsigned v4u __attribute__((ext_vector_type(4)));
typedef unsigned v2u __attribute__((ext_vector_type(2)));
typedef float f32x4 __attribute__((ext_vector_type(4)));
typedef float f32x2 __attribute__((ext_vector_type(2)));
typedef float f32x16 __attribute__((ext_vector_type(16)));
typedef short bf16x8 __attribute__((ext_vector_type(8)));
typedef GAS unsigned gu32;
#define LDS_WAIT() asm volatile("s_waitcnt lgkmcnt(0)" ::: "memory")
#define VM_WAIT() asm volatile("s_waitcnt vmcnt(0)" ::: "memory")
__device__ __forceinline__ unsigned pk2(float lo, float hi) { return pg8::cvt_pk_bf16(lo, hi); }
__device__ __forceinline__ float bflo(unsigned u) { return __uint_as_float(u << 16); }
__device__ __forceinline__ float bfhi(unsigned u) { return __uint_as_float(u & 0xffff0000u); }
__device__ __forceinline__ float silu1(float a) { return a * __builtin_amdgcn_rcpf(1.f + __builtin_amdgcn_exp2f(-1.4426950408889634f * a)); }
__device__ __forceinline__ int batch_of(int row) { const int b = row < MP ? (row >> 13) : (2 + row - MP); return b > 33 ? 33 : b; }
__device__ __forceinline__ float wave_sum(float v) {
#pragma unroll
    for (int o = 1; o < 64; o <<= 1) v += __shfl_xor(v, o);
    return v;
}
__device__ __forceinline__ float wave_max(float v) {
#pragma unroll
    for (int o = 1; o < 64; o <<= 1) v = fmaxf(v, __shfl_xor(v, o));
    return v;
}
#define XB_TMO      128
#define XB_XCNT(j)  (256  + 64 * (j))
#define XB_XSUB(j)  (1280 + 64 * (j))
#define XB_XGEN(j)  (2304 + 64 * (j))
#define XB_TOP      3328
#define XB_TOPGEN   3392
#define XCD_BAR_WORDS 3456
#define XB_SPIN_CAP (1u << 18)

__device__ __forceinline__ unsigned xb_ld(unsigned* p)              { return __hip_atomic_load(p, __ATOMIC_RELAXED, __HIP_MEMORY_SCOPE_AGENT); }
__device__ __forceinline__ unsigned xb_add(unsigned* p, unsigned v) { return __hip_atomic_fetch_add(p, v, __ATOMIC_RELAXED, __HIP_MEMORY_SCOPE_AGENT); }
__device__ __forceinline__ unsigned xb_xcc_id() { return (unsigned)__builtin_amdgcn_s_getreg((3 << 11) | 20) & 0xFu; }
#define XB_SPIN(cond, bar) do { unsigned _sp = 0; while (cond) { __builtin_amdgcn_s_sleep(1); \
    if ((++_sp & 255u) == 0u) { if (xb_ld(&(bar)[XB_TMO])) break; if (_sp > XB_SPIN_CAP) { atomicAdd(&(bar)[XB_TMO], 1u); break; } } } } while (0)

struct XcdBarrier {
    unsigned* bar; unsigned x;
    volatile LAS unsigned* st;
};

__device__ __forceinline__ XcdBarrier xcd_barrier_post(unsigned* bar, volatile LAS unsigned* st) {
    XcdBarrier b; b.bar = bar; b.x = xb_xcc_id(); b.st = st;
    if (threadIdx.x == 0) (void)xb_add(&bar[XB_XCNT(b.x)], 1u);
    return b;
}
__device__ __forceinline__ void xcd_barrier_complete(unsigned* bar, unsigned x, unsigned& nloc, unsigned& nx) {
    const unsigned G = gridDim.x * gridDim.y * gridDim.z;
    unsigned sum, cnt, mine, sp = 0u;
    for (;;) {
        sum = 0u; cnt = 0u; mine = 0u;
#pragma unroll
        for (unsigned j = 0; j < 16; ++j) { const unsigned c = xb_ld(&bar[XB_XCNT(j)]); sum += c; cnt += (c > 0u) ? 1u : 0u; mine = (j == x) ? c : mine; }
        if (sum == G) break;
        __builtin_amdgcn_s_sleep(1);
        if ((++sp & 255u) == 0u) { if (xb_ld(&bar[XB_TMO])) break; if (sp > XB_SPIN_CAP) { atomicAdd(&bar[XB_TMO], 1u); break; } }
    }
    nloc = mine > 0u ? mine : 1u; nx = cnt > 0u ? cnt : 1u;
}

__device__ __forceinline__ void xcd_barrier(const XcdBarrier& b) {
    asm volatile("s_waitcnt vmcnt(0)" ::: "memory");
    __syncthreads();
    if (threadIdx.x == 0) {
        unsigned* bar = b.bar;
        __builtin_amdgcn_s_waitcnt(0);
        unsigned nloc = b.st[0], nx = b.st[1];
        if (nloc == 0u) { xcd_barrier_complete(bar, b.x, nloc, nx); b.st[0] = nloc; b.st[1] = nx; }
        const unsigned old = xb_add(&bar[XB_XSUB(b.x)], 1u);
        const unsigned gen = old / nloc;
        if (old + 1u == (gen + 1u) * nloc) {
            __builtin_amdgcn_fence(__ATOMIC_RELEASE, "agent");
            asm volatile("s_waitcnt vmcnt(0)" ::: "memory");
            const unsigned og = xb_add(&bar[XB_TOP], 1u);
            const unsigned tg = og / nx;
            if (og + 1u == (tg + 1u) * nx) xb_add(&bar[XB_TOPGEN], 1u);
            else XB_SPIN(xb_ld(&bar[XB_TOPGEN]) == tg, bar);
            __builtin_amdgcn_fence(__ATOMIC_ACQUIRE, "agent");
            asm volatile("s_waitcnt vmcnt(0)" ::: "memory");
        } else {
            XB_SPIN(xb_ld(&bar[XB_TOPGEN]) == gen, bar);
            __builtin_amdgcn_fence(__ATOMIC_ACQUIRE, "agent");
            asm volatile("s_waitcnt vmcnt(0)" ::: "memory");
        }
    }
    __syncthreads();
}

using pg8::Unit;
typedef _Float16 h2e __attribute__((ext_vector_type(2)));
__device__ __forceinline__ unsigned pkh2(float a, float b) { const h2e t = __builtin_convertvector((f32x2){a, b}, h2e); return __builtin_bit_cast(unsigned, t); }

struct EpiSwiglu {
    static constexpr bool PERM = true, AFTER_DRAIN = false;
    bf16* U;
    __device__ __forceinline__ void operator()(const f32x4 (&acc)[2][2][4][2], const Unit& u, int wr, int wc, int fr, int fq) const {
        const int row0 = u.pm * 256 + wr * 64 + fr, col0 = u.pn * 128 + wc * 32 + 8 * fq;
#pragma unroll
        for (int ai = 0; ai < 2; ++ai)
#pragma unroll
            for (int m = 0; m < 4; ++m) {
                const f32x4 a0 = acc[ai][0][m][0], a1 = acc[ai][0][m][1], g0 = acc[ai][1][m][0], g1 = acc[ai][1][m][1];
                v4u w;
                w.x = pk2(silu1(a0[0]) * g0[0], silu1(a0[1]) * g0[1]); w.y = pk2(silu1(a0[2]) * g0[2], silu1(a0[3]) * g0[3]);
                w.z = pk2(silu1(a1[0]) * g1[0], silu1(a1[1]) * g1[1]); w.w = pk2(silu1(a1[2]) * g1[2], silu1(a1[3]) * g1[3]);
                *(v4u*)(U + (size_t)(row0 + ai * 128 + m * 16) * DFF + col0) = w;
            }
    }
};

struct EpiResid {
    static constexpr bool PERM = false, AFTER_DRAIN = false;
    float* X; const float* gate; float* outp; int flags;
    __device__ __forceinline__ void operator()(const f32x4 (&acc)[2][2][4][2], const Unit& u, int wr, int wc, int fr, int fq) const {
        const int row0 = u.pm * 256 + wr * 64 + fr, colb = u.pn * 256 + wc * 32 + 4 * fq;
        const float coef = (flags & 1) ? 0.5f : 1.0f; const bool mirror = (flags & 2) != 0;
#pragma unroll
        for (int ai = 0; ai < 2; ++ai)
#pragma unroll
            for (int m = 0; m < 4; ++m) {
                const int row = row0 + ai * 128 + m * 16; const int b = batch_of(row);
                const float* gp = gate + (size_t)b * MODW + colb; float* xp = X + (size_t)row * DM + colb;
#pragma unroll
                for (int bj = 0; bj < 2; ++bj)
#pragma unroll
                    for (int n = 0; n < 2; ++n) { const int off = bj * 128 + n * 16;
                        const f32x4 g = *(const f32x4*)(gp + off); f32x4 x = *(const f32x4*)(xp + off);
                        x = x + (g * coef) * acc[ai][bj][m][n]; *(f32x4*)(xp + off) = x;
                        if (mirror && row < MVALID) *(f32x4*)(outp + (size_t)row * DM + colb + off) = x; }
            }
    }
};

struct EpiResidMod {
    static constexpr bool PERM = false, AFTER_DRAIN = true;
    float* X; const float* gate; float* outp; int flags;
    float* xbuf; unsigned* cnt; bf16* H; const float* modn;
    __device__ __forceinline__ void fused(f32x4 (&acc)[2][2][4][2], const Unit& u, int wr, int wc, int fr, int fq, LAS unsigned char* lds, int wid, int lane) const {
        asm volatile("" : "+v"(fr), "+v"(fq));
        const int row0 = u.pm * 256 + wr * 64 + fr, colb = u.pn * 256 + wc * 32 + 4 * fq;
        const float coef = (flags & 1) ? 0.5f : 1.0f; const bool mirror = (flags & 2) != 0;
        const int b = u.pm >> 5;
        const float* gp = gate + (size_t)b * MODW + colb;
        f32x4 gv[2][2];
#pragma unroll
        for (int bj = 0; bj < 2; ++bj)
#pragma unroll
            for (int n = 0; n < 2; ++n) gv[bj][n] = *(const f32x4*)(gp + bj * 128 + n * 16);
#pragma unroll
        for (int ai = 0; ai < 2; ++ai) {
            float* xp = X + (size_t)(row0 + ai * 128) * DM + colb;
            f32x4 xv[4][2][2];
#pragma unroll
            for (int m = 0; m < 4; ++m)
#pragma unroll
                for (int bj = 0; bj < 2; ++bj)
#pragma unroll
                    for (int n = 0; n < 2; ++n) xv[m][bj][n] = *(const f32x4*)(xp + (size_t)m * 16 * DM + bj * 128 + n * 16);
            asm volatile("" ::: "memory");
            if (ai == 0) {
#pragma unroll
                for (int bj = 0; bj < 2; ++bj)
#pragma unroll
                    for (int n = 0; n < 2; ++n) gv[bj][n] = gv[bj][n] * coef; }
#pragma unroll
            for (int m = 0; m < 4; ++m)
#pragma unroll
                for (int bj = 0; bj < 2; ++bj)
#pragma unroll
                    for (int n = 0; n < 2; ++n) { const f32x4 x = xv[m][bj][n] + gv[bj][n] * acc[ai][bj][m][n]; acc[ai][bj][m][n] = x; *(f32x4*)(xp + (size_t)m * 16 * DM + bj * 128 + n * 16) = x; }
            if (mirror) { float* op = outp + (size_t)(row0 + ai * 128) * DM + colb;
#pragma unroll
                for (int m = 0; m < 4; ++m)
#pragma unroll
                    for (int bj = 0; bj < 2; ++bj)
#pragma unroll
                        for (int n = 0; n < 2; ++n) *(f32x4*)(op + (size_t)m * 16 * DM + bj * 128 + n * 16) = acc[ai][bj][m][n]; }
        }
        if (!(flags & 4)) return;
        const float* mb = modn + (size_t)b * MODW + colb;
        f32x4 shv[2][2], scv[2][2];
#pragma unroll
        for (int bj = 0; bj < 2; ++bj)
#pragma unroll
            for (int n = 0; n < 2; ++n) { shv[bj][n] = *(const f32x4*)(mb + bj * 128 + n * 16); scv[bj][n] = *(const f32x4*)(mb + DM + bj * 128 + n * 16); }
        LAS float* P = (LAS float*)lds;
        LAS float* S = (LAS float*)(lds + 8192);
        LAS unsigned* flag = (LAS unsigned*)(lds + 8192 + 2048);
#pragma unroll
        for (int ai = 0; ai < 2; ++ai)
#pragma unroll
            for (int m = 0; m < 4; ++m) { float s = 0.f;
#pragma unroll
                for (int bj = 0; bj < 2; ++bj)
#pragma unroll
                    for (int n = 0; n < 2; ++n) { const f32x4 x = acc[ai][bj][m][n]; s += (x[0] * x[0] + x[1] * x[1]) + (x[2] * x[2] + x[3] * x[3]); }
                s += __shfl_xor(s, 16); s += __shfl_xor(s, 32);
                if (fq == 0) P[(ai * 128 + wr * 64 + m * 16 + fr) * 4 + wc] = s; }
        asm volatile("s_waitcnt lgkmcnt(0)" ::: "memory"); __builtin_amdgcn_s_barrier(); asm volatile("" ::: "memory");
        const int prow = wid * 32 + (lane & 31);
        if (lane < 32) { const f32x4 p4 = *(const LAS f32x4*)(P + prow * 4); const float t = (p4[0] + p4[1]) + (p4[2] + p4[3]);
            __hip_atomic_store((unsigned*)xbuf + ((size_t)(u.pm * 256 + prow) * 4 + u.pn), __float_as_uint(t), __ATOMIC_RELAXED, __HIP_MEMORY_SCOPE_AGENT); }
        asm volatile("s_waitcnt vmcnt(0)" ::: "memory");
        if (lane == 0) __hip_atomic_fetch_add(cnt + 64 * u.pm, 1u, __ATOMIC_RELAXED, __HIP_MEMORY_SCOPE_AGENT);
        if (wid == 0) {
            unsigned sp = 0;
            while ((unsigned)__builtin_amdgcn_readfirstlane(__hip_atomic_load(cnt + 64 * u.pm, __ATOMIC_RELAXED, __HIP_MEMORY_SCOPE_AGENT)) < 32u) { __builtin_amdgcn_s_sleep(2); if (++sp > (1u << 20)) break; }
            __builtin_amdgcn_fence(__ATOMIC_ACQUIRE, "agent");
            if (lane == 0) flag[0] = 1u;
        }
        asm volatile("s_waitcnt vmcnt(0) lgkmcnt(0)" ::: "memory"); __builtin_amdgcn_s_barrier(); asm volatile("" ::: "memory");
        if (lane < 32) { const unsigned* sl = (const unsigned*)xbuf + (size_t)(u.pm * 256 + prow) * 4; f32x4 q4;
            asm volatile("global_load_dwordx4 %0, %1, off sc1\n\ts_waitcnt vmcnt(0)" : "=v"(q4) : "v"(sl) : "memory");
            const float q = (q4[0] + q4[1]) + (q4[2] + q4[3]);
            S[prow] = __builtin_amdgcn_rsqf(q * (1.f / DM) + RMS_EPS); }
        asm volatile("s_waitcnt lgkmcnt(0)" ::: "memory"); __builtin_amdgcn_s_barrier(); asm volatile("" ::: "memory");
#pragma unroll
        for (int bj = 0; bj < 2; ++bj)
#pragma unroll
            for (int n = 0; n < 2; ++n) { const int off = bj * 128 + n * 16;
                const f32x4 sh = shv[bj][n], sc = scv[bj][n] + 1.f;
#pragma unroll
                for (int ai = 0; ai < 2; ++ai)
#pragma unroll
                    for (int m = 0; m < 4; ++m) { const int r = ai * 128 + wr * 64 + m * 16 + fr; const float rs = S[r];
                        const f32x4 h = acc[ai][bj][m][n] * rs * sc + sh; v2u o; o.x = pk2(h[0], h[1]); o.y = pk2(h[2], h[3]);
                        *(v2u*)(H + (size_t)(u.pm * 256 + r) * DM + colb + off) = o; } }
    }
};

struct EpiAttnIn {
    static constexpr bool PERM = true, AFTER_DRAIN = false;
    bf16 *Qb, *Kb, *Vb, *QIb, *KIb; float* WIb; const float *qg, *kg; float *okp, *ovp, *okip, *oks, *ovs, *okis;
    __device__ __forceinline__ void operator()(const f32x4 (&acc)[2][2][4][2], const Unit& u, int wr, int wc, int fr, int fq) const {
        const int tile = u.pn; const int row0 = u.pm * 256 + wr * 64 + fr;
        if (tile < 5) {
            const float* gain = tile < 4 ? qg : kg; const float post = tile < 4 ? QSCALE : 1.f;
            f32x4 gv[2][2];
#pragma unroll
            for (int bj = 0; bj < 2; ++bj)
#pragma unroll
                for (int n = 0; n < 2; ++n) gv[bj][n] = *(const f32x4*)(gain + 32 * bj + 8 * fq + 4 * n);
#pragma unroll
            for (int ai = 0; ai < 2; ++ai)
#pragma unroll
                for (int m = 0; m < 4; ++m) {
                    const int row = row0 + ai * 128 + m * 16; float ss = 0.f;
#pragma unroll
                    for (int bj = 0; bj < 2; ++bj)
#pragma unroll
                        for (int n = 0; n < 2; ++n) { const f32x4 v = acc[ai][bj][m][n]; ss += (v[0] * v[0] + v[1] * v[1]) + (v[2] * v[2] + v[3] * v[3]); }
                    ss += __shfl_xor(ss, 16); ss += __shfl_xor(ss, 32);
                    const float r = __builtin_amdgcn_rsqf(ss * (1.f / 64.f) + RMS_EPS);
#pragma unroll
                    for (int bj = 0; bj < 2; ++bj) {
                        const f32x4 v0 = acc[ai][bj][m][0] * r * gv[bj][0], v1 = acc[ai][bj][m][1] * r * gv[bj][1];
                        const int hc = 32 * bj + 8 * fq;
                        if (tile < 4) { v4u w; w.x = pk2(v0[0] * post, v0[1] * post); w.y = pk2(v0[2] * post, v0[3] * post); w.z = pk2(v1[0] * post, v1[1] * post); w.w = pk2(v1[2] * post, v1[3] * post);
                            *(v4u*)(Qb + (size_t)row * DM + (4 * tile + wc) * 64 + hc) = w; }
                        else { v4u w; w.x = pk2(v0[0], v0[1]); w.y = pk2(v0[2], v0[3]); w.z = pk2(v1[0], v1[1]); w.w = pk2(v1[2], v1[3]);
                            if (row < MP) *(v4u*)(Kb + ((size_t)((row >> 13) * 4 + wc) * SEQ + (row & (SEQ - 1))) * 64 + hc) = w;
                            float* o = row < MP ? okp + (size_t)row * KVW : (row < MVALID ? oks + (size_t)(row - MP) * KVW : nullptr);
                            if (o) { *(f32x4*)(o + wc * 64 + hc) = v0; *(f32x4*)(o + wc * 64 + hc + 4) = v1; } }
                    }
                }
        } else if (tile == 5) {
#pragma unroll
            for (int ai = 0; ai < 2; ++ai)
#pragma unroll
                for (int m = 0; m < 4; ++m) {
                    const int row = row0 + ai * 128 + m * 16;
                    float* o = row < MP ? ovp + (size_t)row * KVW : (row < MVALID ? ovs + (size_t)(row - MP) * KVW : nullptr);
#pragma unroll
                    for (int bj = 0; bj < 2; ++bj) { const f32x4 v0 = acc[ai][bj][m][0], v1 = acc[ai][bj][m][1]; const int hc = 32 * bj + 8 * fq;
                        v4u w; w.x = pkh2(v0[0], v0[1]); w.y = pkh2(v0[2], v0[3]); w.z = pkh2(v1[0], v1[1]); w.w = pkh2(v1[2], v1[3]);
                        if (row < MP) *(v4u*)(Vb + ((size_t)((row >> 13) * 4 + wc) * SEQ + (row & (SEQ - 1))) * 64 + hc) = w;
                        if (o) { *(f32x4*)(o + wc * 64 + hc) = v0; *(f32x4*)(o + wc * 64 + hc + 4) = v1; } }
                }
        } else if (tile < 8) {
#pragma unroll
            for (int ai = 0; ai < 2; ++ai)
#pragma unroll
                for (int m = 0; m < 4; ++m) {
                    const int row = row0 + ai * 128 + m * 16;
#pragma unroll
                    for (int bj = 0; bj < 2; ++bj) { const f32x4 v0 = acc[ai][bj][m][0], v1 = acc[ai][bj][m][1]; const int hc = 32 * bj + 8 * fq;
                        v4u w; w.x = pk2(v0[0], v0[1]); w.y = pk2(v0[2], v0[3]); w.z = pk2(v1[0], v1[1]); w.w = pk2(v1[2], v1[3]);
                        *(v4u*)(QIb + (size_t)row * IQW + (4 * (tile - 6) + wc) * 64 + hc) = w; }
                }
        } else {
#pragma unroll
            for (int ai = 0; ai < 2; ++ai)
#pragma unroll
                for (int m = 0; m < 4; ++m) {
                    const int row = row0 + ai * 128 + m * 16;
                    if (wc == 0) {
                        float* o = row < MP ? okip + (size_t)row * IDIM : (row < MVALID ? okis + (size_t)(row - MP) * IDIM : nullptr);
#pragma unroll
                        for (int bj = 0; bj < 2; ++bj) { const f32x4 v0 = acc[ai][bj][m][0], v1 = acc[ai][bj][m][1]; const int hc = 32 * bj + 8 * fq;
                            v4u w; w.x = pk2(v0[0], v0[1]); w.y = pk2(v0[2], v0[3]); w.z = pk2(v1[0], v1[1]); w.w = pk2(v1[2], v1[3]);
                            *(v4u*)(KIb + (size_t)row * IDIM + hc) = w;
                            if (o) { *(f32x4*)(o + hc) = v0; *(f32x4*)(o + hc + 4) = v1; } }
                    } else if (wc == 1 && fq == 0) {
                        *(f32x4*)(WIb + (size_t)row * 8) = acc[ai][0][m][0] * WISCALE; *(f32x4*)(WIb + (size_t)row * 8 + 4) = acc[ai][0][m][1] * WISCALE;
                    }
                }
        }
    }
};

struct EpiConvCU {
    static constexpr bool PERM = true, AFTER_DRAIN = false;
    bf16* Zb; float* ocvp; float* ocvs; const float* state;
    __device__ __forceinline__ void operator()(const f32x4 (&acc)[2][2][4][2], const Unit& u, int wr, int wc, int fr, int fq) const {
        const int row0 = u.pm * 256 + wr * 64 + fr, col0 = u.pn * 128 + wc * 32 + 8 * fq;
#pragma unroll
        for (int ai = 0; ai < 2; ++ai)
#pragma unroll
            for (int m = 0; m < 4; ++m) {
                const int row = row0 + ai * 128 + m * 16;
                const f32x4 z0 = acc[ai][0][m][0] * acc[ai][1][m][0], z1 = acc[ai][0][m][1] * acc[ai][1][m][1];
                v4u w; w.x = pk2(z0[0], z0[1]); w.y = pk2(z0[2], z0[3]); w.z = pk2(z1[0], z1[1]); w.w = pk2(z1[2], z1[3]);
                *(v4u*)(Zb + (size_t)row * DM + col0) = w;
                { const int t = row & (SEQ - 1);
                    if (t >= SEQ - 2) { float* o = ocvp + ((size_t)(row >> 13) * 2 + (t - (SEQ - 2))) * DM + col0; *(f32x4*)o = z0; *(f32x4*)(o + 4) = z1; } }
            }
    }
};

struct EpiConvB {
    static constexpr bool PERM = true, AFTER_DRAIN = false;
    const bf16* Zb; bf16* A2; const float* cw; const float* state;
    __device__ __forceinline__ void operator()(const f32x4 (&acc)[2][2][4][2], const Unit& u, int wr, int wc, int fr, int fq) const {
        const int row0 = u.pm * 256 + wr * 64 + fr;
#pragma unroll
        for (int bj = 0; bj < 2; ++bj) {
            const int col0 = u.pn * 256 + bj * 128 + wc * 32 + 8 * fq;
            f32x4 w0[2], w1[2], w2[2];
#pragma unroll
            for (int n = 0; n < 2; ++n) { w0[n] = *(const f32x4*)(cw + col0 + 4 * n); w1[n] = *(const f32x4*)(cw + DM + col0 + 4 * n); w2[n] = *(const f32x4*)(cw + 2 * DM + col0 + 4 * n); }
#pragma unroll
            for (int am = 0; am < 4; ++am) { const int ai = am >> 1, mb = (am & 1) * 2;
                v4u zt[2], q1[2], q2[2];
#pragma unroll
                for (int mm = 0; mm < 2; ++mm) { const int row = row0 + ai * 128 + (mb + mm) * 16, t = row & (SEQ - 1); const bf16* zp = Zb + (size_t)row * DM + col0;
                    zt[mm] = *(const v4u*)zp; q1[mm] = *(const v4u*)(zp - (t >= 1 ? DM : 0)); q2[mm] = *(const v4u*)(zp - (t >= 2 ? 2 * DM : 0)); }
                asm volatile("" ::: "memory");
#pragma unroll
                for (int mm = 0; mm < 2; ++mm) { const int m = mb + mm; const int row = row0 + ai * 128 + m * 16, t = row & (SEQ - 1);
                    const v4u z0 = (v4u){0u, 0u, 0u, 0u}; const v4u p1 = t >= 1 ? q1[mm] : z0, p2 = t >= 2 ? q2[mm] : z0, pt = zt[mm];
                    const f32x4 a1[2] = {(f32x4){bflo(p1.x), bfhi(p1.x), bflo(p1.y), bfhi(p1.y)}, (f32x4){bflo(p1.z), bfhi(p1.z), bflo(p1.w), bfhi(p1.w)}};
                    const f32x4 a2[2] = {(f32x4){bflo(p2.x), bfhi(p2.x), bflo(p2.y), bfhi(p2.y)}, (f32x4){bflo(p2.z), bfhi(p2.z), bflo(p2.w), bfhi(p2.w)}};
                    const f32x4 c0 = (f32x4){bflo(pt.x), bfhi(pt.x), bflo(pt.y), bfhi(pt.y)}, c1 = (f32x4){bflo(pt.z), bfhi(pt.z), bflo(pt.w), bfhi(pt.w)};
                    const f32x4 y0 = (w0[0] * a2[0] + w1[0] * a1[0] + w2[0] * c0) * acc[ai][bj][m][0], y1 = (w0[1] * a2[1] + w1[1] * a1[1] + w2[1] * c1) * acc[ai][bj][m][1];
                    v4u w; w.x = pk2(y0[0], y0[1]); w.y = pk2(y0[2], y0[3]); w.z = pk2(y1[0], y1[1]); w.w = pk2(y1[2], y1[3]);
                    *(v4u*)(A2 + (size_t)row * DM + col0) = w;
                }
            }
        }
    }
};

struct Args { const float* in[20]; float* out; unsigned char* ws; int ph_lo, ph_hi; };
typedef __attribute__((address_space(4))) const unsigned char* kaptr_t;
struct PArgs {
    kaptr_t p;
    __device__ __forceinline__ const float* in(int i) const { return *(const float* const __attribute__((address_space(4)))*)(p + 8 * i); }
    __device__ __forceinline__ float* out() const { return *(float* const __attribute__((address_space(4)))*)(p + 160); }
    __device__ __forceinline__ unsigned char* ws() const { return *(unsigned char* const __attribute__((address_space(4)))*)(p + 168); }
};
static_assert(sizeof(Args) == 184, "kernarg layout");
__device__ __forceinline__ PArgs args_fresh() { kaptr_t p = (kaptr_t)__builtin_amdgcn_kernarg_segment_ptr(); asm volatile("" : "+s"(p)); PArgs a; a.p = p; return a; }
struct Frame {
    LAS unsigned char* lds; volatile LAS unsigned* MISC;
    int vcu, G;
};
struct Tid { int tid, lane, wave; };
__device__ __forceinline__ Tid tid_fresh() { int t = threadIdx.x; asm volatile("" : "+v"(t)); Tid r; r.tid = t; r.lane = t & 63; r.wave = __builtin_amdgcn_readfirstlane(t >> 6); return r; }
#define WSP(T, off) ((T*)(args.ws() + (off)))

__device__ __forceinline__ f32x4 silu4(f32x4 c) { f32x4 r; r[0] = c[0] / (1.f + __expf(-c[0])); r[1] = c[1] / (1.f + __expf(-c[1])); r[2] = c[2] / (1.f + __expf(-c[2])); r[3] = c[3] / (1.f + __expf(-c[3])); return r; }
__device__ __forceinline__ f32x4 silu4f(f32x4 c) { f32x4 r;
#pragma unroll
    for (int e = 0; e < 4; ++e) r[e] = c[e] * __builtin_amdgcn_rcpf(1.f + __builtin_amdgcn_exp2f(-1.4426950408889634f * c[e]));
    return r; }
__device__ __forceinline__ void ada_item16(const float* w_ada, const float* b_ada, const float* c_prompt, const float* c_sample, float* MOD, int item, int lane) {
    const int layer = item / 576, c0 = (item % 576) * 16; const int li = lane & 15, kk = lane >> 4;
    const float* W = w_ada + (size_t)layer * DM * MODW + c0 + li;
    f32x4 acc[2]; float pa[2] = {0.f, 0.f};
    acc[0] = acc[1] = (f32x4){0.f, 0.f, 0.f, 0.f};
#pragma unroll 4
    for (int k0 = 0; k0 < DM; k0 += 16) {
        float w[4]; f32x4 cs[2], cp[2];
#pragma unroll
        for (int st = 0; st < 4; ++st) w[st] = W[(size_t)(k0 + 4 * kk + st) * MODW];
#pragma unroll
        for (int rb = 0; rb < 2; ++rb) cs[rb] = silu4f(*(const f32x4*)(c_sample + (size_t)(16 * rb + li) * DM + k0 + 4 * kk));
#pragma unroll
        for (int b = 0; b < 2; ++b) cp[b] = silu4f(*(const f32x4*)(c_prompt + (size_t)b * DM + k0 + 4 * kk));
#pragma unroll
        for (int st = 0; st < 4; ++st) {
            acc[0] = __builtin_amdgcn_mfma_f32_16x16x4f32(cs[0][st], w[st], acc[0], 0, 0, 0);
            acc[1] = __builtin_amdgcn_mfma_f32_16x16x4f32(cs[1][st], w[st], acc[1], 0, 0, 0);
            pa[0] = fmaf(cp[0][st], w[st], pa[0]); pa[1] = fmaf(cp[1][st], w[st], pa[1]);
        }
    }
    const float bias = b_ada[(size_t)layer * MODW + c0 + li];
    float* Mo = MOD + (size_t)layer * NBATCH * MODW + c0 + li;
#pragma unroll
    for (int rb = 0; rb < 2; ++rb)
#pragma unroll
        for (int reg = 0; reg < 4; ++reg) Mo[(size_t)(2 + 16 * rb + 4 * kk + reg) * MODW] = acc[rb][reg] + bias;
#pragma unroll
    for (int b = 0; b < 2; ++b) { float v = pa[b]; v += __shfl_xor(v, 16); v += __shfl_xor(v, 32); if (kk == 0) Mo[(size_t)b * MODW] = v + bias; }
}
__device__ __forceinline__ void ada_item_wg(Frame& F, const float* w_ada, const float* b_ada, const float* c_prompt, const float* c_sample, float* MOD, int item, const Tid T) {
    const int lane = T.lane, wave = T.wave;
    const int layer = item / 576, c0 = (item % 576) * 16; const int li = lane & 15, kk = lane >> 4;
    const float* W = w_ada + (size_t)layer * DM * MODW + c0 + li;
    f32x4 acc[2]; float pa[2] = {0.f, 0.f};
    acc[0] = acc[1] = (f32x4){0.f, 0.f, 0.f, 0.f};
    const int kb = wave * 128;
    float w[8][4]; f32x4 cs[8][2], cp[8][2];
#pragma unroll
    for (int i = 0; i < 8; ++i) { const int k0 = kb + 16 * i;
#pragma unroll
        for (int st = 0; st < 4; ++st) w[i][st] = W[(size_t)(k0 + 4 * kk + st) * MODW];
#pragma unroll
        for (int rb = 0; rb < 2; ++rb) cs[i][rb] = *(const f32x4*)(c_sample + (size_t)(16 * rb + li) * DM + k0 + 4 * kk);
#pragma unroll
        for (int b = 0; b < 2; ++b) cp[i][b] = *(const f32x4*)(c_prompt + (size_t)b * DM + k0 + 4 * kk); }
    asm volatile("" ::: "memory");
#pragma unroll
    for (int i = 0; i < 8; ++i) { const f32x4 s0 = silu4f(cs[i][0]), s1 = silu4f(cs[i][1]), p0 = silu4f(cp[i][0]), p1 = silu4f(cp[i][1]);
#pragma unroll
        for (int st = 0; st < 4; ++st) {
            acc[0] = __builtin_amdgcn_mfma_f32_16x16x4f32(s0[st], w[i][st], acc[0], 0, 0, 0);
            acc[1] = __builtin_amdgcn_mfma_f32_16x16x4f32(s1[st], w[i][st], acc[1], 0, 0, 0);
            pa[0] = fmaf(p0[st], w[i][st], pa[0]); pa[1] = fmaf(p1[st], w[i][st], pa[1]);
        } }
    LAS float* red = (LAS float*)(F.lds + RING_OFF);
#pragma unroll
    for (int r = 0; r < 8; ++r) red[(wave * 10 + r) * 64 + lane] = acc[r >> 2][r & 3];
    red[(wave * 10 + 8) * 64 + lane] = pa[0]; red[(wave * 10 + 9) * 64 + lane] = pa[1];
    __syncthreads();
    const float bias = b_ada[(size_t)layer * MODW + c0 + li];
    float* Mo = MOD + (size_t)layer * NBATCH * MODW + c0 + li;
    { float s = 0.f;
#pragma unroll
      for (int ww = 0; ww < 8; ++ww) s += red[(ww * 10 + wave) * 64 + lane];
      Mo[(size_t)(2 + 16 * (wave >> 2) + 4 * kk + (wave & 3)) * MODW] = s + bias; }
    if (wave < 2) { float v = 0.f;
#pragma unroll
      for (int ww = 0; ww < 8; ++ww) v += red[(ww * 10 + 8 + wave) * 64 + lane];
      v += __shfl_xor(v, 16); v += __shfl_xor(v, 32); if (kk == 0) Mo[(size_t)wave * MODW] = v + bias; }
    __syncthreads();
}
__device__ __forceinline__ void titem_load(const float* W, int ldn, int nvalid, int sc0, int k0, int lane, f32x4 (&v)[8]) {
    const int rr = lane >> 3, c4 = 4 * (lane & 7); const bool ok = sc0 + c4 < nvalid;
    const float* src = W + (size_t)(k0 + rr) * ldn + sc0 + c4;
#pragma unroll
    for (int i = 0; i < 8; ++i) v[i] = ok ? *(const f32x4*)(src + (size_t)(8 * i) * ldn) : (f32x4){0.f, 0.f, 0.f, 0.f};
}
__device__ __forceinline__ void titem_store(const f32x4 (&v)[8], int K, bf16* WT, int n0, int k0, LAS float* scr, int lane) {
    const int rr = lane >> 3, c4 = 4 * (lane & 7);
#pragma unroll
    for (int i = 0; i < 8; ++i) { LAS float* d = scr + (8 * i + rr) * 33 + c4; d[0] = v[i][0]; d[1] = v[i][1]; d[2] = v[i][2]; d[3] = v[i][3]; }
    LDS_WAIT(); asm volatile("" ::: "memory");
    const int c = lane & 7;
#pragma unroll
    for (int j = 0; j < 4; ++j) { const int n = (lane >> 3) + 8 * j; const LAS float* s = scr + (8 * c) * 33 + n;
        v4u o; o.x = pk2(s[0 * 33], s[1 * 33]); o.y = pk2(s[2 * 33], s[3 * 33]); o.z = pk2(s[4 * 33], s[5 * 33]); o.w = pk2(s[6 * 33], s[7 * 33]);
        *(GAS v4u*)(WT + (size_t)(n0 + n) * K + k0 + 8 * c) = o; }
    LDS_WAIT(); asm volatile("" ::: "memory");
}
__device__ __forceinline__ int src_col_ffn(int nb) { const int p = 32 * nb, tile = p >> 8, w = p & 255; return w < 128 ? 128 * tile + w : DFF + 128 * tile + (w - 128); }
__device__ __forceinline__ int src_col_att(int nb) { const int p = 32 * nb, tile = p >> 8, w = p & 255; return 256 * tile + 64 * ((w >> 5) & 3) + 32 * (w >> 7); }
__device__ __forceinline__ int src_col_ccu(int nb) { const int p = 32 * nb, tile = p >> 8, w = p & 255; return w < 128 ? DM + 128 * tile + w : 2 * DM + 128 * tile + (w - 128); }

namespace wc {
constexpr int I_FI = 16 * 176, I_FO = 44 * 32, I_AI = 16 * 72, I_SQ = 16 * 32, I_CU = 16 * 64;
constexpr int OFF_FI = 0, OFF_FO = OFF_FI + 8 * I_FI, OFF_AI = OFF_FO + 8 * I_FO, OFF_AO = OFF_AI + 2 * I_AI, OFF_CU = OFF_AO + 2 * I_SQ, OFF_CB = OFF_CU + 2 * I_CU, OFF_CO = OFF_CB + 2 * I_SQ;
}
__device__ __forceinline__ void convert_set(Frame& F, int code, int w, int nw) {
    using namespace wc;
    const PArgs args = args_fresh(); const Tid T = tid_fresh();
    LAS float* scr = (LAS float*)(F.lds + RING_OFF + T.wave * 16384);
    int lo0, n0, lo1, n1, lo2 = 0, n2 = 0;
    if (code < 8) { lo0 = OFF_FI + code * I_FI; n0 = I_FI; lo1 = OFF_FO + code * I_FO; n1 = I_FO; }
    else if (code < 10) { const int li = code - 8; lo0 = OFF_AI + li * I_AI; n0 = I_AI; lo1 = OFF_AO + li * I_SQ; n1 = I_SQ; }
    else { const int li = code - 10; lo0 = OFF_CU + li * I_CU; n0 = I_CU; lo1 = OFF_CB + li * I_SQ; n1 = I_SQ; lo2 = OFF_CO + li * I_SQ; n2 = I_SQ; }
    const int ntot = n0 + n1 + n2;
    struct TD { const float* W; bf16* WT; int K, ldn, nvalid, n0, sc0, k0; };
    auto decode = [&](int v) __attribute__((always_inline)) -> TD {
        int r = v < n0 ? lo0 + v : (v < n0 + n1 ? lo1 + (v - n0) : lo2 + (v - n0 - n1)); TD t;
        if (r < 8 * I_FI) { const int s = r / I_FI, q = r % I_FI, nb = q % 176, kb = q / 176;
            t = TD{args.in(11) + (size_t)s * DM * NFFIN, WSP(bf16, WS_WFI) + (size_t)s * NFFIN * DM, DM, NFFIN, NFFIN, 32 * nb, src_col_ffn(nb), 64 * kb}; return t; } r -= 8 * I_FI;
        if (r < 8 * I_FO) { const int s = r / I_FO, q = r % I_FO, nb = q % 32, kb = q / 32;
            t = TD{args.in(12) + (size_t)s * DFF * DM, WSP(bf16, WS_WFO) + (size_t)s * DM * DFF, DFF, DM, DM, 32 * nb, 32 * nb, 64 * kb}; return t; } r -= 8 * I_FO;
        if (r < 2 * I_AI) { const int s = r / I_AI, q = r % I_AI, nb = q % 72, kb = q / 72;
            t = TD{args.in(13) + (size_t)s * DM * ATT_COLS, WSP(bf16, WS_WAI) + (size_t)s * ATT_NP * DM, DM, ATT_COLS, ATT_COLS, 32 * nb, src_col_att(nb), 64 * kb}; return t; } r -= 2 * I_AI;
        if (r < 2 * I_SQ) { const int s = r / I_SQ, q = r % I_SQ, nb = q % 32, kb = q / 32;
            t = TD{args.in(14) + (size_t)s * DM * DM, WSP(bf16, WS_WAO) + (size_t)s * DM * DM, DM, DM, DM, 32 * nb, 32 * nb, 64 * kb}; return t; } r -= 2 * I_SQ;
        if (r < 2 * I_CU) { const int s = r / I_CU, q = r % I_CU, nb = q % 64, kb = q / 64;
            t = TD{args.in(17) + (size_t)s * DM * 3 * DM, WSP(bf16, WS_WCU) + (size_t)s * 2 * DM * DM, DM, 3 * DM, 3 * DM, 32 * nb, src_col_ccu(nb), 64 * kb}; return t; } r -= 2 * I_CU;
        if (r < 2 * I_SQ) { const int s = r / I_SQ, q = r % I_SQ, nb = q % 32, kb = q / 32;
            t = TD{args.in(17) + (size_t)s * DM * 3 * DM, WSP(bf16, WS_WCB) + (size_t)s * DM * DM, DM, 3 * DM, 3 * DM, 32 * nb, 32 * nb, 64 * kb}; return t; } r -= 2 * I_SQ;
        { const int s = r / I_SQ, q = r % I_SQ, nb = q % 32, kb = q / 32;
            t = TD{args.in(19) + (size_t)s * DM * DM, WSP(bf16, WS_WCO) + (size_t)s * DM * DM, DM, DM, DM, 32 * nb, 32 * nb, 64 * kb}; return t; }
    };
    f32x4 va[8], vb[8], vc[8], vd[8];
    const int npair = (ntot + 1) >> 1;
#define CV_LOAD(P, X, Y) do { const TD t_ = decode(2 * (P)); titem_load(t_.W, t_.ldn, t_.nvalid, t_.sc0, t_.k0, T.lane, X); \
        if (2 * (P) + 1 < ntot) { const TD u_ = decode(2 * (P) + 1); titem_load(u_.W, u_.ldn, u_.nvalid, u_.sc0, u_.k0, T.lane, Y); } } while (0)
#define CV_STORE(P, X, Y) do { const TD t_ = decode(2 * (P)); titem_store(X, t_.K, t_.WT, t_.n0, t_.k0, scr, T.lane); \
        if (2 * (P) + 1 < ntot) { const TD u_ = decode(2 * (P) + 1); titem_store(Y, u_.K, u_.WT, u_.n0, u_.k0, scr, T.lane); } } while (0)
    if (w < npair) CV_LOAD(w, va, vb);
#pragma unroll 1
    for (int p = w; p < npair; p += 2 * nw) {
        const bool hb = p + nw < npair, hc = p + 2 * nw < npair;
        if (hb) CV_LOAD(p + nw, vc, vd);
        CV_STORE(p, va, vb);
        if (hc) CV_LOAD(p + 2 * nw, va, vb);
        if (hb) CV_STORE(p + nw, vc, vd);
    }
#undef CV_LOAD
#undef CV_STORE
}
__device__ __forceinline__ void convert_in_tail(Frame& F, int code, int first_idle) {
    if (code < 0 || (int)blockIdx.x < first_idle) return;
    const int wv = __builtin_amdgcn_readfirstlane((int)threadIdx.x >> 6);
    convert_set(F, code, ((int)blockIdx.x - first_idle) * NWAVES + wv, (F.G - first_idle) * NWAVES);
}

__device__ __forceinline__ void p0_prologue(Frame& F) {
    const PArgs args = args_fresh(); const Tid T = tid_fresh();
    const int gw = F.vcu * NWAVES + T.wave, NGW = F.G * NWAVES;
    if (gw < 2304) ada_item16(args.in(9), args.in(10), args.in(7), args.in(8), WSP(float, WS_MOD), gw, T.lane);
#pragma unroll 1
    for (int it = NGW + F.vcu; it < 2304; it += F.G) ada_item_wg(F, args.in(9), args.in(10), args.in(7), args.in(8), WSP(float, WS_MOD), it, tid_fresh());
#pragma unroll 1
    for (int k = 0; k < 3; ++k) { const int rot = k == 0 ? 0 : (k == 1 ? NGW - 128 : NGW - 64); convert_set(F, k == 0 ? 0 : (k == 1 ? 8 : 1), (gw + rot) % NGW, NGW); }
}

__device__ __forceinline__ void mod_phase(Frame& F, int layer, int which) {
    const PArgs args = args_fresh(); const Tid T = tid_fresh();
    const int gw = F.vcu * NWAVES + T.wave, NGW = F.G * NWAVES;
    float* X = WSP(float, WS_X); bf16* H = WSP(bf16, WS_H);
    const float* mod = WSP(float, WS_MOD) + (size_t)layer * NBATCH * MODW + which * 3 * DM;
    for (int m = gw; m < MROWS; m += NGW) {
        const float* mb = mod + (size_t)batch_of(m) * MODW + 4 * T.lane;
        f32x4 v[4]; float s = 0.f;
        const float* src = m < MP ? args.in(0) + (size_t)m * DM : (m < MVALID ? args.in(1) + (size_t)(m - MP) * DM : nullptr);
        f32x4 shv[4], scv[4];
#pragma unroll
        for (int j = 0; j < 4; ++j) { v[j] = src ? *(const f32x4*)(src + 4 * T.lane + 256 * j) : (f32x4){0.f, 0.f, 0.f, 0.f}; shv[j] = *(const f32x4*)(mb + 256 * j); scv[j] = *(const f32x4*)(mb + DM + 256 * j); }
        asm volatile("" ::: "memory");
#pragma unroll
        for (int j = 0; j < 4; ++j) { *(f32x4*)(X + (size_t)m * DM + 4 * T.lane + 256 * j) = v[j];
            s += (v[j][0] * v[j][0] + v[j][1] * v[j][1]) + (v[j][2] * v[j][2] + v[j][3] * v[j][3]); }
        const float rstd = __builtin_amdgcn_rsqf(wave_sum(s) * (1.f / DM) + RMS_EPS);
#pragma unroll
        for (int j = 0; j < 4; ++j) { const f32x4 sh = shv[j], sc = scv[j];
            const f32x4 h = v[j] * rstd * (sc + 1.f) + sh; v2u o; o.x = pk2(h[0], h[1]); o.y = pk2(h[2], h[3]);
            *(v2u*)(H + (size_t)m * DM + 4 * T.lane + 256 * j) = o; }
    }
}


namespace a1 {
constexpr int CAP = 768, NE = CAP / 64;
constexpr int KT = 128;
constexpr int LDS_KT = 0, LDS_BUF = 32768;
constexpr int LDS_CNT = LDS_BUF + 8 * 4 * CAP * 4;
typedef _Float16 h2 __attribute__((ext_vector_type(2)));
typedef _Float16 h8 __attribute__((ext_vector_type(8)));
typedef _Float16 h4 __attribute__((ext_vector_type(4)));
typedef float f32x8_t __attribute__((ext_vector_type(8)));
typedef short s16x4_t __attribute__((ext_vector_type(4)));
typedef short s16x8_t __attribute__((ext_vector_type(8)));
__device__ __forceinline__ unsigned pkh(float a, float b) { const h2 t = __builtin_convertvector((f32x2){a, b}, h2); return __builtin_bit_cast(unsigned, t); }
__device__ __forceinline__ int mbcnt64(unsigned long long m) { return (int)__builtin_amdgcn_mbcnt_hi((unsigned)(m >> 32), __builtin_amdgcn_mbcnt_lo((unsigned)m, 0u)); }

template <bool EXACT>
__device__ __forceinline__ unsigned compact(LAS unsigned* buf, int n, int lane, int& kept, LAS unsigned* dump) {
    unsigned e[NE]; unsigned mx = 0u, mn = 0xFFFFFFFFu;
#pragma unroll
    for (int j = 0; j < NE; ++j) { const int i = lane + 64 * j; const bool ok = i < n; e[j] = ok ? buf[i] : 0u; mx = max(mx, e[j]); mn = min(mn, ok ? e[j] : 0xFFFFFFFFu); }
#pragma unroll
    for (int o = 1; o < 64; o <<= 1) { mx = max(mx, (unsigned)__shfl_xor((int)mx, o)); mn = min(mn, (unsigned)__shfl_xor((int)mn, o)); }
    mx = __builtin_amdgcn_readfirstlane(mx); mn = __builtin_amdgcn_readfirstlane(mn);
    const int hb = 31 - __builtin_clz(mx ^ mn);
    const unsigned base = hb >= 31 ? 0u : (mx >> (hb + 1)) << (hb + 1);
    unsigned T = base; int cT = n; bool have = false;
    if (!EXACT) {
        const int ms = min(max(n, 0), 64) + min(max(n - 256, 0), 64) + min(max(n - 512, 0), 64);
        const int ks = max(1, (ms * 320) / n);
        unsigned Ts = base;
        for (int b = hb; b >= 0; --b) {
            const unsigned tr = Ts | (1u << b);
            const int c = __popcll(__ballot(e[0] >= tr)) + __popcll(__ballot(e[4] >= tr)) + __popcll(__ballot(e[8] >= tr));
            if (c >= ks) { Ts = tr; if (c == ks) break; }
        }
        int c = 0;
#pragma unroll
        for (int j = 0; j < NE; ++j) c += __popcll(__ballot(e[j] >= Ts));
        if (c >= TOPK) { T = Ts; cT = c; have = true; }
    }
    if (!have) {
        T = base; cT = n;
        for (int b = hb; b >= 0; --b) {
            const unsigned tr = T | (1u << b); int c = 0;
#pragma unroll
            for (int j = 0; j < NE; ++j) c += __popcll(__ballot(e[j] >= tr));
            if (c >= TOPK) { T = tr; cT = c; if (c == TOPK) break; }
        }
    }
    int bs = 0;
#pragma unroll
    for (int j = 0; j < NE; ++j) { const bool keep = e[j] >= T; const unsigned long long m = __ballot(keep); const int pos = bs + mbcnt64(m); LAS unsigned* d = keep ? buf + pos : dump; *d = e[j]; bs += __popcll(m); }
    kept = cT;
    return T;
}

__device__ __forceinline__ unsigned prune_given(LAS unsigned* buf, int n, int lane, int& kept, LAS unsigned* dump, unsigned Ts) {
    unsigned e[NE]; int c = 0;
#pragma unroll
    for (int j = 0; j < NE; ++j) { const int i = lane + 64 * j; e[j] = i < n ? buf[i] : 0u; }
#pragma unroll
    for (int j = 0; j < NE; ++j) c += __popcll(__ballot(e[j] >= Ts));
    if (c < TOPK || Ts == 0u) return compact<true>(buf, n, lane, kept, dump);
    int bs = 0;
#pragma unroll
    for (int j = 0; j < NE; ++j) { const bool keep = e[j] >= Ts; const unsigned long long m = __ballot(keep); const int pos = bs + mbcnt64(m); LAS unsigned* d = keep ? buf + pos : dump; *d = e[j]; bs += __popcll(m); }
    kept = c;
    return Ts;
}
constexpr int PRUNE_MIN = 448;
__device__ __forceinline__ void prune4(LAS unsigned* mybuf, int lane, int hi, int& cntA, int& cntB, unsigned& tauA, unsigned& tauB, LAS unsigned* dump) {
    int n[4]; n[0] = __builtin_amdgcn_readlane(cntA, 0); n[1] = __builtin_amdgcn_readlane(cntB, 0); n[2] = __builtin_amdgcn_readlane(cntA, 32); n[3] = __builtin_amdgcn_readlane(cntB, 32);
    unsigned s0[4], s1[4], s2[4], Ts[4]; int ks[4]; bool done[4];
#pragma unroll
    for (int q = 0; q < 4; ++q) { const bool act = n[q] > PRUNE_MIN; LAS unsigned* b = mybuf + q * CAP; const int nn = act ? n[q] : 0;
        s0[q] = lane < nn ? b[lane] : 0u; s1[q] = lane + 256 < nn ? b[lane + 256] : 0u; s2[q] = lane + 512 < nn ? b[lane + 512] : 0u;
        const int ms = min(nn, 64) + min(max(nn - 256, 0), 64) + min(max(nn - 512, 0), 64);
        ks[q] = act ? max(1, (ms * 320) / nn) : 0; Ts[q] = 0u; done[q] = !act; }
#pragma unroll 1
    for (int b = 31; b >= 13; --b) {
#pragma unroll
        for (int q = 0; q < 4; ++q) { const unsigned tr = Ts[q] | (1u << b);
            const int c = __popcll(__ballot(s0[q] >= tr)) + __popcll(__ballot(s1[q] >= tr)) + __popcll(__ballot(s2[q] >= tr));
            const bool take = !done[q] && c >= ks[q]; Ts[q] = take ? tr : Ts[q]; done[q] = done[q] || (take && c == ks[q]); }
        if (done[0] && done[1] && done[2] && done[3]) break;
    }
#pragma unroll
    for (int q = 0; q < 4; ++q) if (n[q] > PRUNE_MIN) { int kept; unsigned T = prune_given(mybuf + q * CAP, n[q], lane, kept, dump, Ts[q]);
        if (kept > CAP - 128) T = compact<true>(mybuf + q * CAP, kept, lane, kept, dump);
        if (hi == (q >> 1)) { if (q & 1) { cntB = kept; tauB = T; } else { cntA = kept; tauA = T; } } }
}

__device__ __forceinline__ void prompt_unit(Frame& F, int b, int blk) {
    const PArgs args = args_fresh(); const Tid TI = tid_fresh();
    LAS unsigned char* lds = F.lds;
    const int tid = TI.tid, lane = TI.lane, wave = TI.wave, r = lane & 31, hi = lane >> 5;
    const int q0 = blk * 32, qw = q0 + 4 * wave; const size_t rowbase = (size_t)b * SEQ;
    const bf16* QIb = WSP(bf16, WS_QI); const bf16* KIb = WSP(bf16, WS_KI); const float* WIb = WSP(float, WS_WI);
    const bf16* Qb = WSP(bf16, WS_Q); const bf16* Kb = WSP(bf16, WS_K); const bf16* Vb = WSP(bf16, WS_V); bf16* Ob = WSP(bf16, WS_O);
    bf16x8 qa[4];
    { const int ri = r & 3, rh = (r >> 2) & 1, rg = r >> 3, aq = 2 * rh + (rg >> 1), ah = 4 * (rg & 1) + ri;
      const bf16* p = QIb + (rowbase + qw + aq) * IQW + ah * 64 + 8 * hi;
#pragma unroll
      for (int s = 0; s < 4; ++s) qa[s] = *(const bf16x8*)(p + 16 * s); }
    float wA[8], wB[8];
    { const float* p = WIb + (rowbase + qw + 2 * hi) * 8; const f32x4 a0 = *(const f32x4*)p, a1 = *(const f32x4*)(p + 4), b0 = *(const f32x4*)(p + 8), b1 = *(const f32x4*)(p + 12);
#pragma unroll
      for (int i = 0; i < 4; ++i) { wA[i] = a0[i]; wA[4 + i] = a1[i]; wB[i] = b0[i]; wB[4 + i] = b1[i]; } }
    LAS unsigned* mybuf = (LAS unsigned*)(lds + LDS_BUF) + wave * 4 * CAP;
    if (wave >= 4) __builtin_amdgcn_s_setprio(1);
    LAS unsigned* bufA = mybuf + (2 * hi) * CAP; LAS unsigned* bufB = bufA + CAP;
    int cntA = 0, cntB = 0; unsigned tauA = 0u, tauB = 0u;
#ifndef PROBE_SC
#define PROBE_SC 1
#endif
#pragma unroll 1
    for (int rep_sc = 0; rep_sc < PROBE_SC; ++rep_sc) { cntA = 0; cntB = 0; tauA = 0u; tauB = 0u;
    const int qposA = qw + 2 * hi, qposB = qposA + 1;
    const int ntile = (q0 + 31) / KT + 1;
    const char* kbase = (const char*)(KIb + rowbase * IDIM);
    const int so0 = 16 * tid, so1 = so0 + 8192;
    const int sd0 = (so0 >> 7) * 128 + ((((so0 >> 4) & 7) ^ ((so0 >> 8) & 7)) << 4), sd1 = (so1 >> 7) * 128 + ((((so1 >> 4) & 7) ^ ((so1 >> 8) & 7)) << 4);
    auto compute_tile = [&](int t) __attribute__((always_inline)) {
        LAS unsigned char* kt = lds + LDS_KT + (t & 1) * 16384;
        LAS unsigned* flg = (LAS unsigned*)(lds + LDS_CNT + 128);
        const unsigned fl = flg[(t + 2) % 3];
        if (tid == 0) flg[(t + 1) % 3] = 0u;
        if (__builtin_amdgcn_readfirstlane(fl) != 0u) prune4(mybuf, lane, hi, cntA, cntB, tauA, tauB, (LAS unsigned*)(lds + LDS_CNT) + wave);
        if (t * KT > qw + 3) return;
        bf16x8 kf[4][4];
#pragma unroll
        for (int sub = 0; sub < 4; ++sub) { const int key = 32 * sub + r;
#pragma unroll
            for (int s = 0; s < 4; ++s) kf[sub][s] = *(const LAS bf16x8*)(kt + key * 128 + ((((2 * s + hi) ^ ((key >> 1) & 7))) << 4)); }
        f32x16 D[4];
#pragma unroll
        for (int sub = 0; sub < 4; ++sub) D[sub] = (f32x16){};
#pragma unroll
        for (int s = 0; s < 4; ++s)
#pragma unroll
            for (int sub = 0; sub < 4; ++sub) D[sub] = __builtin_amdgcn_mfma_f32_32x32x16_bf16(qa[s], kf[sub][s], D[sub], 0, 0, 0);
        unsigned uA[4], uB[4];
#pragma unroll
        for (int sub = 0; sub < 4; ++sub) {
            float sA = 0.f, sB = 0.f;
#pragma unroll
            for (int i = 0; i < 8; ++i) {
                const float ra = __int_as_float(max(__float_as_int(D[sub][i]), 0)), rb = __int_as_float(max(__float_as_int(D[sub][8 + i]), 0));
                sA = fmaf(wA[i], ra, sA); sB = fmaf(wB[i], rb, sB); }
            const int kidx = t * KT + 32 * sub + r; const unsigned ipart = (unsigned)(8191 - kidx);
            unsigned a = __float_as_uint(sA), b2 = __float_as_uint(sB);
            a ^= (unsigned)(((int)a >> 31) | (int)0x80000000); b2 ^= (unsigned)(((int)b2 >> 31) | (int)0x80000000);
            a = (a & 0xFFFFE000u) | ipart; b2 = (b2 & 0xFFFFE000u) | ipart;
            uA[sub] = kidx <= qposA ? a : 0u; uB[sub] = kidx <= qposB ? b2 : 0u;
        }
        LAS unsigned* dump = (LAS unsigned*)(lds + LDS_CNT) + wave;
#pragma unroll
        for (int sub = 0; sub < 4; ++sub) {
            const bool pA = uA[sub] > tauA, pB = uB[sub] > tauB;
            const unsigned long long mA = __builtin_amdgcn_ballot_w64(pA), mB = __builtin_amdgcn_ballot_w64(pB);
            const int loA = __popc((unsigned)mA), loB = __popc((unsigned)mB), hiA = __popc((unsigned)(mA >> 32)), hiB = __popc((unsigned)(mB >> 32));
            const int preA = mbcnt64(mA) - (hi ? loA : 0), preB = mbcnt64(mB) - (hi ? loB : 0);
            LAS unsigned* dA = pA ? bufA + cntA + preA : dump; LAS unsigned* dB = pB ? bufB + cntB + preB : dump;
            *dA = uA[sub]; *dB = uB[sub];
            cntA += hi ? hiA : loA; cntB += hi ? hiB : loB;
        }
        if (__builtin_amdgcn_ballot_w64(cntA > CAP - 128 || cntB > CAP - 128) != 0ull) { if (lane == 0) flg[t % 3] = 1u; }
    };
    v4u pa0, pa1, pb0, pb1;
    pa0 = *(const v4u*)(kbase + so0); pa1 = *(const v4u*)(kbase + so1);
    *(LAS v4u*)(lds + LDS_KT + sd0) = pa0; *(LAS v4u*)(lds + LDS_KT + sd1) = pa1;
    pb0 = pa0; pb1 = pa1;
    if (tid < 3) ((LAS unsigned*)(lds + LDS_CNT + 128))[tid] = 0u;
    if (ntile > 1) { pb0 = *(const v4u*)(kbase + 16384 + so0); pb1 = *(const v4u*)(kbase + 16384 + so1); }
    __syncthreads();
#pragma unroll 1
    for (int t = 0; t < ntile; t += 2) {
        if (t + 2 < ntile) { pa0 = *(const v4u*)(kbase + (size_t)(t + 2) * 16384 + so0); pa1 = *(const v4u*)(kbase + (size_t)(t + 2) * 16384 + so1); }
        compute_tile(t);
        if (t + 1 < ntile) { *(LAS v4u*)(lds + LDS_KT + 16384 + sd0) = pb0; *(LAS v4u*)(lds + LDS_KT + 16384 + sd1) = pb1; }
        __syncthreads();
        if (t + 1 < ntile) {
            if (t + 3 < ntile) { pb0 = *(const v4u*)(kbase + (size_t)(t + 3) * 16384 + so0); pb1 = *(const v4u*)(kbase + (size_t)(t + 3) * 16384 + so1); }
            compute_tile(t + 1);
            if (t + 2 < ntile) { *(LAS v4u*)(lds + LDS_KT + sd0) = pa0; *(LAS v4u*)(lds + LDS_KT + sd1) = pa1; }
            __syncthreads();
        }
    }
    }
    __builtin_amdgcn_s_setprio(0);
    unsigned short* IDXg = WSP(unsigned short, WS_IDX); int* NSELg = WSP(int, WS_NSEL);
#pragma unroll
    for (int qq = 0; qq < 4; ++qq) { int n = __builtin_amdgcn_readlane((qq & 1) ? cntB : cntA, (qq >> 1) * 32);
        if (n > TOPK) { int kept; (void)compact<true>(mybuf + qq * CAP, n, lane, kept, (LAS unsigned*)(lds + LDS_CNT) + wave); n = TOPK; }
        const v4u e4 = *(const LAS v4u*)(mybuf + qq * CAP + 4 * lane);
        v2u o;
        { const unsigned i0 = 4 * lane < n ? 8191u - (e4.x & 8191u) : 0u, i1 = 4 * lane + 1 < n ? 8191u - (e4.y & 8191u) : 0u, i2 = 4 * lane + 2 < n ? 8191u - (e4.z & 8191u) : 0u, i3 = 4 * lane + 3 < n ? 8191u - (e4.w & 8191u) : 0u;
          o.x = i0 | (i1 << 16); o.y = i2 | (i3 << 16); }
        const size_t row = rowbase + qw + qq;
        *(v2u*)(IDXg + row * TOPK + 4 * lane) = o;
        if (lane == 0) NSELg[row] = n; }
    LDS_WAIT();
    __syncthreads();
}

__device__ __forceinline__ void attend_wave(Frame& F, int b, int g, int t0) {
    const PArgs args = args_fresh(); const Tid TI = tid_fresh();
    const int lane = TI.lane, wave = TI.wave;
    const bf16* Qb = WSP(bf16, WS_Q); const bf16* Kb = WSP(bf16, WS_K); const bf16* Vb = WSP(bf16, WS_V); bf16* Ob = WSP(bf16, WS_O);
    const unsigned short* IDXg = WSP(unsigned short, WS_IDX); const int* NSELg = WSP(int, WS_NSEL);
    LAS unsigned char* Ks = F.lds + wave * 16384;
    LAS unsigned char* Vs = Ks + 8192;
    const size_t rowbase = (size_t)b * SEQ;
    const bf16* Kg = Kb + (size_t)(b * 4 + g) * SEQ * 64; const bf16* Vg = Vb + (size_t)(b * 4 + g) * SEQ * 64;
#define AT_KIDX(K, H, G) ((int)((K[H][((G) & 7) >> 1] >> (16 * ((G) & 1))) & 0xffffu))
#define AT_GATHER(K, BASE, C, dst) do { _Pragma("unroll") for (int i_ = 0; i_ < 8; ++i_) dst[i_] = *(const v4u*)((const char*)(BASE) + (unsigned)(AT_KIDX(K, i_ & 1, 4 * (C) + (i_ >> 1)) * 128 + 16 * (c8 ^ ks))); } while (0)
    v4u kA[2], kB[2], nA[2], nB[2]; bf16x8 bq0 = {}, bq1 = {}, bqn0 = {}, bqn1 = {};
    v4u kr[2][8], vr[2][8];
    { const int j = lane & 15, fq = lane >> 4, ks = lane >> 3, c8 = lane & 7; const size_t row = rowbase + t0;
#pragma unroll
      for (int h = 0; h < 2; ++h) { kA[h] = *(const v4u*)(IDXg + row * TOPK + 16 * (8 * h + ks)); kB[h] = *(const v4u*)(IDXg + row * TOPK + 16 * (8 * h + ks) + 8); }
      if (j < 4) { const bf16* qp = Qb + row * DM + (4 * g + j) * 64 + 8 * fq; bq0 = *(const bf16x8*)qp; bq1 = *(const bf16x8*)(qp + 32); }
      AT_GATHER(kA, Kg, 0, kr[0]); AT_GATHER(kA, Kg, 1, kr[1]); }
#pragma unroll 1
    for (int qi = 0; qi < 32; ++qi) {
        int lq = lane; asm volatile("" : "+v"(lq));
        const int j = lq & 15, fq = lq >> 4, ks = lq >> 3, c8 = lq & 7;
        const size_t row = rowbase + t0 + qi; const int nsel = NSELg[row];
        const size_t rown = rowbase + t0 + min(qi + 1, 31);
        f32x4 lg[16];
#pragma unroll
        for (int C = 0; C < 4; ++C) {
#pragma unroll
            for (int i = 0; i < 8; ++i) *(LAS v4u*)(Ks + (8 * i + ks) * 128 + c8 * 16) = kr[C & 1][i];
            if (C + 2 < 4) AT_GATHER(kB, Kg, C + 2, kr[C & 1]);
            if (C == 2) AT_GATHER(kA, Vg, 0, vr[0]);
            if (C == 3) AT_GATHER(kA, Vg, 1, vr[1]);
#pragma unroll
            for (int gg = 0; gg < 4; ++gg) { const int G = 4 * C + gg; const int rr = 16 * gg + j;
                const bf16x8 a0 = *(const LAS bf16x8*)(Ks + rr * 128 + ((fq ^ (j & 7)) << 4)), a1 = *(const LAS bf16x8*)(Ks + rr * 128 + (((4 + fq) ^ (j & 7)) << 4));
                f32x4 acc = {0.f, 0.f, 0.f, 0.f};
                acc = __builtin_amdgcn_mfma_f32_16x16x32_bf16(a0, bq0, acc, 0, 0, 0);
                acc = __builtin_amdgcn_mfma_f32_16x16x32_bf16(a1, bq1, acc, 0, 0, 0);
                lg[G] = acc; }
        }
#pragma unroll
        for (int h = 0; h < 2; ++h) { nA[h] = *(const v4u*)(IDXg + rown * TOPK + 16 * (8 * h + ks)); nB[h] = *(const v4u*)(IDXg + rown * TOPK + 16 * (8 * h + ks) + 8); }
        if (j < 4) { const bf16* qp = Qb + rown * DM + (4 * g + j) * 64 + 8 * fq; bqn0 = *(const bf16x8*)qp; bqn1 = *(const bf16x8*)(qp + 32); }
        if (nsel < TOPK) {
#pragma unroll
            for (int G = 0; G < 16; ++G)
#pragma unroll
                for (int reg = 0; reg < 4; ++reg) if (16 * (4 * fq + reg) + G >= nsel) lg[G][reg] = -INFINITY;
        }
        float mx = -INFINITY, mx2 = -INFINITY;
#pragma unroll
        for (int G = 0; G < 16; ++G) { mx = fmaxf(fmaxf(mx, lg[G][0]), lg[G][1]); mx2 = fmaxf(fmaxf(mx2, lg[G][2]), lg[G][3]); }
        mx = fmaxf(mx, mx2);
        mx = fmaxf(mx, __shfl_xor(mx, 16)); mx = fmaxf(mx, __shfl_xor(mx, 32));
        h8 pb[8];
#pragma unroll
        for (int kk = 0; kk < 8; ++kk) { f32x8_t pv;
#pragma unroll
            for (int e = 0; e < 8; ++e) pv[e] = __builtin_amdgcn_exp2f(lg[2 * kk + (e >> 2)][e & 3] - mx);
            pb[kk] = __builtin_convertvector(pv, h8); }
        f32x4 osum = (f32x4){0.f, 0.f, 0.f, 0.f};
        { const _Float16 one = (_Float16)1.0f; h8 ones = {one, one, one, one, one, one, one, one}; asm volatile("" : "+v"(ones));
#pragma unroll
          for (int kk = 0; kk < 8; ++kk) osum = __builtin_amdgcn_mfma_f32_16x16x32_f16(ones, pb[kk], osum, 0, 0, 0); }
        f32x4 oacc[4];
#pragma unroll
        for (int db = 0; db < 4; ++db) oacc[db] = (f32x4){0.f, 0.f, 0.f, 0.f};
        const int tq_ = (lq >> 2) & 3, tp_ = lq & 3;
#pragma unroll
        for (int C = 0; C < 4; ++C) {
#pragma unroll
            for (int i = 0; i < 8; ++i) *(LAS v4u*)(Vs + (8 * i + ks) * 128 + c8 * 16) = vr[C & 1][i];
            if (C + 2 < 4) AT_GATHER(kB, Vg, C + 2, vr[C & 1]);
#pragma unroll
            for (int st = 0; st < 2; ++st) {
#pragma unroll
                for (int db = 0; db < 4; ++db) {
                    const int r0 = 16 * (2 * st) + 4 * fq + tq_, r1 = r0 + 16; const int ch = 2 * db + (tp_ >> 1);
                    const s16x4_t t0 = __builtin_amdgcn_ds_read_tr16_b64_v4i16((LAS s16x4_t*)(Vs + r0 * 128 + ((ch ^ (r0 & 7)) << 4) + 8 * (tp_ & 1)));
                    const s16x4_t t1 = __builtin_amdgcn_ds_read_tr16_b64_v4i16((LAS s16x4_t*)(Vs + r1 * 128 + ((ch ^ (r1 & 7)) << 4) + 8 * (tp_ & 1)));
                    const h8 va = __builtin_bit_cast(h8, (s16x8_t){t0[0], t0[1], t0[2], t0[3], t1[0], t1[1], t1[2], t1[3]});
                    oacc[db] = __builtin_amdgcn_mfma_f32_16x16x32_f16(va, pb[2 * C + st], oacc[db], 0, 0, 0);
                }
            }
            if (C == 0) { AT_GATHER(nA, Kg, 0, kr[0]); AT_GATHER(nA, Kg, 1, kr[1]); }
        }
        if (j < 4) { const float inv = 1.f / osum[0];
#pragma unroll
            for (int db = 0; db < 4; ++db) { v2u w; w.x = pk2(oacc[db][0] * inv, oacc[db][1] * inv); w.y = pk2(oacc[db][2] * inv, oacc[db][3] * inv);
                *(v2u*)(Ob + row * DM + (4 * g + j) * 64 + 16 * db + 4 * fq) = w; }
        }
        LDS_WAIT(); asm volatile("" ::: "memory");
#pragma unroll
        for (int h = 0; h < 2; ++h) { kA[h] = nA[h]; kB[h] = nB[h]; }
        bq0 = bqn0; bq1 = bqn1;
    }
#undef AT_GATHER
#undef AT_KIDX
}

__device__ __forceinline__ void sample_unit(Frame& F, int li, int s) {
    const PArgs args = args_fresh(); const Tid TI = tid_fresh();
    LAS unsigned char* lds = F.lds; const int tid = TI.tid, lane = TI.lane, wave = TI.wave;
    LAS float* qi = (LAS float*)lds;
    LAS float* qs = qi + 512;
    LAS int* sel = (LAS int*)(qs + 1024);
    LAS float* lg = (LAS float*)(sel + 256);
    LAS int* cnt3 = (LAS int*)(lg + 4096);
    LAS int* cw = cnt3 + 4;
    const int row = MP + s;
    const bf16* QIb = WSP(bf16, WS_QI); const bf16* Qb = WSP(bf16, WS_Q); const float* WIb = WSP(float, WS_WI); bf16* Ob = WSP(bf16, WS_O);
    const float* ckidx = args.in(4) + (size_t)li * NPOOL * PAGE * IDIM; const float* ck = args.in(2) + (size_t)li * NPOOL * PAGE * KVW; const float* cv = args.in(3) + (size_t)li * NPOOL * PAGE * KVW;
    const int* pt = (const int*)args.in(6) + s * NPG;
    const float* nk = args.out() + O_KS + ((size_t)li * NS + s) * KVW; const float* nv = args.out() + O_VS + ((size_t)li * NS + s) * KVW; const float* nki = args.out() + O_KIS + ((size_t)li * NS + s) * IDIM;
    { const bf16 v = QIb[(size_t)row * IQW + tid]; qi[tid] = __uint_as_float((unsigned)v << 16); }
    { const bf16 v0 = Qb[(size_t)row * DM + tid], v1 = Qb[(size_t)row * DM + 512 + tid]; qs[tid] = __uint_as_float((unsigned)v0 << 16); qs[512 + tid] = __uint_as_float((unsigned)v1 << 16); }
    if (tid < 4) cnt3[tid] = 0;
    float wv[8];
#pragma unroll
    for (int h = 0; h < 8; ++h) wv[h] = WIb[(size_t)row * 8 + h];
    __syncthreads();
    unsigned long long keys[17];
#pragma unroll
    for (int j = 0; j < 17; ++j) {
        const int kidx = tid + 512 * j;
        if (kidx <= SEQ) {
            const float* kp = kidx < SEQ ? ckidx + ((size_t)pt[kidx >> 7] * PAGE + (kidx & 127)) * IDIM : nki;
            float acc[8];
#pragma unroll
            for (int h = 0; h < 8; ++h) acc[h] = 0.f;
            f32x4 kv[16];
#pragma unroll
            for (int d = 0; d < 16; ++d) kv[d] = *(const f32x4*)(kp + 4 * d);
            asm volatile("" ::: "memory");
#pragma unroll
            for (int d = 0; d < 64; d += 4) { const f32x4 k4 = kv[d >> 2];
#pragma unroll
                for (int h = 0; h < 8; ++h) { const f32x4 q4 = *(const LAS f32x4*)(qi + h * 64 + d); acc[h] += (q4[0] * k4[0] + q4[1] * k4[1]) + (q4[2] * k4[2] + q4[3] * k4[3]); } }
            float sc = 0.f;
#pragma unroll
            for (int h = 0; h < 8; ++h) sc = fmaf(wv[h], fmaxf(acc[h], 0.f), sc);
            unsigned u = __float_as_uint(sc); u ^= (u >> 31) ? 0xFFFFFFFFu : 0x80000000u;
            keys[j] = ((unsigned long long)u << 32) | (unsigned long long)(0xFFFFFFFFu - (unsigned)kidx);
        } else keys[j] = 0ull;
    }
    unsigned long long T = 0ull;
#pragma unroll 1
    for (int step = 0; step < 46; ++step) {
        const int bit = step < 32 ? 63 - step : 45 - step;
        if (step == 32) T |= 0xFFFFC000ull;
        const unsigned long long tr = T | (1ull << bit); int c = 0;
#pragma unroll
        for (int j = 0; j < 17; ++j) c += __popcll(__ballot(keys[j] >= tr));
        if (lane == 0) atomicAdd((int*)&cnt3[step % 3], c);
        __syncthreads();
        if (cnt3[step % 3] >= TOPK) T = tr;
        if (tid == 0) cnt3[(step + 2) % 3] = 0;
    }
#pragma unroll
    for (int j = 0; j < 17; ++j) { const int c = __popcll(__ballot(keys[j] >= T)); if (lane == 0) cw[j * 8 + wave] = c; }
    __syncthreads();
    if (tid == 0) { int run = 0; for (int i = 0; i < 136; ++i) { const int c = cw[i]; cw[i] = run; run += c; } }
    __syncthreads();
#pragma unroll
    for (int j = 0; j < 17; ++j) { const bool keep = keys[j] >= T; const unsigned long long m = __ballot(keep); if (keep) { const int pos = cw[j * 8 + wave] + mbcnt64(m); if (pos < TOPK) sel[pos] = tid + 512 * j; } }
    __syncthreads();
    LAS int* phys = cw + 144;
    if (tid < TOPK) { const int idx = sel[tid]; phys[tid] = idx < SEQ ? pt[idx >> 7] * PAGE + (idx & 127) : -1; }
    __syncthreads();
#pragma unroll
    for (int ii = 0; ii < 2; ++ii) {
        const int it = tid + 512 * ii;
        const int n = it & 255, kvh = it >> 8; const int pr = phys[n];
        const float* kp = pr >= 0 ? ck + (size_t)pr * KVW + kvh * 64 : nk + kvh * 64;
        f32x4 k4[16];
#pragma unroll
        for (int d = 0; d < 16; ++d) k4[d] = *(const f32x4*)(kp + 4 * d);
        float acc[4] = {0.f, 0.f, 0.f, 0.f};
#pragma unroll
        for (int d = 0; d < 16; ++d) {
#pragma unroll
            for (int i = 0; i < 4; ++i) { const f32x4 q4 = *(const LAS f32x4*)(qs + (4 * kvh + i) * 64 + 4 * d); acc[i] += (q4[0] * k4[d][0] + q4[1] * k4[d][1]) + (q4[2] * k4[d][2] + q4[3] * k4[d][3]); } }
#pragma unroll
        for (int i = 0; i < 4; ++i) lg[(4 * kvh + i) * 256 + n] = acc[i];
    }
    __syncthreads();
#pragma unroll
    for (int hh = 0; hh < 2; ++hh) { LAS float* l = lg + (2 * wave + hh) * 256; float v[4]; float mx = -INFINITY;
#pragma unroll
        for (int i = 0; i < 4; ++i) { v[i] = l[lane + 64 * i]; mx = fmaxf(mx, v[i]); }
        mx = wave_max(mx); float sum = 0.f;
#pragma unroll
        for (int i = 0; i < 4; ++i) { v[i] = __builtin_amdgcn_exp2f(v[i] - mx); sum += v[i]; }
        sum = wave_sum(sum); const float inv = 1.f / sum;
#pragma unroll
        for (int i = 0; i < 4; ++i) l[lane + 64 * i] = v[i] * inv; }
    __syncthreads();
    { const int hd = tid >> 5, dp = tid & 31, kvh = hd >> 2; float o0 = 0.f, o1 = 0.f;
#pragma unroll 1
      for (int n0 = 0; n0 < TOPK; n0 += 16) {
          f32x2 v[16];
#pragma unroll
          for (int k = 0; k < 16; ++k) { const int pr = phys[n0 + k]; const float* vp = pr >= 0 ? cv + (size_t)pr * KVW + kvh * 64 : nv + kvh * 64; v[k] = *(const f32x2*)(vp + 2 * dp); }
#pragma unroll
          for (int k = 0; k < 16; ++k) { const float p = lg[hd * 256 + n0 + k]; o0 = fmaf(p, v[k][0], o0); o1 = fmaf(p, v[k][1], o1); } }
      *(unsigned*)(Ob + (size_t)row * DM + hd * 64 + 2 * dp) = pk2(o0, o1); }
    __syncthreads();
}
}

#ifndef MK_SINGLE
#define MK_SINGLE 1
#endif
#ifndef EN_MASK
#define EN_MASK 0xFFFF
#endif
#define EN(b) ((EN_MASK >> (b)) & 1)
constexpr int N_PHASES = 32;
template <int NB, int NSTEPS, class Fn>
__device__ __forceinline__ float small_item(Frame& F, const bf16* A, int K, const bf16* W0, const bf16* W1, Fn fn) {
    const Tid T = tid_fresh(); const int lane = T.lane, wave = T.wave;
    const int kper = K >> 3, kbeg = wave * kper; constexpr int nsteps = NSTEPS;
    const bf16* ap = A + (size_t)(lane & 15) * K + 8 * (lane >> 4) + kbeg;
    const bf16* wp0 = W0 + (size_t)(lane & 15) * K + 8 * (lane >> 4) + kbeg;
    const bf16* wp1 = (NB == 2 ? W1 : W0) + (size_t)(lane & 15) * K + 8 * (lane >> 4) + kbeg;
    f32x4 d[NB][2];
#pragma unroll
    for (int nb = 0; nb < NB; ++nb) { d[nb][0] = (f32x4){0.f, 0.f, 0.f, 0.f}; d[nb][1] = d[nb][0]; }
    bf16x8 av0[nsteps], av1[nsteps], wv0[nsteps], wv1[NB == 2 ? nsteps : 1];
#pragma unroll
    for (int s = 0; s < nsteps; ++s) { av0[s] = *(const bf16x8*)(ap + 32 * s); av1[s] = *(const bf16x8*)(ap + (size_t)16 * K + 32 * s); wv0[s] = *(const bf16x8*)(wp0 + 32 * s);
        if constexpr (NB == 2) wv1[s] = *(const bf16x8*)(wp1 + 32 * s); }
    asm volatile("" ::: "memory");
#pragma unroll
    for (int s = 0; s < nsteps; ++s) {
        d[0][0] = __builtin_amdgcn_mfma_f32_16x16x32_bf16(wv0[s], av0[s], d[0][0], 0, 0, 0); d[0][1] = __builtin_amdgcn_mfma_f32_16x16x32_bf16(wv0[s], av1[s], d[0][1], 0, 0, 0);
        if constexpr (NB == 2) { d[1][0] = __builtin_amdgcn_mfma_f32_16x16x32_bf16(wv1[s], av0[s], d[1][0], 0, 0, 0); d[1][1] = __builtin_amdgcn_mfma_f32_16x16x32_bf16(wv1[s], av1[s], d[1][1], 0, 0, 0); }
    }
    LAS float* red = (LAS float*)(F.lds + RING_OFF);
#pragma unroll
    for (int nb = 0; nb < NB; ++nb)
#pragma unroll
        for (int f = 0; f < 2; ++f)
#pragma unroll
            for (int r = 0; r < 4; ++r) red[((wave * NB + nb) * 8 + f * 4 + r) * 64 + lane] = d[nb][f][r];
    __syncthreads();
    { const int i = wave, f = i >> 2, r = i & 3; float v[NB];
#pragma unroll
      for (int nb = 0; nb < NB; ++nb) { float s = 0.f;
#pragma unroll
          for (int w = 0; w < 8; ++w) s += red[((w * NB + nb) * 8 + i) * 64 + lane];
          v[nb] = s; }
      const float ret = fn((lane & 15) + 16 * f, 4 * (lane >> 4) + r, v[0], v[NB - 1]);
      __syncthreads();
      return ret; }
}
template <class Epi>
__device__ __forceinline__ void run_gemm(Frame& F, const bf16* A, const bf16* Bt, int M, int N, int K, const Epi E) {
    pg8::Gemm g{A, Bt, M, N, K}; pg8::StaticOrder S; S.init(M, N, F.G, (int)blockIdx.x);
    pg8::gemm_phase<Epi, pg8::StaticOrder, true, true>(F.lds + RING_OFF, g, S, E);
}

__global__ void __launch_bounds__(NWAVES * 64, 2) mega_fwd(Args kargs) {
    extern __shared__ __attribute__((aligned(16))) unsigned char lds_raw[];
    Frame F;
    F.lds = (LAS unsigned char*)lds_raw;
    F.MISC = (volatile LAS unsigned*)(F.lds + MISC_OFF);
    F.G = gridDim.x; { const int bx = blockIdx.x; F.vcu = (F.G % 8 == 0) ? (bx % 8) * (F.G / 8) + bx / 8 : bx; }
    for (int u = threadIdx.x; u < (LDS_BYTES - LDSCTL_OFF) / 4; u += NWAVES * 64) ((LAS unsigned*)(F.lds + LDSCTL_OFF))[u] = 0u;
    __syncthreads();
    const int lo = kargs.ph_lo, hi = kargs.ph_hi;
    unsigned* const barw = (unsigned*)(kargs.ws + WS_CTL) + CW_BAR;
    XcdBarrier bar; bar.bar = barw; bar.x = 0; bar.st = nullptr;
    if (hi - lo > 1) bar = xcd_barrier_post(barw, F.MISC + 8);
    int ph = 0;
#define PH_ON() (ph >= lo && ph < hi)
#define PH_END() do { if (ph >= lo && ph + 1 < hi) xcd_barrier(bar); ++ph; } while (0)

#ifndef PROBE_P0
#define PROBE_P0 1
#endif
    if (EN(0) && PH_ON()) { for (int rep = 0; rep < PROBE_P0; ++rep) p0_prologue(F); }
    PH_END();

#pragma unroll 1
    for (int j = 0; j < 12; ++j) {
        const int layer = j / 3, kind = j - 3 * layer, li = layer >> 1; const bool is_attn = (layer & 1) == 0;
#ifndef PROBE_MOD
#define PROBE_MOD 1
#endif
        if (j == 0) { if (EN(1) && PH_ON()) mod_phase(F, layer, kind); PH_END(); }
        if (kind != 1) {
            if (EN(2) && PH_ON()) { const PArgs args = args_fresh(); const int sff = 2 * layer + (kind >> 1);
                EpiSwiglu E{WSP(bf16, WS_U)};
#ifndef PROBE_FI
#define PROBE_FI 1
#endif
#pragma unroll 1
                for (int rep = 0; rep < PROBE_FI; ++rep) run_gemm(F, WSP(bf16, WS_H), WSP(bf16, WS_WFI) + (size_t)sff * NFFIN * DM, MROWS, NFFIN, DM, E);
                { constexpr int NU = (MROWS / 256) * (NFFIN / 256); const int tail = NU % F.G;
                  const int code = sff == 0 ? 2 : sff == 1 ? 3 : sff == 2 ? 4 : sff == 3 ? 9 : sff == 4 ? 5 : sff == 5 ? 11 : sff == 6 ? 7 : -1;
                  if (tail != 0) convert_in_tail(F, code, tail); else if (code >= 0) convert_set(F, code, F.vcu * NWAVES + __builtin_amdgcn_readfirstlane((int)threadIdx.x >> 6), F.G * NWAVES); } }
            PH_END();
        } else if (is_attn) {
            if (EN(4) && PH_ON()) { const PArgs args = args_fresh();
                EpiAttnIn E{WSP(bf16, WS_Q), WSP(bf16, WS_K), WSP(bf16, WS_V), WSP(bf16, WS_QI), WSP(bf16, WS_KI), WSP(float, WS_WI), args.in(15) + li * HDIM, args.in(16) + li * HDIM,
                            args.out() + O_KP + (size_t)li * MP * KVW, args.out() + O_VP + (size_t)li * MP * KVW, args.out() + O_KIP + (size_t)li * MP * IDIM,
                            args.out() + O_KS + (size_t)li * NS * KVW, args.out() + O_VS + (size_t)li * NS * KVW, args.out() + O_KIS + (size_t)li * NS * IDIM};
                run_gemm(F, WSP(bf16, WS_H), WSP(bf16, WS_WAI) + (size_t)li * ATT_NP * DM, MROWS, ATT_NP, DM, E);
                { constexpr int NU = (MROWS / 256) * (ATT_NP / 256); const int tail = NU % F.G; const int code = li == 0 ? 10 : 6;
                  if (tail != 0) convert_in_tail(F, code, tail); else convert_set(F, code, F.vcu * NWAVES + __builtin_amdgcn_readfirstlane((int)threadIdx.x >> 6), F.G * NWAVES); }
            }
            PH_END();
#ifndef PROBE_A1
#define PROBE_A1 1
#endif
            if (EN(5) && PH_ON()) {
                const int qb = (2 * F.vcu) / F.G;
#pragma unroll 1
              for (int rep = 0; rep < PROBE_A1; ++rep) {
                gu32* qhead = (gu32*)(args_fresh().ws() + WS_CTL) + CW_Q + (li * 2 + qb + 4 * rep) * 64;
#pragma unroll 1
                for (;;) {
                    if (threadIdx.x == 0) F.MISC[4] = __hip_atomic_fetch_add(qhead, 1u, __ATOMIC_RELAXED, __HIP_MEMORY_SCOPE_AGENT);
                    __syncthreads();
                    const int t = (int)F.MISC[4];
                    __syncthreads();
                    if (t >= 16 + 256) break;
                    if (t < 16) { if (EN(6)) a1::sample_unit(F, li, qb * 16 + t); }
                    else a1::prompt_unit(F, qb, 255 - (t - 16));
                }
              }
            }
            PH_END();
            if (EN(5) && PH_ON()) {
                const int grp = (8 * F.vcu) / F.G, wgi = F.vcu - grp * (F.G / 8), per = SEQ / (F.G / 8);
                const int wv = __builtin_amdgcn_readfirstlane((int)threadIdx.x >> 6);
#pragma unroll 1
                for (int q0 = wgi * per + 32 * wv; q0 < (wgi + 1) * per; q0 += 256) a1::attend_wave(F, grp >> 2, grp & 3, q0);
            }
            PH_END();
        } else {
            if (EN(8) && PH_ON()) { const PArgs args = args_fresh(); const float* st = args.in(5) + (size_t)li * NS * 2 * DM;
                EpiConvCU E{WSP(bf16, WS_Z), args.out() + O_CVP + (size_t)li * NBP * 2 * DM, args.out() + O_CVS + (size_t)li * NS * 2 * DM, st};
                run_gemm(F, WSP(bf16, WS_H), WSP(bf16, WS_WCU) + (size_t)li * 2 * DM * DM, MP, 2 * DM, DM, E);
                if (blockIdx.x < 64) { const int zb = blockIdx.x; const bf16* w0 = WSP(bf16, WS_WCU) + (size_t)li * 2 * DM * DM + (size_t)(256 * (zb >> 3) + 16 * (zb & 7)) * DM;
                    bf16* Zb = WSP(bf16, WS_Z); float* ocvs = args.out() + O_CVS + (size_t)li * NS * 2 * DM;
                    small_item<2, 4>(F, WSP(bf16, WS_H) + (size_t)MP * DM, DM, w0, w0 + (size_t)128 * DM, [=](int m, int c, float vc, float vu) {
                        const int col = 16 * zb + c; const float z = vc * vu; Zb[(size_t)(MP + m) * DM + col] = (bf16)(pk2(z, 0.f) & 0xffffu);
                        ocvs[(size_t)(2 * m + 1) * DM + col] = z; ocvs[(size_t)(2 * m) * DM + col] = st[(size_t)(2 * m + 1) * DM + col]; return 0.f; }); } }
            PH_END();
            if (EN(9) && PH_ON()) { const PArgs args = args_fresh(); const float* st = args.in(5) + (size_t)li * NS * 2 * DM;
                EpiConvB E{WSP(bf16, WS_Z), WSP(bf16, WS_O), args.in(18) + (size_t)li * 3 * DM, st}; run_gemm(F, WSP(bf16, WS_H), WSP(bf16, WS_WCB) + (size_t)li * DM * DM, MP, DM, DM, E);
                if (blockIdx.x < 64) { const int nb = blockIdx.x; const bf16* Zb = WSP(bf16, WS_Z); bf16* A2 = WSP(bf16, WS_O); const float* cw = args.in(18) + (size_t)li * 3 * DM;
                    small_item<1, 4>(F, WSP(bf16, WS_H) + (size_t)MP * DM, DM, WSP(bf16, WS_WCB) + (size_t)li * DM * DM + (size_t)16 * nb * DM, nullptr, [=](int m, int c, float v, float) {
                        const int col = 16 * nb + c; const float zt = __uint_as_float((unsigned)Zb[(size_t)(MP + m) * DM + col] << 16);
                        const float y = cw[col] * st[(size_t)(2 * m) * DM + col] + cw[DM + col] * st[(size_t)(2 * m + 1) * DM + col] + cw[2 * DM + col] * zt;
                        A2[(size_t)(MP + m) * DM + col] = (bf16)(pk2(v * y, 0.f) & 0xffffu); return 0.f; }); } }
            PH_END();
        }
        if (EN(3) && PH_ON()) { const PArgs args = args_fresh();
            const bf16* ra; const bf16* rb; int rk; int rflags;
            if (kind != 1) { const int sff = 2 * layer + (kind >> 1); ra = WSP(bf16, WS_U); rb = WSP(bf16, WS_WFO) + (size_t)sff * DM * DFF; rk = DFF; rflags = 1; }
            else if (is_attn) { ra = WSP(bf16, WS_O); rb = WSP(bf16, WS_WAO) + (size_t)li * DM * DM; rk = DM; rflags = 0; }
            else { ra = WSP(bf16, WS_O); rb = WSP(bf16, WS_WCO) + (size_t)li * DM * DM; rk = DM; rflags = 0; }
            const bool fuse = j < 11; const int nl = (j + 1) / 3, nk = (j + 1) - 3 * nl;
            const float* modn = WSP(float, WS_MOD) + (size_t)nl * NBATCH * MODW + nk * 3 * DM;
            float* xslots = WSP(float, WS_XS) + (size_t)j * XS_STRIDE; unsigned* pcnt = (unsigned*)(args.ws() + WS_CTL) + CW_PC + (size_t)j * 65 * 64;
            EpiResidMod E{WSP(float, WS_X), WSP(float, WS_MOD) + (size_t)layer * NBATCH * MODW + (3 * kind + 2) * DM, args.out() + O_YP, rflags | (j == 11 ? 2 : 0) | (fuse ? 4 : 0),
                          xslots, pcnt, WSP(bf16, WS_H), modn};
            float xk = 0.f; const bool smp = blockIdx.x < 64; const int nb = blockIdx.x;
            float* ss = xslots + (size_t)MP * 4; unsigned* scn = pcnt + 64 * 64;
            if (smp) { float* X = WSP(float, WS_X); const float* gate = WSP(float, WS_MOD) + (size_t)layer * NBATCH * MODW + (3 * kind + 2) * DM;
                float* outp = args.out() + O_YP; const float coef = (rflags & 1) ? 0.5f : 1.0f; const bool mirror = j == 11;
                const Tid T0 = tid_fresh(); const int pm_ = (T0.lane & 15) + 16 * (T0.wave >> 2), pc_ = 4 * (T0.lane >> 4) + (T0.wave & 3);
                const float xpre = X[(size_t)(MP + pm_) * DM + 16 * nb + pc_], gpre = gate[(size_t)(2 + pm_) * MODW + 16 * nb + pc_];
                auto fin = [=](int m, int c, float v, float) -> float {
                    const int col = 16 * nb + c; const size_t o = (size_t)(MP + m) * DM + col;
                    const float x = xpre + coef * gpre * v; X[o] = x; if (mirror) outp[o] = x; return x; };
                if (rk == DFF) xk = small_item<1, DFF / 256>(F, ra + (size_t)MP * rk, rk, rb + (size_t)16 * nb * rk, nullptr, fin);
                else xk = small_item<1, DM / 256>(F, ra + (size_t)MP * rk, rk, rb + (size_t)16 * nb * rk, nullptr, fin);
                if (fuse) { const Tid T = tid_fresh(); const int m = (T.lane & 15) + 16 * (T.wave >> 2);
                    LAS float* part = (LAS float*)(F.lds + RING_OFF + 65536);
                    float s = xk * xk; s += __shfl_xor(s, 16); s += __shfl_xor(s, 32);
                    if (T.lane < 16) part[(T.wave & 3) * 32 + m] = s;
                    __syncthreads();
                    if (T.tid < 32) { const float t4 = (part[T.tid] + part[32 + T.tid]) + (part[64 + T.tid] + part[96 + T.tid]);
                        __hip_atomic_store((unsigned*)ss + T.tid * 64 + nb, __float_as_uint(t4), __ATOMIC_RELAXED, __HIP_MEMORY_SCOPE_AGENT); }
                    asm volatile("s_waitcnt vmcnt(0)" ::: "memory");
                    __syncthreads();
                    if (T.tid == 0) (void)__hip_atomic_fetch_add(scn, 1u, __ATOMIC_RELAXED, __HIP_MEMORY_SCOPE_AGENT);
                } }
            run_gemm(F, ra, rb, MP, DM, rk, E);
            if (smp && fuse) { const Tid T = tid_fresh(); const int tid = T.tid;
                LAS float* rsl = (LAS float*)(F.lds + RING_OFF + 65536);
                if (tid == 0) { unsigned sp = 0;
                    while (__hip_atomic_load(scn, __ATOMIC_RELAXED, __HIP_MEMORY_SCOPE_AGENT) < 64u) { __builtin_amdgcn_s_sleep(2); if (++sp > (1u << 20)) break; }
                    __builtin_amdgcn_fence(__ATOMIC_ACQUIRE, "agent"); asm volatile("s_waitcnt vmcnt(0)" ::: "memory"); }
                __syncthreads();
                { const int m = tid >> 4, k4 = (tid & 15) * 4; f32x4 q4;
                  asm volatile("global_load_dwordx4 %0, %1, off sc1\n\ts_waitcnt vmcnt(0)" : "=v"(q4) : "v"((const unsigned*)ss + m * 64 + k4) : "memory");
                  float q = (q4[0] + q4[1]) + (q4[2] + q4[3]);
                  q += __shfl_xor(q, 1); q += __shfl_xor(q, 2); q += __shfl_xor(q, 4); q += __shfl_xor(q, 8);
                  if ((tid & 15) == 0) rsl[m] = __builtin_amdgcn_rsqf(q * (1.f / DM) + RMS_EPS); }
                __syncthreads();
                { const int m = (T.lane & 15) + 16 * (T.wave >> 2), c = 4 * (T.lane >> 4) + (T.wave & 3), col = 16 * nb + c; const float* mb = modn + (size_t)(2 + m) * MODW + col;
                  const float h = xk * rsl[m] * (mb[DM] + 1.f) + mb[0];
                  WSP(bf16, WS_H)[(size_t)(MP + m) * DM + col] = (bf16)(pk2(h, 0.f) & 0xffffu); }
                __syncthreads();
            } }
        PH_END();
    }
#undef PH_ON
#undef PH_END
}

extern "C" void kernel_launch(void* const* d_in, const int* in_sizes, int n_in, void* d_out, int out_size, void* d_ws, size_t ws_size, hipStream_t stream) {
    static int grid = 0;
    if (grid == 0) {
        if (n_in != 20 || (size_t)out_size != O_END || ws_size < WS_END) { fprintf(stderr, "kernel_launch: unexpected problem shape (n_in %d, out %d, ws %zu); nothing launched\n", n_in, out_size, ws_size); grid = -1; return; }
        int dev = 0, cus = 0, per_cu = 0;
        if (hipGetDevice(&dev) != hipSuccess || hipDeviceGetAttribute(&cus, hipDeviceAttributeMultiprocessorCount, dev) != hipSuccess) { grid = -1; return; }
        if (hipFuncSetAttribute((const void*)mega_fwd, hipFuncAttributeMaxDynamicSharedMemorySize, LDS_BYTES) != hipSuccess) { fprintf(stderr, "kernel_launch: hipFuncSetAttribute failed\n"); grid = -1; return; }
        if (hipOccupancyMaxActiveBlocksPerMultiprocessor(&per_cu, (const void*)mega_fwd, NWAVES * 64, LDS_BYTES) != hipSuccess || per_cu < 1)
            fprintf(stderr, "kernel_launch: note: occupancy query reports %d workgroups per CU\n", per_cu);
        (void)hipGetLastError();
        grid = cus;
    }
    if (grid < 0) return;
    if (hipMemsetAsync((char*)d_ws + WS_CTL, 0, CTL_ZERO_BYTES, stream) != hipSuccess) return;
    Args a{};
    for (int i = 0; i < 20; ++i) a.in[i] = (const float*)d_in[i];
    a.out = (float*)d_out; a.ws = (unsigned char*)d_ws;
#if MK_SINGLE
    a.ph_lo = 0; a.ph_hi = N_PHASES;
    hipLaunchKernelGGL(mega_fwd, dim3(grid), dim3(NWAVES * 64), LDS_BYTES, stream, a);
#else
    for (int p = 0; p < N_PHASES; ++p) { a.ph_lo = p; a.ph_hi = p + 1; hipLaunchKernelGGL(mega_fwd, dim3(grid), dim3(NWAVES * 64), LDS_BYTES, stream, a); }
#endif
}
```

```cpp
#include <hip/hip_runtime.h>
#include <cstdio>
#include <cstdint>
namespace pg8 {
#define PG8_LAS __attribute__((address_space(3)))
typedef unsigned short bf16_t;
typedef short bf16x8 __attribute__((ext_vector_type(8)));
typedef float f32x4 __attribute__((ext_vector_type(4)));
typedef unsigned u32x4 __attribute__((ext_vector_type(4)));
constexpr int BM = 256, BK = 64, HALF = 128, HTB = HALF * BK * 2  , STAGE_BYTES = 8 * HTB, NXCD = 8, WGM = 8;

__host__ __device__ __forceinline__ int lds_byte(int r, int c) { const int st = (r >> 4) * 2 + (c >> 5), rr = r & 15, cc = c & 31, ob = rr * 64 + cc * 2; return st * 1024 + (ob ^ (((ob >> 9) & 1) << 5)); }
__host__ __device__ __forceinline__ void stage_rc(int b, int& R, int& C) { const int st = b / 1024, sb = b % 1024, swz = sb ^ (((sb >> 9) & 1) << 5); R = (st >> 1) * 16 + swz / 64; C = (st & 1) * 32 + (swz % 64) / 2; }
__host__ __device__ __forceinline__ int perm32(int rho) { const int n = rho >> 4, i = rho & 15; return 8 * (i >> 2) + 4 * n + (i & 3); }

struct Unit { int pm, pn; };
struct Gemm { const bf16_t* A; const bf16_t* Bt; int M, N, K; };

struct StaticOrder {
    int nM, nN, nwg, G, c;
    __host__ __device__ void init(int M, int N, int G_, int c_) { nM = M / BM; nN = N / BM; nwg = nM * nN; G = G_; c = c_; }
    __host__ __device__ __forceinline__ bool next(int i, Unit& u) const {
        const long L = (long)i * G + c; if (L >= nwg) return false;
        int wgid = (int)L; { const int q = nwg / NXCD, r = nwg % NXCD, xcd = wgid % NXCD, off = wgid / NXCD; wgid = (xcd < r ? xcd * (q + 1) : r * (q + 1) + (xcd - r) * q) + off; }
        const int nig = WGM * nN, gid = wgid / nig, fm = gid * WGM, gsz = (nM - fm) < WGM ? (nM - fm) : WGM;
        u.pm = fm + ((wgid % nig) % gsz); u.pn = (wgid % nig) / gsz; return true;
    }
    __device__ __forceinline__ void a_ready(const Unit&) const {}
    __device__ __forceinline__ void done(const Unit&) const {}
};

__device__ __forceinline__ unsigned cvt_pk_bf16(float lo, float hi) { unsigned r; asm volatile("v_cvt_pk_bf16_f32 %0, %1, %2" : "=v"(r) : "v"(lo), "v"(hi)); return r; }
typedef float f32x2 __attribute__((ext_vector_type(2)));
template <class Epi, class Sched, bool ALIGN_EPI = false, bool SP2 = false>
__device__ __forceinline__ void gemm_phase(PG8_LAS unsigned char* lds, const Gemm g, const Sched S, const Epi E) {
    int tid_ = threadIdx.x; asm volatile("" : "+v"(tid_));
    const int tid = tid_, wid = __builtin_amdgcn_readfirstlane(tid >> 6), lane = tid & 63, wr = wid >> 2, wc = wid & 3, fr = lane & 15, fq = lane >> 4;
    const int K = g.K, nt = K / BK;
    unsigned voffA[2], voffB[2];
#pragma unroll
    for (int i = 0; i < 2; ++i) { int R, C; stage_rc(tid * 16 + i * 8192, R, C); const int Rb = Epi::PERM ? ((R & ~31) + perm32(R & 31)) : R;
        voffA[i] = (unsigned)(R * K + C) * 2u; voffB[i] = (unsigned)(Rb * K + C) * 2u; }
    const size_t kstep = (size_t)(BK * 2);
    const size_t hstep = (size_t)HALF * K * 2;
    const size_t tstep = 2 * hstep;
    const unsigned ldsw = (unsigned)wid * 1024u;
    const int aoff = lds_byte(wr * 64 + fr, fq * 8), boff = lds_byte(wc * 32 + fr, fq * 8);
#define PG8_SA(b, h) (((b) * 2 + (h)) * HTB)
#define PG8_SB(b, h) ((4 + (b) * 2 + (h)) * HTB)
#define PG8_STAGE(bufoff, gbase, voff) do { _Pragma("unroll") for (int _i = 0; _i < 2; ++_i) \
        __builtin_amdgcn_global_load_lds((const unsigned*)((const char*)(gbase) + (voff)[_i]), (PG8_LAS unsigned*)(lds + (bufoff) + ldsw + _i * 8192), 16, 0, 0); } while (0)
#define PG8_LDA(dst, b, h) do { _Pragma("unroll") for (int m = 0; m < 4; ++m) _Pragma("unroll") for (int k = 0; k < 2; ++k) dst[m][k] = *(const PG8_LAS bf16x8*)(lds + PG8_SA(b, h) + aoff + m * 2048 + k * 1024); } while (0)
#define PG8_LDB(dst, b, h) do { _Pragma("unroll") for (int n = 0; n < 2; ++n) _Pragma("unroll") for (int k = 0; k < 2; ++k) dst[n][k] = *(const PG8_LAS bf16x8*)(lds + PG8_SB(b, h) + boff + n * 2048 + k * 1024); } while (0)
#define PG8_MMA(ai, bj, At, Bt) do { __builtin_amdgcn_s_setprio(1); _Pragma("unroll") for (int m = 0; m < 4; ++m) _Pragma("unroll") for (int n = 0; n < 2; ++n) _Pragma("unroll") for (int k = 0; k < 2; ++k) \
        acc[ai][bj][m][n] = __builtin_amdgcn_mfma_f32_16x16x32_bf16(Bt[n][k], At[m][k], acc[ai][bj][m][n], 0, 0, 0); __builtin_amdgcn_s_setprio(0); } while (0)
#define PG8_WAIT_V(n) asm volatile("s_waitcnt vmcnt(" #n ")" ::: "memory")
#define PG8_WAIT_L(n) asm volatile("s_waitcnt lgkmcnt(" #n ")" ::: "memory")
#define PG8_BAR __builtin_amdgcn_s_barrier()
#define PG8_SCHED __builtin_amdgcn_sched_barrier(0)
    Unit cur, nxt; int ui = 0;
    if (!S.next(0, cur)) return;
    f32x4 acc[2][2][4][2];
#pragma unroll
    for (int a = 0; a < 2; ++a)
#pragma unroll
        for (int b = 0; b < 2; ++b)
#pragma unroll
            for (int m = 0; m < 4; ++m)
#pragma unroll
                for (int n = 0; n < 2; ++n) acc[a][b][m][n] = (f32x4){0.f, 0.f, 0.f, 0.f};
    bf16x8 At[4][2], B0[2][2], B1[2][2];
    const char* cA = (const char*)g.A + (size_t)cur.pm * tstep; const char* cB = (const char*)g.Bt + (size_t)cur.pn * tstep;
    S.a_ready(cur);
    if constexpr (SP2) {
        PG8_STAGE(PG8_SB(0, 0), cB, voffB); PG8_STAGE(PG8_SB(0, 1), cB + hstep, voffB); PG8_STAGE(PG8_SA(0, 0), cA, voffA); PG8_STAGE(PG8_SA(0, 1), cA + hstep, voffA);
        if (wr == 1) PG8_BAR;
        PG8_WAIT_V(2); PG8_BAR;
        PG8_STAGE(PG8_SB(1, 0), cB + kstep, voffB); PG8_STAGE(PG8_SA(1, 0), cA + kstep, voffA); PG8_STAGE(PG8_SB(1, 1), cB + hstep + kstep, voffB);
        PG8_WAIT_V(6); PG8_BAR;
    } else {
        PG8_STAGE(PG8_SB(0, 0), cB, voffB); PG8_STAGE(PG8_SA(0, 0), cA, voffA); PG8_STAGE(PG8_SB(0, 1), cB + hstep, voffB); PG8_STAGE(PG8_SA(0, 1), cA + hstep, voffA);
        if (wr == 1) PG8_BAR;
        PG8_WAIT_V(4); PG8_BAR;
        PG8_STAGE(PG8_SB(1, 0), cB + kstep, voffB); PG8_STAGE(PG8_SA(1, 0), cA + kstep, voffA); PG8_STAGE(PG8_SB(1, 1), cB + hstep + kstep, voffB);
        PG8_WAIT_V(6); PG8_BAR;
    }
    for (;;) {
        const bool has_next = S.next(ui + 1, nxt);
        const char* nA = has_next ? (const char*)g.A + (size_t)nxt.pm * tstep : cA; const char* nB = has_next ? (const char*)g.Bt + (size_t)nxt.pn * tstep : cB;
        for (int t = 0; t < nt; t += 2) {
            const bool last = (t == nt - 2);
            const char* a1 = cA + (size_t)(t + 1) * kstep;
            const char* a2 = last ? nA : cA + (size_t)(t + 2) * kstep; const char* b2 = last ? nB : cB + (size_t)(t + 2) * kstep;
            const char* a3 = a2 + kstep; const char* b3 = b2 + kstep;
            if (last && has_next) S.a_ready(nxt);
            if constexpr (SP2) {
            PG8_LDB(B0, 0, 0); PG8_LDB(B1, 0, 1); PG8_SCHED; PG8_LDA(At, 0, 0); PG8_STAGE(PG8_SA(1, 1), a1 + hstep, voffA);
            PG8_WAIT_V(8); PG8_WAIT_L(0); PG8_BAR; PG8_MMA(0, 0, At, B0); PG8_MMA(0, 1, At, B1); PG8_BAR; PG8_SCHED;
            PG8_LDA(At, 0, 1); PG8_STAGE(PG8_SB(0, 0), b2, voffB); PG8_STAGE(PG8_SB(0, 1), b2 + hstep, voffB); PG8_STAGE(PG8_SA(0, 0), a2, voffA);
            PG8_WAIT_V(8); PG8_WAIT_L(0); PG8_BAR; PG8_MMA(1, 0, At, B0); PG8_MMA(1, 1, At, B1); PG8_BAR; PG8_SCHED;
            PG8_LDB(B0, 1, 0); PG8_LDB(B1, 1, 1); PG8_SCHED; PG8_LDA(At, 1, 0); PG8_STAGE(PG8_SA(0, 1), a2 + hstep, voffA);
            PG8_WAIT_V(8); PG8_WAIT_L(0); PG8_BAR; PG8_MMA(0, 0, At, B0); PG8_MMA(0, 1, At, B1); PG8_BAR; PG8_SCHED;
            PG8_LDA(At, 1, 1); PG8_STAGE(PG8_SB(1, 0), b3, voffB); PG8_STAGE(PG8_SB(1, 1), b3 + hstep, voffB); PG8_STAGE(PG8_SA(1, 0), a3, voffA);
            PG8_WAIT_V(8); PG8_WAIT_L(0); PG8_BAR; PG8_MMA(1, 0, At, B0); PG8_MMA(1, 1, At, B1); PG8_BAR; PG8_SCHED;
            } else {
            PG8_LDB(B0, 0, 0); PG8_SCHED; PG8_LDA(At, 0, 0); PG8_STAGE(PG8_SA(1, 1), a1 + hstep, voffA);
            PG8_WAIT_L(8); PG8_BAR; PG8_WAIT_L(0); PG8_MMA(0, 0, At, B0); PG8_BAR; PG8_SCHED;
            PG8_LDB(B1, 0, 1); PG8_STAGE(PG8_SB(0, 0), b2, voffB);
            PG8_BAR; PG8_WAIT_L(0); PG8_MMA(0, 1, At, B1); PG8_BAR;
            PG8_LDA(At, 0, 1); PG8_STAGE(PG8_SA(0, 0), a2, voffA);
            PG8_BAR; PG8_WAIT_L(0); PG8_MMA(1, 0, At, B0); PG8_BAR; PG8_SCHED;
            PG8_STAGE(PG8_SB(0, 1), b2 + hstep, voffB);
            PG8_WAIT_V(6); PG8_BAR; PG8_MMA(1, 1, At, B1); PG8_BAR;
            PG8_LDB(B0, 1, 0); PG8_SCHED; PG8_LDA(At, 1, 0); PG8_STAGE(PG8_SA(0, 1), a2 + hstep, voffA);
            PG8_WAIT_L(8); PG8_BAR; PG8_WAIT_L(0); PG8_MMA(0, 0, At, B0); PG8_BAR; PG8_SCHED;
            PG8_LDB(B1, 1, 1); PG8_STAGE(PG8_SB(1, 0), b3, voffB);
            PG8_BAR; PG8_WAIT_L(0); PG8_MMA(0, 1, At, B1); PG8_BAR;
            PG8_LDA(At, 1, 1); PG8_STAGE(PG8_SA(1, 0), a3, voffA);
            PG8_BAR; PG8_WAIT_L(0); PG8_MMA(1, 0, At, B0); PG8_BAR; PG8_SCHED;
            PG8_STAGE(PG8_SB(1, 1), b3 + hstep, voffB);
            PG8_WAIT_V(6); PG8_BAR; PG8_MMA(1, 1, At, B1); PG8_BAR;
            }
        }
        if constexpr (ALIGN_EPI) { if (wr == 0) PG8_BAR; }
        if constexpr (!Epi::AFTER_DRAIN) { E(acc, cur, wr, wc, fr, fq); S.done(cur); }
        if (!has_next) break;
#pragma unroll
        for (int a = 0; a < 2; ++a)
#pragma unroll
            for (int b = 0; b < 2; ++b)
#pragma unroll
                for (int m = 0; m < 4; ++m)
#pragma unroll
                    for (int n = 0; n < 2; ++n) acc[a][b][m][n] = (f32x4){0.f, 0.f, 0.f, 0.f};
        cur = nxt; cA = nA; cB = nB; ++ui;
        if constexpr (ALIGN_EPI) { if (wr == 1) PG8_BAR; }
    }
    PG8_WAIT_V(0);
    if constexpr (!ALIGN_EPI) { if (wr == 0) PG8_BAR; }
    PG8_BAR;
    if constexpr (Epi::AFTER_DRAIN) { E.fused(acc, cur, wr, wc, fr, fq, lds, wid, lane); S.done(cur); }
#undef PG8_SA
#undef PG8_SB
#undef PG8_STAGE
#undef PG8_LDA
#undef PG8_LDB
#undef PG8_MMA
#undef PG8_WAIT_V
#undef PG8_WAIT_L
#undef PG8_BAR
#undef PG8_SCHED
}
}

constexpr int DM = 1024, SEQ = 8192, NBP = 2, MP = NBP * SEQ, NS = 32;
constexpr int MROWS = 16640, MVALID = MP + NS;
constexpr int DFF = 2816, NFFIN = 2 * DFF;
constexpr int NHEAD = 16, HDIM = 64, KVW = 256, IQW = 512, IDIM = 64, IHEADS = 8, TOPK = 256;
constexpr int ATT_COLS = 2120, ATT_NP = 2304;
constexpr int MODW = 9 * DM, NBATCH = 34;
constexpr int NPG = 64, PAGE = 128, NPOOL = 2560;
constexpr float RMS_EPS = 1e-6f;
constexpr float QSCALE = 0.125f * 1.4426950408889634f;
constexpr float WISCALE = 0.35355339059327373f * 0.125f;
constexpr size_t O_YP = 0, O_YS = 16777216, O_KP = 16809984, O_VP = 25198592, O_KIP = 33587200, O_CVP = 35684352,
                 O_KS = 35692544, O_VS = 35708928, O_KIS = 35725312, O_CVS = 35729408, O_END = 35860480;
constexpr size_t MiB = 1u << 20;
constexpr size_t WS_CTL = 0, CTL_ZERO_BYTES = 1 * MiB;
constexpr size_t WS_MOD = 1 * MiB;
constexpr size_t WS_WFI = 8 * MiB;
constexpr size_t WS_WFO = 96 * MiB;
constexpr size_t WS_WAI = 140 * MiB;
constexpr size_t WS_WAO = 150 * MiB;
constexpr size_t WS_WCU = 154 * MiB;
constexpr size_t WS_WCB = 162 * MiB;
constexpr size_t WS_WCO = 166 * MiB;
constexpr size_t WS_X = 176 * MiB;
constexpr size_t WS_H = 242 * MiB;
constexpr size_t WS_U = 276 * MiB;
constexpr size_t WS_Q = 366 * MiB;
constexpr size_t WS_K = 399 * MiB;
constexpr size_t WS_V = 408 * MiB;
constexpr size_t WS_QI = 417 * MiB;
constexpr size_t WS_KI = 434 * MiB;
constexpr size_t WS_WI = 437 * MiB;
constexpr size_t WS_O = 438 * MiB;
constexpr size_t WS_Z = 471 * MiB;
constexpr size_t WS_IDX = 504 * MiB;
constexpr size_t WS_NSEL = 512 * MiB;
constexpr size_t WS_XS = 513 * MiB;
constexpr size_t XS_STRIDE = (size_t)MP * 4 + 32 * 64;
constexpr size_t WS_END = 517 * MiB;
static_assert(WS_MOD + (size_t)4 * 34 * 9216 * 4 <= WS_WFI && WS_WFI + (size_t)8 * 5632 * 1024 * 2 <= WS_WFO && WS_WFO + (size_t)8 * 1024 * 2816 * 2 <= WS_WAI &&
              WS_WAI + (size_t)2 * 2304 * 1024 * 2 <= WS_WAO && WS_X + (size_t)MROWS * DM * 4 <= WS_H && WS_H + (size_t)MROWS * DM * 2 <= WS_U &&
              WS_U + (size_t)MROWS * DFF * 2 <= WS_Q && WS_Q + (size_t)MROWS * DM * 2 <= WS_K && WS_K + (size_t)MROWS * KVW * 2 <= WS_V && WS_V + (size_t)MROWS * KVW * 2 <= WS_QI &&
              WS_QI + (size_t)MROWS * IQW * 2 <= WS_KI && WS_KI + (size_t)MROWS * IDIM * 2 <= WS_WI && WS_WI + (size_t)MROWS * 8 * 4 <= WS_O && WS_O + (size_t)MROWS * DM * 2 <= WS_Z &&
              WS_Z + (size_t)MROWS * DM * 2 <= WS_IDX && WS_IDX + (size_t)MP * TOPK * 2 <= WS_NSEL && WS_NSEL + (size_t)MP * 4 <= WS_XS && WS_XS + 12 * XS_STRIDE * 4 <= WS_END, "d_ws map");
constexpr int CW_TMO = 0, CW_BAR = 4096, CW_Q = 8192, CW_PC = 16384;
constexpr int RING_OFF = 0, RING_BYTES = 131072;
constexpr int LDSCTL_OFF = RING_BYTES, MISC_OFF = LDSCTL_OFF + 320;
constexpr int LDS_BYTES = 147456;
constexpr int NWAVES = 8;

#define GAS __attribute__((address_space(1)))
#define LAS __attribute__((address_space(3)))
typedef unsigned short bf16;
typedef unsigned v4u __attribute__((ext_vector_type(4)));
typedef unsigned v2u __attribute__((ext_vector_type(2)));
typedef float f32x4 __attribute__((ext_vector_type(4)));
typedef float f32x2 __attribute__((ext_vector_type(2)));
typedef float f32x16 __attribute__((ext_vector_type(16)));
typedef short bf16x8 __attribute__((ext_vector_type(8)));
typedef GAS unsigned gu32;
#define LDS_WAIT() asm volatile("s_waitcnt lgkmcnt(0)" ::: "memory")
#define VM_WAIT() asm volatile("s_waitcnt vmcnt(0)" ::: "memory")
__device__ __forceinline__ unsigned pk2(float lo, float hi) { return pg8::cvt_pk_bf16(lo, hi); }
__device__ __forceinline__ float bflo(unsigned u) { return __uint_as_float(u << 16); }
__device__ __forceinline__ float bfhi(unsigned u) { return __uint_as_float(u & 0xffff0000u); }
__device__ __forceinline__ float silu1(float a) { return a * __builtin_amdgcn_rcpf(1.f + __builtin_amdgcn_exp2f(-1.4426950408889634f * a)); }
__device__ __forceinline__ int batch_of(int row) { const int b = row < MP ? (row >> 13) : (2 + row - MP); return b > 33 ? 33 : b; }
__device__ __forceinline__ float wave_sum(float v) {
#pragma unroll
    for (int o = 1; o < 64; o <<= 1) v += __shfl_xor(v, o);
    return v;
}
__device__ __forceinline__ float wave_max(float v) {
#pragma unroll
    for (int o = 1; o < 64; o <<= 1) v = fmaxf(v, __shfl_xor(v, o));
    return v;
}
#define XB_TMO      128
#define XB_XCNT(j)  (256  + 64 * (j))
#define XB_XSUB(j)  (1280 + 64 * (j))
#define XB_XGEN(j)  (2304 + 64 * (j))
#define XB_TOP      3328
#define XB_TOPGEN   3392
#define XCD_BAR_WORDS 3456
#define XB_SPIN_CAP (1u << 18)

__device__ __forceinline__ unsigned xb_ld(unsigned* p)              { return __hip_atomic_load(p, __ATOMIC_RELAXED, __HIP_MEMORY_SCOPE_AGENT); }
__device__ __forceinline__ unsigned xb_add(unsigned* p, unsigned v) { return __hip_atomic_fetch_add(p, v, __ATOMIC_RELAXED, __HIP_MEMORY_SCOPE_AGENT); }
__device__ __forceinline__ unsigned xb_xcc_id() { return (unsigned)__builtin_amdgcn_s_getreg((3 << 11) | 20) & 0xFu; }
#define XB_SPIN(cond, bar) do { unsigned _sp = 0; while (cond) { __builtin_amdgcn_s_sleep(1); \
    if ((++_sp & 255u) == 0u) { if (xb_ld(&(bar)[XB_TMO])) break; if (_sp > XB_SPIN_CAP) { atomicAdd(&(bar)[XB_TMO], 1u); break; } } } } while (0)

struct XcdBarrier {
    unsigned* bar; unsigned x;
    volatile LAS unsigned* st;
};

__device__ __forceinline__ XcdBarrier xcd_barrier_post(unsigned* bar, volatile LAS unsigned* st) {
    XcdBarrier b; b.bar = bar; b.x = xb_xcc_id(); b.st = st;
    if (threadIdx.x == 0) (void)xb_add(&bar[XB_XCNT(b.x)], 1u);
    return b;
}
__device__ __forceinline__ void xcd_barrier_complete(unsigned* bar, unsigned x, unsigned& nloc, unsigned& nx) {
    const unsigned G = gridDim.x * gridDim.y * gridDim.z;
    unsigned sum, cnt, mine, sp = 0u;
    for (;;) {
        sum = 0u; cnt = 0u; mine = 0u;
#pragma unroll
        for (unsigned j = 0; j < 16; ++j) { const unsigned c = xb_ld(&bar[XB_XCNT(j)]); sum += c; cnt += (c > 0u) ? 1u : 0u; mine = (j == x) ? c : mine; }
        if (sum == G) break;
        __builtin_amdgcn_s_sleep(1);
        if ((++sp & 255u) == 0u) { if (xb_ld(&bar[XB_TMO])) break; if (sp > XB_SPIN_CAP) { atomicAdd(&bar[XB_TMO], 1u); break; } }
    }
    nloc = mine > 0u ? mine : 1u; nx = cnt > 0u ? cnt : 1u;
}

__device__ __forceinline__ void xcd_barrier(const XcdBarrier& b) {
    asm volatile("s_waitcnt vmcnt(0)" ::: "memory");
    __syncthreads();
    if (threadIdx.x == 0) {
        unsigned* bar = b.bar;
        __builtin_amdgcn_s_waitcnt(0);
        unsigned nloc = b.st[0], nx = b.st[1];
        if (nloc == 0u) { xcd_barrier_complete(bar, b.x, nloc, nx); b.st[0] = nloc; b.st[1] = nx; }
        const unsigned old = xb_add(&bar[XB_XSUB(b.x)], 1u);
        const unsigned gen = old / nloc;
        if (old + 1u == (gen + 1u) * nloc) {
            __builtin_amdgcn_fence(__ATOMIC_RELEASE, "agent");
            asm volatile("s_waitcnt vmcnt(0)" ::: "memory");
            const unsigned og = xb_add(&bar[XB_TOP], 1u);
            const unsigned tg = og / nx;
            if (og + 1u == (tg + 1u) * nx) xb_add(&bar[XB_TOPGEN], 1u);
            else XB_SPIN(xb_ld(&bar[XB_TOPGEN]) == tg, bar);
            __builtin_amdgcn_fence(__ATOMIC_ACQUIRE, "agent");
            asm volatile("s_waitcnt vmcnt(0)" ::: "memory");
        } else {
            XB_SPIN(xb_ld(&bar[XB_TOPGEN]) == gen, bar);
            __builtin_amdgcn_fence(__ATOMIC_ACQUIRE, "agent");
            asm volatile("s_waitcnt vmcnt(0)" ::: "memory");
        }
    }
    __syncthreads();
}

using pg8::Unit;
typedef _Float16 h2e __attribute__((ext_vector_type(2)));
__device__ __forceinline__ unsigned pkh2(float a, float b) { const h2e t = __builtin_convertvector((f32x2){a, b}, h2e); return __builtin_bit_cast(unsigned, t); }

struct EpiSwiglu {
    static constexpr bool PERM = true, AFTER_DRAIN = false;
    bf16* U;
    __device__ __forceinline__ void operator()(const f32x4 (&acc)[2][2][4][2], const Unit& u, int wr, int wc, int fr, int fq) const {
        const int row0 = u.pm * 256 + wr * 64 + fr, col0 = u.pn * 128 + wc * 32 + 8 * fq;
#pragma unroll
        for (int ai = 0; ai < 2; ++ai)
#pragma unroll
            for (int m = 0; m < 4; ++m) {
                const f32x4 a0 = acc[ai][0][m][0], a1 = acc[ai][0][m][1], g0 = acc[ai][1][m][0], g1 = acc[ai][1][m][1];
                v4u w;
                w.x = pk2(silu1(a0[0]) * g0[0], silu1(a0[1]) * g0[1]); w.y = pk2(silu1(a0[2]) * g0[2], silu1(a0[3]) * g0[3]);
                w.z = pk2(silu1(a1[0]) * g1[0], silu1(a1[1]) * g1[1]); w.w = pk2(silu1(a1[2]) * g1[2], silu1(a1[3]) * g1[3]);
                *(v4u*)(U + (size_t)(row0 + ai * 128 + m * 16) * DFF + col0) = w;
            }
    }
};

struct EpiResid {
    static constexpr bool PERM = false, AFTER_DRAIN = false;
    float* X; const float* gate; float* outp; int flags;
    __device__ __forceinline__ void operator()(const f32x4 (&acc)[2][2][4][2], const Unit& u, int wr, int wc, int fr, int fq) const {
        const int row0 = u.pm * 256 + wr * 64 + fr, colb = u.pn * 256 + wc * 32 + 4 * fq;
        const float coef = (flags & 1) ? 0.5f : 1.0f; const bool mirror = (flags & 2) != 0;
#pragma unroll
        for (int ai = 0; ai < 2; ++ai)
#pragma unroll
            for (int m = 0; m < 4; ++m) {
                const int row = row0 + ai * 128 + m * 16; const int b = batch_of(row);
                const float* gp = gate + (size_t)b * MODW + colb; float* xp = X + (size_t)row * DM + colb;
#pragma unroll
                for (int bj = 0; bj < 2; ++bj)
#pragma unroll
                    for (int n = 0; n < 2; ++n) { const int off = bj * 128 + n * 16;
                        const f32x4 g = *(const f32x4*)(gp + off); f32x4 x = *(const f32x4*)(xp + off);
                        x = x + (g * coef) * acc[ai][bj][m][n]; *(f32x4*)(xp + off) = x;
                        if (mirror && row < MVALID) *(f32x4*)(outp + (size_t)row * DM + colb + off) = x; }
            }
    }
};

struct EpiResidMod {
    static constexpr bool PERM = false, AFTER_DRAIN = true;
    float* X; const float* gate; float* outp; int flags;
    float* xbuf; unsigned* cnt; bf16* H; const float* modn;
    __device__ __forceinline__ void fused(f32x4 (&acc)[2][2][4][2], const Unit& u, int wr, int wc, int fr, int fq, LAS unsigned char* lds, int wid, int lane) const {
        asm volatile("" : "+v"(fr), "+v"(fq));
        const int row0 = u.pm * 256 + wr * 64 + fr, colb = u.pn * 256 + wc * 32 + 4 * fq;
        const float coef = (flags & 1) ? 0.5f : 1.0f; const bool mirror = (flags & 2) != 0;
        const int b = u.pm >> 5;
        const float* gp = gate + (size_t)b * MODW + colb;
        f32x4 gv[2][2];
#pragma unroll
        for (int bj = 0; bj < 2; ++bj)
#pragma unroll
            for (int n = 0; n < 2; ++n) gv[bj][n] = *(const f32x4*)(gp + bj * 128 + n * 16);
#pragma unroll
        for (int ai = 0; ai < 2; ++ai) {
            float* xp = X + (size_t)(row0 + ai * 128) * DM + colb;
            f32x4 xv[4][2][2];
#pragma unroll
            for (int m = 0; m < 4; ++m)
#pragma unroll
                for (int bj = 0; bj < 2; ++bj)
#pragma unroll
                    for (int n = 0; n < 2; ++n) xv[m][bj][n] = *(const f32x4*)(xp + (size_t)m * 16 * DM + bj * 128 + n * 16);
            asm volatile("" ::: "memory");
            if (ai == 0) {
#pragma unroll
                for (int bj = 0; bj < 2; ++bj)
#pragma unroll
                    for (int n = 0; n < 2; ++n) gv[bj][n] = gv[bj][n] * coef; }
#pragma unroll
            for (int m = 0; m < 4; ++m)
#pragma unroll
                for (int bj = 0; bj < 2; ++bj)
#pragma unroll
                    for (int n = 0; n < 2; ++n) { const f32x4 x = xv[m][bj][n] + gv[bj][n] * acc[ai][bj][m][n]; acc[ai][bj][m][n] = x; *(f32x4*)(xp + (size_t)m * 16 * DM + bj * 128 + n * 16) = x; }
            if (mirror) { float* op = outp + (size_t)(row0 + ai * 128) * DM + colb;
#pragma unroll
                for (int m = 0; m < 4; ++m)
#pragma unroll
                    for (int bj = 0; bj < 2; ++bj)
#pragma unroll
                        for (int n = 0; n < 2; ++n) *(f32x4*)(op + (size_t)m * 16 * DM + bj * 128 + n * 16) = acc[ai][bj][m][n]; }
        }
        if (!(flags & 4)) return;
        const float* mb = modn + (size_t)b * MODW + colb;
        f32x4 shv[2][2], scv[2][2];
#pragma unroll
        for (int bj = 0; bj < 2; ++bj)
#pragma unroll
            for (int n = 0; n < 2; ++n) { shv[bj][n] = *(const f32x4*)(mb + bj * 128 + n * 16); scv[bj][n] = *(const f32x4*)(mb + DM + bj * 128 + n * 16); }
        LAS float* P = (LAS float*)lds;
        LAS float* S = (LAS float*)(lds + 8192);
        LAS unsigned* flag = (LAS unsigned*)(lds + 8192 + 2048);
#pragma unroll
        for (int ai = 0; ai < 2; ++ai)
#pragma unroll
            for (int m = 0; m < 4; ++m) { float s = 0.f;
#pragma unroll
                for (int bj = 0; bj < 2; ++bj)
#pragma unroll
                    for (int n = 0; n < 2; ++n) { const f32x4 x = acc[ai][bj][m][n]; s += (x[0] * x[0] + x[1] * x[1]) + (x[2] * x[2] + x[3] * x[3]); }
                s += __shfl_xor(s, 16); s += __shfl_xor(s, 32);
                if (fq == 0) P[(ai * 128 + wr * 64 + m * 16 + fr) * 4 + wc] = s; }
        asm volatile("s_waitcnt lgkmcnt(0)" ::: "memory"); __builtin_amdgcn_s_barrier(); asm volatile("" ::: "memory");
        const int prow = wid * 32 + (lane & 31);
        if (lane < 32) { const f32x4 p4 = *(const LAS f32x4*)(P + prow * 4); const float t = (p4[0] + p4[1]) + (p4[2] + p4[3]);
            __hip_atomic_store((unsigned*)xbuf + ((size_t)(u.pm * 256 + prow) * 4 + u.pn), __float_as_uint(t), __ATOMIC_RELAXED, __HIP_MEMORY_SCOPE_AGENT); }
        asm volatile("s_waitcnt vmcnt(0)" ::: "memory");
        if (lane == 0) __hip_atomic_fetch_add(cnt + 64 * u.pm, 1u, __ATOMIC_RELAXED, __HIP_MEMORY_SCOPE_AGENT);
        if (wid == 0) {
            unsigned sp = 0;
            while ((unsigned)__builtin_amdgcn_readfirstlane(__hip_atomic_load(cnt + 64 * u.pm, __ATOMIC_RELAXED, __HIP_MEMORY_SCOPE_AGENT)) < 32u) { __builtin_amdgcn_s_sleep(2); if (++sp > (1u << 20)) break; }
            __builtin_amdgcn_fence(__ATOMIC_ACQUIRE, "agent");
            if (lane == 0) flag[0] = 1u;
        }
        asm volatile("s_waitcnt vmcnt(0) lgkmcnt(0)" ::: "memory"); __builtin_amdgcn_s_barrier(); asm volatile("" ::: "memory");
        if (lane < 32) { const unsigned* sl = (const unsigned*)xbuf + (size_t)(u.pm * 256 + prow) * 4; f32x4 q4;
            asm volatile("global_load_dwordx4 %0, %1, off sc1\n\ts_waitcnt vmcnt(0)" : "=v"(q4) : "v"(sl) : "memory");
            const float q = (q4[0] + q4[1]) + (q4[2] + q4[3]);
            S[prow] = __builtin_amdgcn_rsqf(q * (1.f / DM) + RMS_EPS); }
        asm volatile("s_waitcnt lgkmcnt(0)" ::: "memory"); __builtin_amdgcn_s_barrier(); asm volatile("" ::: "memory");
#pragma unroll
        for (int bj = 0; bj < 2; ++bj)
#pragma unroll
            for (int n = 0; n < 2; ++n) { const int off = bj * 128 + n * 16;
                const f32x4 sh = shv[bj][n], sc = scv[bj][n] + 1.f;
#pragma unroll
                for (int ai = 0; ai < 2; ++ai)
#pragma unroll
                    for (int m = 0; m < 4; ++m) { const int r = ai * 128 + wr * 64 + m * 16 + fr; const float rs = S[r];
                        const f32x4 h = acc[ai][bj][m][n] * rs * sc + sh; v2u o; o.x = pk2(h[0], h[1]); o.y = pk2(h[2], h[3]);
                        *(v2u*)(H + (size_t)(u.pm * 256 + r) * DM + colb + off) = o; } }
    }
};

struct EpiAttnIn {
    static constexpr bool PERM = true, AFTER_DRAIN = false;
    bf16 *Qb, *Kb, *Vb, *QIb, *KIb; float* WIb; const float *qg, *kg; float *okp, *ovp, *okip, *oks, *ovs, *okis;
    __device__ __forceinline__ void operator()(const f32x4 (&acc)[2][2][4][2], const Unit& u, int wr, int wc, int fr, int fq) const {
        const int tile = u.pn; const int row0 = u.pm * 256 + wr * 64 + fr;
        if (tile < 5) {
            const float* gain = tile < 4 ? qg : kg; const float post = tile < 4 ? QSCALE : 1.f;
            f32x4 gv[2][2];
#pragma unroll
            for (int bj = 0; bj < 2; ++bj)
#pragma unroll
                for (int n = 0; n < 2; ++n) gv[bj][n] = *(const f32x4*)(gain + 32 * bj + 8 * fq + 4 * n);
#pragma unroll
            for (int ai = 0; ai < 2; ++ai)
#pragma unroll
                for (int m = 0; m < 4; ++m) {
                    const int row = row0 + ai * 128 + m * 16; float ss = 0.f;
#pragma unroll
                    for (int bj = 0; bj < 2; ++bj)
#pragma unroll
                        for (int n = 0; n < 2; ++n) { const f32x4 v = acc[ai][bj][m][n]; ss += (v[0] * v[0] + v[1] * v[1]) + (v[2] * v[2] + v[3] * v[3]); }
                    ss += __shfl_xor(ss, 16); ss += __shfl_xor(ss, 32);
                    const float r = __builtin_amdgcn_rsqf(ss * (1.f / 64.f) + RMS_EPS);
#pragma unroll
                    for (int bj = 0; bj < 2; ++bj) {
                        const f32x4 v0 = acc[ai][bj][m][0] * r * gv[bj][0], v1 = acc[ai][bj][m][1] * r * gv[bj][1];
                        const int hc = 32 * bj + 8 * fq;
                        if (tile < 4) { v4u w; w.x = pk2(v0[0] * post, v0[1] * post); w.y = pk2(v0[2] * post, v0[3] * post); w.z = pk2(v1[0] * post, v1[1] * post); w.w = pk2(v1[2] * post, v1[3] * post);
                            *(v4u*)(Qb + (size_t)row * DM + (4 * tile + wc) * 64 + hc) = w; }
                        else { v4u w; w.x = pk2(v0[0], v0[1]); w.y = pk2(v0[2], v0[3]); w.z = pk2(v1[0], v1[1]); w.w = pk2(v1[2], v1[3]);
                            if (row < MP) *(v4u*)(Kb + ((size_t)((row >> 13) * 4 + wc) * SEQ + (row & (SEQ - 1))) * 64 + hc) = w;
                            float* o = row < MP ? okp + (size_t)row * KVW : (row < MVALID ? oks + (size_t)(row - MP) * KVW : nullptr);
                            if (o) { *(f32x4*)(o + wc * 64 + hc) = v0; *(f32x4*)(o + wc * 64 + hc + 4) = v1; } }
                    }
                }
        } else if (tile == 5) {
#pragma unroll
            for (int ai = 0; ai < 2; ++ai)
#pragma unroll
                for (int m = 0; m < 4; ++m) {
                    const int row = row0 + ai * 128 + m * 16;
                    float* o = row < MP ? ovp + (size_t)row * KVW : (row < MVALID ? ovs + (size_t)(row - MP) * KVW : nullptr);
#pragma unroll
                    for (int bj = 0; bj < 2; ++bj) { const f32x4 v0 = acc[ai][bj][m][0], v1 = acc[ai][bj][m][1]; const int hc = 32 * bj + 8 * fq;
                        v4u w; w.x = pkh2(v0[0], v0[1]); w.y = pkh2(v0[2], v0[3]); w.z = pkh2(v1[0], v1[1]); w.w = pkh2(v1[2], v1[3]);
                        if (row < MP) *(v4u*)(Vb + ((size_t)((row >> 13) * 4 + wc) * SEQ + (row & (SEQ - 1))) * 64 + hc) = w;
                        if (o) { *(f32x4*)(o + wc * 64 + hc) = v0; *(f32x4*)(o + wc * 64 + hc + 4) = v1; } }
                }
        } else if (tile < 8) {
#pragma unroll
            for (int ai = 0; ai < 2; ++ai)
#pragma unroll
                for (int m = 0; m < 4; ++m) {
                    const int row = row0 + ai * 128 + m * 16;
#pragma unroll
                    for (int bj = 0; bj < 2; ++bj) { const f32x4 v0 = acc[ai][bj][m][0], v1 = acc[ai][bj][m][1]; const int hc = 32 * bj + 8 * fq;
                        v4u w; w.x = pk2(v0[0], v0[1]); w.y = pk2(v0[2], v0[3]); w.z = pk2(v1[0], v1[1]); w.w = pk2(v1[2], v1[3]);
                        *(v4u*)(QIb + (size_t)row * IQW + (4 * (tile - 6) + wc) * 64 + hc) = w; }
                }
        } else {
#pragma unroll
            for (int ai = 0; ai < 2; ++ai)
#pragma unroll
                for (int m = 0; m < 4; ++m) {
                    const int row = row0 + ai * 128 + m * 16;
                    if (wc == 0) {
                        float* o = row < MP ? okip + (size_t)row * IDIM : (row < MVALID ? okis + (size_t)(row - MP) * IDIM : nullptr);
#pragma unroll
                        for (int bj = 0; bj < 2; ++bj) { const f32x4 v0 = acc[ai][bj][m][0], v1 = acc[ai][bj][m][1]; const int hc = 32 * bj + 8 * fq;
                            v4u w; w.x = pk2(v0[0], v0[1]); w.y = pk2(v0[2], v0[3]); w.z = pk2(v1[0], v1[1]); w.w = pk2(v1[2], v1[3]);
                            *(v4u*)(KIb + (size_t)row * IDIM + hc) = w;
                            if (o) { *(f32x4*)(o + hc) = v0; *(f32x4*)(o + hc + 4) = v1; } }
                    } else if (wc == 1 && fq == 0) {
                        *(f32x4*)(WIb + (size_t)row * 8) = acc[ai][0][m][0] * WISCALE; *(f32x4*)(WIb + (size_t)row * 8 + 4) = acc[ai][0][m][1] * WISCALE;
                    }
                }
        }
    }
};

struct EpiConvCU {
    static constexpr bool PERM = true, AFTER_DRAIN = false;
    bf16* Zb; float* ocvp; float* ocvs; const float* state;
    __device__ __forceinline__ void operator()(const f32x4 (&acc)[2][2][4][2], const Unit& u, int wr, int wc, int fr, int fq) const {
        const int row0 = u.pm * 256 + wr * 64 + fr, col0 = u.pn * 128 + wc * 32 + 8 * fq;
#pragma unroll
        for (int ai = 0; ai < 2; ++ai)
#pragma unroll
            for (int m = 0; m < 4; ++m) {
                const int row = row0 + ai * 128 + m * 16;
                const f32x4 z0 = acc[ai][0][m][0] * acc[ai][1][m][0], z1 = acc[ai][0][m][1] * acc[ai][1][m][1];
                v4u w; w.x = pk2(z0[0], z0[1]); w.y = pk2(z0[2], z0[3]); w.z = pk2(z1[0], z1[1]); w.w = pk2(z1[2], z1[3]);
                *(v4u*)(Zb + (size_t)row * DM + col0) = w;
                { const int t = row & (SEQ - 1);
                    if (t >= SEQ - 2) { float* o = ocvp + ((size_t)(row >> 13) * 2 + (t - (SEQ - 2))) * DM + col0; *(f32x4*)o = z0; *(f32x4*)(o + 4) = z1; } }
            }
    }
};

struct EpiConvB {
    static constexpr bool PERM = true, AFTER_DRAIN = false;
    const bf16* Zb; bf16* A2; const float* cw; const float* state;
    __device__ __forceinline__ void operator()(const f32x4 (&acc)[2][2][4][2], const Unit& u, int wr, int wc, int fr, int fq) const {
        const int row0 = u.pm * 256 + wr * 64 + fr;
#pragma unroll
        for (int bj = 0; bj < 2; ++bj) {
            const int col0 = u.pn * 256 + bj * 128 + wc * 32 + 8 * fq;
            f32x4 w0[2], w1[2], w2[2];
#pragma unroll
            for (int n = 0; n < 2; ++n) { w0[n] = *(const f32x4*)(cw + col0 + 4 * n); w1[n] = *(const f32x4*)(cw + DM + col0 + 4 * n); w2[n] = *(const f32x4*)(cw + 2 * DM + col0 + 4 * n); }
#pragma unroll
            for (int am = 0; am < 4; ++am) { const int ai = am >> 1, mb = (am & 1) * 2;
                v4u zt[2], q1[2], q2[2];
#pragma unroll
                for (int mm = 0; mm < 2; ++mm) { const int row = row0 + ai * 128 + (mb + mm) * 16, t = row & (SEQ - 1); const bf16* zp = Zb + (size_t)row * DM + col0;
                    zt[mm] = *(const v4u*)zp; q1[mm] = *(const v4u*)(zp - (t >= 1 ? DM : 0)); q2[mm] = *(const v4u*)(zp - (t >= 2 ? 2 * DM : 0)); }
                asm volatile("" ::: "memory");
#pragma unroll
                for (int mm = 0; mm < 2; ++mm) { const int m = mb + mm; const int row = row0 + ai * 128 + m * 16, t = row & (SEQ - 1);
                    const v4u z0 = (v4u){0u, 0u, 0u, 0u}; const v4u p1 = t >= 1 ? q1[mm] : z0, p2 = t >= 2 ? q2[mm] : z0, pt = zt[mm];
                    const f32x4 a1[2] = {(f32x4){bflo(p1.x), bfhi(p1.x), bflo(p1.y), bfhi(p1.y)}, (f32x4){bflo(p1.z), bfhi(p1.z), bflo(p1.w), bfhi(p1.w)}};
                    const f32x4 a2[2] = {(f32x4){bflo(p2.x), bfhi(p2.x), bflo(p2.y), bfhi(p2.y)}, (f32x4){bflo(p2.z), bfhi(p2.z), bflo(p2.w), bfhi(p2.w)}};
                    const f32x4 c0 = (f32x4){bflo(pt.x), bfhi(pt.x), bflo(pt.y), bfhi(pt.y)}, c1 = (f32x4){bflo(pt.z), bfhi(pt.z), bflo(pt.w), bfhi(pt.w)};
                    const f32x4 y0 = (w0[0] * a2[0] + w1[0] * a1[0] + w2[0] * c0) * acc[ai][bj][m][0], y1 = (w0[1] * a2[1] + w1[1] * a1[1] + w2[1] * c1) * acc[ai][bj][m][1];
                    v4u w; w.x = pk2(y0[0], y0[1]); w.y = pk2(y0[2], y0[3]); w.z = pk2(y1[0], y1[1]); w.w = pk2(y1[2], y1[3]);
                    *(v4u*)(A2 + (size_t)row * DM + col0) = w;
                }
            }
        }
    }
};

struct Args { const float* in[20]; float* out; unsigned char* ws; int ph_lo, ph_hi; };
typedef __attribute__((address_space(4))) const unsigned char* kaptr_t;
struct PArgs {
    kaptr_t p;
    __device__ __forceinline__ const float* in(int i) const { return *(const float* const __attribute__((address_space(4)))*)(p + 8 * i); }
    __device__ __forceinline__ float* out() const { return *(float* const __attribute__((address_space(4)))*)(p + 160); }
    __device__ __forceinline__ unsigned char* ws() const { return *(unsigned char* const __attribute__((address_space(4)))*)(p + 168); }
};
static_assert(sizeof(Args) == 184, "kernarg layout");
__device__ __forceinline__ PArgs args_fresh() { kaptr_t p = (kaptr_t)__builtin_amdgcn_kernarg_segment_ptr(); asm volatile("" : "+s"(p)); PArgs a; a.p = p; return a; }
struct Frame {
    LAS unsigned char* lds; volatile LAS unsigned* MISC;
    int vcu, G;
};
struct Tid { int tid, lane, wave; };
__device__ __forceinline__ Tid tid_fresh() { int t = threadIdx.x; asm volatile("" : "+v"(t)); Tid r; r.tid = t; r.lane = t & 63; r.wave = __builtin_amdgcn_readfirstlane(t >> 6); return r; }
#define WSP(T, off) ((T*)(args.ws() + (off)))

__device__ __forceinline__ f32x4 silu4(f32x4 c) { f32x4 r; r[0] = c[0] / (1.f + __expf(-c[0])); r[1] = c[1] / (1.f + __expf(-c[1])); r[2] = c[2] / (1.f + __expf(-c[2])); r[3] = c[3] / (1.f + __expf(-c[3])); return r; }
__device__ __forceinline__ f32x4 silu4f(f32x4 c) { f32x4 r;
#pragma unroll
    for (int e = 0; e < 4; ++e) r[e] = c[e] * __builtin_amdgcn_rcpf(1.f + __builtin_amdgcn_exp2f(-1.4426950408889634f * c[e]));
    return r; }
__device__ __forceinline__ void ada_item16(const float* w_ada, const float* b_ada, const float* c_prompt, const float* c_sample, float* MOD, int item, int lane) {
    const int layer = item / 576, c0 = (item % 576) * 16; const int li = lane & 15, kk = lane >> 4;
    const float* W = w_ada + (size_t)layer * DM * MODW + c0 + li;
    f32x4 acc[2]; float pa[2] = {0.f, 0.f};
    acc[0] = acc[1] = (f32x4){0.f, 0.f, 0.f, 0.f};
#pragma unroll 4
    for (int k0 = 0; k0 < DM; k0 += 16) {
        float w[4]; f32x4 cs[2], cp[2];
#pragma unroll
        for (int st = 0; st < 4; ++st) w[st] = W[(size_t)(k0 + 4 * kk + st) * MODW];
#pragma unroll
        for (int rb = 0; rb < 2; ++rb) cs[rb] = silu4f(*(const f32x4*)(c_sample + (size_t)(16 * rb + li) * DM + k0 + 4 * kk));
#pragma unroll
        for (int b = 0; b < 2; ++b) cp[b] = silu4f(*(const f32x4*)(c_prompt + (size_t)b * DM + k0 + 4 * kk));
#pragma unroll
        for (int st = 0; st < 4; ++st) {
            acc[0] = __builtin_amdgcn_mfma_f32_16x16x4f32(cs[0][st], w[st], acc[0], 0, 0, 0);
            acc[1] = __builtin_amdgcn_mfma_f32_16x16x4f32(cs[1][st], w[st], acc[1], 0, 0, 0);
            pa[0] = fmaf(cp[0][st], w[st], pa[0]); pa[1] = fmaf(cp[1][st], w[st], pa[1]);
        }
    }
    const float bias = b_ada[(size_t)layer * MODW + c0 + li];
    float* Mo = MOD + (size_t)layer * NBATCH * MODW + c0 + li;
#pragma unroll
    for (int rb = 0; rb < 2; ++rb)
#pragma unroll
        for (int reg = 0; reg < 4; ++reg) Mo[(size_t)(2 + 16 * rb + 4 * kk + reg) * MODW] = acc[rb][reg] + bias;
#pragma unroll
    for (int b = 0; b < 2; ++b) { float v = pa[b]; v += __shfl_xor(v, 16); v += __shfl_xor(v, 32); if (kk == 0) Mo[(size_t)b * MODW] = v + bias; }
}
__device__ __forceinline__ void ada_item_wg(Frame& F, const float* w_ada, const float* b_ada, const float* c_prompt, const float* c_sample, float* MOD, int item, const Tid T) {
    const int lane = T.lane, wave = T.wave;
    const int layer = item / 576, c0 = (item % 576) * 16; const int li = lane & 15, kk = lane >> 4;
    const float* W = w_ada + (size_t)layer * DM * MODW + c0 + li;
    f32x4 acc[2]; float pa[2] = {0.f, 0.f};
    acc[0] = acc[1] = (f32x4){0.f, 0.f, 0.f, 0.f};
    const int kb = wave * 128;
    float w[8][4]; f32x4 cs[8][2], cp[8][2];
#pragma unroll
    for (int i = 0; i < 8; ++i) { const int k0 = kb + 16 * i;
#pragma unroll
        for (int st = 0; st < 4; ++st) w[i][st] = W[(size_t)(k0 + 4 * kk + st) * MODW];
#pragma unroll
        for (int rb = 0; rb < 2; ++rb) cs[i][rb] = *(const f32x4*)(c_sample + (size_t)(16 * rb + li) * DM + k0 + 4 * kk);
#pragma unroll
        for (int b = 0; b < 2; ++b) cp[i][b] = *(const f32x4*)(c_prompt + (size_t)b * DM + k0 + 4 * kk); }
    asm volatile("" ::: "memory");
#pragma unroll
    for (int i = 0; i < 8; ++i) { const f32x4 s0 = silu4f(cs[i][0]), s1 = silu4f(cs[i][1]), p0 = silu4f(cp[i][0]), p1 = silu4f(cp[i][1]);
#pragma unroll
        for (int st = 0; st < 4; ++st) {
            acc[0] = __builtin_amdgcn_mfma_f32_16x16x4f32(s0[st], w[i][st], acc[0], 0, 0, 0);
            acc[1] = __builtin_amdgcn_mfma_f32_16x16x4f32(s1[st], w[i][st], acc[1], 0, 0, 0);
            pa[0] = fmaf(p0[st], w[i][st], pa[0]); pa[1] = fmaf(p1[st], w[i][st], pa[1]);
        } }
    LAS float* red = (LAS float*)(F.lds + RING_OFF);
#pragma unroll
    for (int r = 0; r < 8; ++r) red[(wave * 10 + r) * 64 + lane] = acc[r >> 2][r & 3];
    red[(wave * 10 + 8) * 64 + lane] = pa[0]; red[(wave * 10 + 9) * 64 + lane] = pa[1];
    __syncthreads();
    const float bias = b_ada[(size_t)layer * MODW + c0 + li];
    float* Mo = MOD + (size_t)layer * NBATCH * MODW + c0 + li;
    { float s = 0.f;
#pragma unroll
      for (int ww = 0; ww < 8; ++ww) s += red[(ww * 10 + wave) * 64 + lane];
      Mo[(size_t)(2 + 16 * (wave >> 2) + 4 * kk + (wave & 3)) * MODW] = s + bias; }
    if (wave < 2) { float v = 0.f;
#pragma unroll
      for (int ww = 0; ww < 8; ++ww) v += red[(ww * 10 + 8 + wave) * 64 + lane];
      v += __shfl_xor(v, 16); v += __shfl_xor(v, 32); if (kk == 0) Mo[(size_t)wave * MODW] = v + bias; }
    __syncthreads();
}
__device__ __forceinline__ void titem_load(const float* W, int ldn, int nvalid, int sc0, int k0, int lane, f32x4 (&v)[8]) {
    const int rr = lane >> 3, c4 = 4 * (lane & 7); const bool ok = sc0 + c4 < nvalid;
    const float* src = W + (size_t)(k0 + rr) * ldn + sc0 + c4;
#pragma unroll
    for (int i = 0; i < 8; ++i) v[i] = ok ? *(const f32x4*)(src + (size_t)(8 * i) * ldn) : (f32x4){0.f, 0.f, 0.f, 0.f};
}
__device__ __forceinline__ void titem_store(const f32x4 (&v)[8], int K, bf16* WT, int n0, int k0, LAS float* scr, int lane) {
    const int rr = lane >> 3, c4 = 4 * (lane & 7);
#pragma unroll
    for (int i = 0; i < 8; ++i) { LAS float* d = scr + (8 * i + rr) * 33 + c4; d[0] = v[i][0]; d[1] = v[i][1]; d[2] = v[i][2]; d[3] = v[i][3]; }
    LDS_WAIT(); asm volatile("" ::: "memory");
    const int c = lane & 7;
#pragma unroll
    for (int j = 0; j < 4; ++j) { const int n = (lane >> 3) + 8 * j; const LAS float* s = scr + (8 * c) * 33 + n;
        v4u o; o.x = pk2(s[0 * 33], s[1 * 33]); o.y = pk2(s[2 * 33], s[3 * 33]); o.z = pk2(s[4 * 33], s[5 * 33]); o.w = pk2(s[6 * 33], s[7 * 33]);
        *(GAS v4u*)(WT + (size_t)(n0 + n) * K + k0 + 8 * c) = o; }
    LDS_WAIT(); asm volatile("" ::: "memory");
}
__device__ __forceinline__ int src_col_ffn(int nb) { const int p = 32 * nb, tile = p >> 8, w = p & 255; return w < 128 ? 128 * tile + w : DFF + 128 * tile + (w - 128); }
__device__ __forceinline__ int src_col_att(int nb) { const int p = 32 * nb, tile = p >> 8, w = p & 255; return 256 * tile + 64 * ((w >> 5) & 3) + 32 * (w >> 7); }
__device__ __forceinline__ int src_col_ccu(int nb) { const int p = 32 * nb, tile = p >> 8, w = p & 255; return w < 128 ? DM + 128 * tile + w : 2 * DM + 128 * tile + (w - 128); }

namespace wc {
constexpr int I_FI = 16 * 176, I_FO = 44 * 32, I_AI = 16 * 72, I_SQ = 16 * 32, I_CU = 16 * 64;
constexpr int OFF_FI = 0, OFF_FO = OFF_FI + 8 * I_FI, OFF_AI = OFF_FO + 8 * I_FO, OFF_AO = OFF_AI + 2 * I_AI, OFF_CU = OFF_AO + 2 * I_SQ, OFF_CB = OFF_CU + 2 * I_CU, OFF_CO = OFF_CB + 2 * I_SQ;
}
__device__ __forceinline__ void convert_set(Frame& F, int code, int w, int nw) {
    using namespace wc;
    const PArgs args = args_fresh(); const Tid T = tid_fresh();
    LAS float* scr = (LAS float*)(F.lds + RING_OFF + T.wave * 16384);
    int lo0, n0, lo1, n1, lo2 = 0, n2 = 0;
    if (code < 8) { lo0 = OFF_FI + code * I_FI; n0 = I_FI; lo1 = OFF_FO + code * I_FO; n1 = I_FO; }
    else if (code < 10) { const int li = code - 8; lo0 = OFF_AI + li * I_AI; n0 = I_AI; lo1 = OFF_AO + li * I_SQ; n1 = I_SQ; }
    else { const int li = code - 10; lo0 = OFF_CU + li * I_CU; n0 = I_CU; lo1 = OFF_CB + li * I_SQ; n1 = I_SQ; lo2 = OFF_CO + li * I_SQ; n2 = I_SQ; }
    const int ntot = n0 + n1 + n2;
    struct TD { const float* W; bf16* WT; int K, ldn, nvalid, n0, sc0, k0; };
    auto decode = [&](int v) __attribute__((always_inline)) -> TD {
        int r = v < n0 ? lo0 + v : (v < n0 + n1 ? lo1 + (v - n0) : lo2 + (v - n0 - n1)); TD t;
        if (r < 8 * I_FI) { const int s = r / I_FI, q = r % I_FI, nb = q % 176, kb = q / 176;
            t = TD{args.in(11) + (size_t)s * DM * NFFIN, WSP(bf16, WS_WFI) + (size_t)s * NFFIN * DM, DM, NFFIN, NFFIN, 32 * nb, src_col_ffn(nb), 64 * kb}; return t; } r -= 8 * I_FI;
        if (r < 8 * I_FO) { const int s = r / I_FO, q = r % I_FO, nb = q % 32, kb = q / 32;
            t = TD{args.in(12) + (size_t)s * DFF * DM, WSP(bf16, WS_WFO) + (size_t)s * DM * DFF, DFF, DM, DM, 32 * nb, 32 * nb, 64 * kb}; return t; } r -= 8 * I_FO;
        if (r < 2 * I_AI) { const int s = r / I_AI, q = r % I_AI, nb = q % 72, kb = q / 72;
            t = TD{args.in(13) + (size_t)s * DM * ATT_COLS, WSP(bf16, WS_WAI) + (size_t)s * ATT_NP * DM, DM, ATT_COLS, ATT_COLS, 32 * nb, src_col_att(nb), 64 * kb}; return t; } r -= 2 * I_AI;
        if (r < 2 * I_SQ) { const int s = r / I_SQ, q = r % I_SQ, nb = q % 32, kb = q / 32;
            t = TD{args.in(14) + (size_t)s * DM * DM, WSP(bf16, WS_WAO) + (size_t)s * DM * DM, DM, DM, DM, 32 * nb, 32 * nb, 64 * kb}; return t; } r -= 2 * I_SQ;
        if (r < 2 * I_CU) { const int s = r / I_CU, q = r % I_CU, nb = q % 64, kb = q / 64;
            t = TD{args.in(17) + (size_t)s * DM * 3 * DM, WSP(bf16, WS_WCU) + (size_t)s * 2 * DM * DM, DM, 3 * DM, 3 * DM, 32 * nb, src_col_ccu(nb), 64 * kb}; return t; } r -= 2 * I_CU;
        if (r < 2 * I_SQ) { const int s = r / I_SQ, q = r % I_SQ, nb = q % 32, kb = q / 32;
            t = TD{args.in(17) + (size_t)s * DM * 3 * DM, WSP(bf16, WS_WCB) + (size_t)s * DM * DM, DM, 3 * DM, 3 * DM, 32 * nb, 32 * nb, 64 * kb}; return t; } r -= 2 * I_SQ;
        { const int s = r / I_SQ, q = r % I_SQ, nb = q % 32, kb = q / 32;
            t = TD{args.in(19) + (size_t)s * DM * DM, WSP(bf16, WS_WCO) + (size_t)s * DM * DM, DM, DM, DM, 32 * nb, 32 * nb, 64 * kb}; return t; }
    };
    f32x4 va[8], vb[8], vc[8], vd[8];
    const int npair = (ntot + 1) >> 1;
#define CV_LOAD(P, X, Y) do { const TD t_ = decode(2 * (P)); titem_load(t_.W, t_.ldn, t_.nvalid, t_.sc0, t_.k0, T.lane, X); \
        if (2 * (P) + 1 < ntot) { const TD u_ = decode(2 * (P) + 1); titem_load(u_.W, u_.ldn, u_.nvalid, u_.sc0, u_.k0, T.lane, Y); } } while (0)
#define CV_STORE(P, X, Y) do { const TD t_ = decode(2 * (P)); titem_store(X, t_.K, t_.WT, t_.n0, t_.k0, scr, T.lane); \
        if (2 * (P) + 1 < ntot) { const TD u_ = decode(2 * (P) + 1); titem_store(Y, u_.K, u_.WT, u_.n0, u_.k0, scr, T.lane); } } while (0)
    if (w < npair) CV_LOAD(w, va, vb);
#pragma unroll 1
    for (int p = w; p < npair; p += 2 * nw) {
        const bool hb = p + nw < npair, hc = p + 2 * nw < npair;
        if (hb) CV_LOAD(p + nw, vc, vd);
        CV_STORE(p, va, vb);
        if (hc) CV_LOAD(p + 2 * nw, va, vb);
        if (hb) CV_STORE(p + nw, vc, vd);
    }
#undef CV_LOAD
#undef CV_STORE
}
__device__ __forceinline__ void convert_in_tail(Frame& F, int code, int first_idle) {
    if (code < 0 || (int)blockIdx.x < first_idle) return;
    const int wv = __builtin_amdgcn_readfirstlane((int)threadIdx.x >> 6);
    convert_set(F, code, ((int)blockIdx.x - first_idle) * NWAVES + wv, (F.G - first_idle) * NWAVES);
}

__device__ __forceinline__ void p0_prologue(Frame& F) {
    const PArgs args = args_fresh(); const Tid T = tid_fresh();
    const int gw = F.vcu * NWAVES + T.wave, NGW = F.G * NWAVES;
    if (gw < 2304) ada_item16(args.in(9), args.in(10), args.in(7), args.in(8), WSP(float, WS_MOD), gw, T.lane);
#pragma unroll 1
    for (int it = NGW + F.vcu; it < 2304; it += F.G) ada_item_wg(F, args.in(9), args.in(10), args.in(7), args.in(8), WSP(float, WS_MOD), it, tid_fresh());
#pragma unroll 1
    for (int k = 0; k < 3; ++k) { const int rot = k == 0 ? 0 : (k == 1 ? NGW - 128 : NGW - 64); convert_set(F, k == 0 ? 0 : (k == 1 ? 8 : 1), (gw + rot) % NGW, NGW); }
}

__device__ __forceinline__ void mod_phase(Frame& F, int layer, int which) {
    const PArgs args = args_fresh(); const Tid T = tid_fresh();
    const int gw = F.vcu * NWAVES + T.wave, NGW = F.G * NWAVES;
    float* X = WSP(float, WS_X); bf16* H = WSP(bf16, WS_H);
    const float* mod = WSP(float, WS_MOD) + (size_t)layer * NBATCH * MODW + which * 3 * DM;
    for (int m = gw; m < MROWS; m += NGW) {
        const float* mb = mod + (size_t)batch_of(m) * MODW + 4 * T.lane;
        f32x4 v[4]; float s = 0.f;
        const float* src = m < MP ? args.in(0) + (size_t)m * DM : (m < MVALID ? args.in(1) + (size_t)(m - MP) * DM : nullptr);
        f32x4 shv[4], scv[4];
#pragma unroll
        for (int j = 0; j < 4; ++j) { v[j] = src ? *(const f32x4*)(src + 4 * T.lane + 256 * j) : (f32x4){0.f, 0.f, 0.f, 0.f}; shv[j] = *(const f32x4*)(mb + 256 * j); scv[j] = *(const f32x4*)(mb + DM + 256 * j); }
        asm volatile("" ::: "memory");
#pragma unroll
        for (int j = 0; j < 4; ++j) { *(f32x4*)(X + (size_t)m * DM + 4 * T.lane + 256 * j) = v[j];
            s += (v[j][0] * v[j][0] + v[j][1] * v[j][1]) + (v[j][2] * v[j][2] + v[j][3] * v[j][3]); }
        const float rstd = __builtin_amdgcn_rsqf(wave_sum(s) * (1.f / DM) + RMS_EPS);
#pragma unroll
        for (int j = 0; j < 4; ++j) { const f32x4 sh = shv[j], sc = scv[j];
            const f32x4 h = v[j] * rstd * (sc + 1.f) + sh; v2u o; o.x = pk2(h[0], h[1]); o.y = pk2(h[2], h[3]);
            *(v2u*)(H + (size_t)m * DM + 4 * T.lane + 256 * j) = o; }
    }
}


namespace a1 {
constexpr int CAP = 768, NE = CAP / 64;
constexpr int KT = 128;
constexpr int LDS_KT = 0, LDS_BUF = 32768;
constexpr int LDS_CNT = LDS_BUF + 8 * 4 * CAP * 4;
typedef _Float16 h2 __attribute__((ext_vector_type(2)));
typedef _Float16 h8 __attribute__((ext_vector_type(8)));
typedef _Float16 h4 __attribute__((ext_vector_type(4)));
typedef float f32x8_t __attribute__((ext_vector_type(8)));
typedef short s16x4_t __attribute__((ext_vector_type(4)));
typedef short s16x8_t __attribute__((ext_vector_type(8)));
__device__ __forceinline__ unsigned pkh(float a, float b) { const h2 t = __builtin_convertvector((f32x2){a, b}, h2); return __builtin_bit_cast(unsigned, t); }
__device__ __forceinline__ int mbcnt64(unsigned long long m) { return (int)__builtin_amdgcn_mbcnt_hi((unsigned)(m >> 32), __builtin_amdgcn_mbcnt_lo((unsigned)m, 0u)); }

template <bool EXACT>
__device__ __forceinline__ unsigned compact(LAS unsigned* buf, int n, int lane, int& kept, LAS unsigned* dump) {
    unsigned e[NE]; unsigned mx = 0u, mn = 0xFFFFFFFFu;
#pragma unroll
    for (int j = 0; j < NE; ++j) { const int i = lane + 64 * j; const bool ok = i < n; e[j] = ok ? buf[i] : 0u; mx = max(mx, e[j]); mn = min(mn, ok ? e[j] : 0xFFFFFFFFu); }
#pragma unroll
    for (int o = 1; o < 64; o <<= 1) { mx = max(mx, (unsigned)__shfl_xor((int)mx, o)); mn = min(mn, (unsigned)__shfl_xor((int)mn, o)); }
    mx = __builtin_amdgcn_readfirstlane(mx); mn = __builtin_amdgcn_readfirstlane(mn);
    const int hb = 31 - __builtin_clz(mx ^ mn);
    const unsigned base = hb >= 31 ? 0u : (mx >> (hb + 1)) << (hb + 1);
    unsigned T = base; int cT = n; bool have = false;
    if (!EXACT) {
        const int ms = min(max(n, 0), 64) + min(max(n - 256, 0), 64) + min(max(n - 512, 0), 64);
        const int ks = max(1, (ms * 320) / n);
        unsigned Ts = base;
        for (int b = hb; b >= 0; --b) {
            const unsigned tr = Ts | (1u << b);
            const int c = __popcll(__ballot(e[0] >= tr)) + __popcll(__ballot(e[4] >= tr)) + __popcll(__ballot(e[8] >= tr));
            if (c >= ks) { Ts = tr; if (c == ks) break; }
        }
        int c = 0;
#pragma unroll
        for (int j = 0; j < NE; ++j) c += __popcll(__ballot(e[j] >= Ts));
        if (c >= TOPK) { T = Ts; cT = c; have = true; }
    }
    if (!have) {
        T = base; cT = n;
        for (int b = hb; b >= 0; --b) {
            const unsigned tr = T | (1u << b); int c = 0;
#pragma unroll
            for (int j = 0; j < NE; ++j) c += __popcll(__ballot(e[j] >= tr));
            if (c >= TOPK) { T = tr; cT = c; if (c == TOPK) break; }
        }
    }
    int bs = 0;
#pragma unroll
    for (int j = 0; j < NE; ++j) { const bool keep = e[j] >= T; const unsigned long long m = __ballot(keep); const int pos = bs + mbcnt64(m); LAS unsigned* d = keep ? buf + pos : dump; *d = e[j]; bs += __popcll(m); }
    kept = cT;
    return T;
}

__device__ __forceinline__ unsigned prune_given(LAS unsigned* buf, int n, int lane, int& kept, LAS unsigned* dump, unsigned Ts) {
    unsigned e[NE]; int c = 0;
#pragma unroll
    for (int j = 0; j < NE; ++j) { const int i = lane + 64 * j; e[j] = i < n ? buf[i] : 0u; }
#pragma unroll
    for (int j = 0; j < NE; ++j) c += __popcll(__ballot(e[j] >= Ts));
    if (c < TOPK || Ts == 0u) return compact<true>(buf, n, lane, kept, dump);
    int bs = 0;
#pragma unroll
    for (int j = 0; j < NE; ++j) { const bool keep = e[j] >= Ts; const unsigned long long m = __ballot(keep); const int pos = bs + mbcnt64(m); LAS unsigned* d = keep ? buf + pos : dump; *d = e[j]; bs += __popcll(m); }
    kept = c;
    return Ts;
}
constexpr int PRUNE_MIN = 448;
__device__ __forceinline__ void prune4(LAS unsigned* mybuf, int lane, int hi, int& cntA, int& cntB, unsigned& tauA, unsigned& tauB, LAS unsigned* dump) {
    int n[4]; n[0] = __builtin_amdgcn_readlane(cntA, 0); n[1] = __builtin_amdgcn_readlane(cntB, 0); n[2] = __builtin_amdgcn_readlane(cntA, 32); n[3] = __builtin_amdgcn_readlane(cntB, 32);
    unsigned s0[4], s1[4], s2[4], Ts[4]; int ks[4]; bool done[4];
#pragma unroll
    for (int q = 0; q < 4; ++q) { const bool act = n[q] > PRUNE_MIN; LAS unsigned* b = mybuf + q * CAP; const int nn = act ? n[q] : 0;
        s0[q] = lane < nn ? b[lane] : 0u; s1[q] = lane + 256 < nn ? b[lane + 256] : 0u; s2[q] = lane + 512 < nn ? b[lane + 512] : 0u;
        const int ms = min(nn, 64) + min(max(nn - 256, 0), 64) + min(max(nn - 512, 0), 64);
        ks[q] = act ? max(1, (ms * 320) / nn) : 0; Ts[q] = 0u; done[q] = !act; }
#pragma unroll 1
    for (int b = 31; b >= 13; --b) {
#pragma unroll
        for (int q = 0; q < 4; ++q) { const unsigned tr = Ts[q] | (1u << b);
            const int c = __popcll(__ballot(s0[q] >= tr)) + __popcll(__ballot(s1[q] >= tr)) + __popcll(__ballot(s2[q] >= tr));
            const bool take = !done[q] && c >= ks[q]; Ts[q] = take ? tr : Ts[q]; done[q] = done[q] || (take && c == ks[q]); }
        if (done[0] && done[1] && done[2] && done[3]) break;
    }
#pragma unroll
    for (int q = 0; q < 4; ++q) if (n[q] > PRUNE_MIN) { int kept; unsigned T = prune_given(mybuf + q * CAP, n[q], lane, kept, dump, Ts[q]);
        if (kept > CAP - 128) T = compact<true>(mybuf + q * CAP, kept, lane, kept, dump);
        if (hi == (q >> 1)) { if (q & 1) { cntB = kept; tauB = T; } else { cntA = kept; tauA = T; } } }
}

__device__ __forceinline__ void prompt_unit(Frame& F, int b, int blk) {
    const PArgs args = args_fresh(); const Tid TI = tid_fresh();
    LAS unsigned char* lds = F.lds;
    const int tid = TI.tid, lane = TI.lane, wave = TI.wave, r = lane & 31, hi = lane >> 5;
    const int q0 = blk * 32, qw = q0 + 4 * wave; const size_t rowbase = (size_t)b * SEQ;
    const bf16* QIb = WSP(bf16, WS_QI); const bf16* KIb = WSP(bf16, WS_KI); const float* WIb = WSP(float, WS_WI);
    const bf16* Qb = WSP(bf16, WS_Q); const bf16* Kb = WSP(bf16, WS_K); const bf16* Vb = WSP(bf16, WS_V); bf16* Ob = WSP(bf16, WS_O);
    bf16x8 qa[4];
    { const int ri = r & 3, rh = (r >> 2) & 1, rg = r >> 3, aq = 2 * rh + (rg >> 1), ah = 4 * (rg & 1) + ri;
      const bf16* p = QIb + (rowbase + qw + aq) * IQW + ah * 64 + 8 * hi;
#pragma unroll
      for (int s = 0; s < 4; ++s) qa[s] = *(const bf16x8*)(p + 16 * s); }
    float wA[8], wB[8];
    { const float* p = WIb + (rowbase + qw + 2 * hi) * 8; const f32x4 a0 = *(const f32x4*)p, a1 = *(const f32x4*)(p + 4), b0 = *(const f32x4*)(p + 8), b1 = *(const f32x4*)(p + 12);
#pragma unroll
      for (int i = 0; i < 4; ++i) { wA[i] = a0[i]; wA[4 + i] = a1[i]; wB[i] = b0[i]; wB[4 + i] = b1[i]; } }
    LAS unsigned* mybuf = (LAS unsigned*)(lds + LDS_BUF) + wave * 4 * CAP;
    if (wave >= 4) __builtin_amdgcn_s_setprio(1);
    LAS unsigned* bufA = mybuf + (2 * hi) * CAP; LAS unsigned* bufB = bufA + CAP;
    int cntA = 0, cntB = 0; unsigned tauA = 0u, tauB = 0u;
#ifndef PROBE_SC
#define PROBE_SC 1
#endif
#pragma unroll 1
    for (int rep_sc = 0; rep_sc < PROBE_SC; ++rep_sc) { cntA = 0; cntB = 0; tauA = 0u; tauB = 0u;
    const int qposA = qw + 2 * hi, qposB = qposA + 1;
    const int ntile = (q0 + 31) / KT + 1;
    const char* kbase = (const char*)(KIb + rowbase * IDIM);
    const int so0 = 16 * tid, so1 = so0 + 8192;
    const int sd0 = (so0 >> 7) * 128 + ((((so0 >> 4) & 7) ^ ((so0 >> 8) & 7)) << 4), sd1 = (so1 >> 7) * 128 + ((((so1 >> 4) & 7) ^ ((so1 >> 8) & 7)) << 4);
    auto compute_tile = [&](int t) __attribute__((always_inline)) {
        LAS unsigned char* kt = lds + LDS_KT + (t & 1) * 16384;
        LAS unsigned* flg = (LAS unsigned*)(lds + LDS_CNT + 128);
        const unsigned fl = flg[(t + 2) % 3];
        if (tid == 0) flg[(t + 1) % 3] = 0u;
        if (__builtin_amdgcn_readfirstlane(fl) != 0u) prune4(mybuf, lane, hi, cntA, cntB, tauA, tauB, (LAS unsigned*)(lds + LDS_CNT) + wave);
        if (t * KT > qw + 3) return;
        bf16x8 kf[4][4];
#pragma unroll
        for (int sub = 0; sub < 4; ++sub) { const int key = 32 * sub + r;
#pragma unroll
            for (int s = 0; s < 4; ++s) kf[sub][s] = *(const LAS bf16x8*)(kt + key * 128 + ((((2 * s + hi) ^ ((key >> 1) & 7))) << 4)); }
        f32x16 D[4];
#pragma unroll
        for (int sub = 0; sub < 4; ++sub) D[sub] = (f32x16){};
#pragma unroll
        for (int s = 0; s < 4; ++s)
#pragma unroll
            for (int sub = 0; sub < 4; ++sub) D[sub] = __builtin_amdgcn_mfma_f32_32x32x16_bf16(qa[s], kf[sub][s], D[sub], 0, 0, 0);
        unsigned uA[4], uB[4];
#pragma unroll
        for (int sub = 0; sub < 4; ++sub) {
            float sA = 0.f, sB = 0.f;
#pragma unroll
            for (int i = 0; i < 8; ++i) {
                const float ra = __int_as_float(max(__float_as_int(D[sub][i]), 0)), rb = __int_as_float(max(__float_as_int(D[sub][8 + i]), 0));
                sA = fmaf(wA[i], ra, sA); sB = fmaf(wB[i], rb, sB); }
            const int kidx = t * KT + 32 * sub + r; const unsigned ipart = (unsigned)(8191 - kidx);
            unsigned a = __float_as_uint(sA), b2 = __float_as_uint(sB);
            a ^= (unsigned)(((int)a >> 31) | (int)0x80000000); b2 ^= (unsigned)(((int)b2 >> 31) | (int)0x80000000);
            a = (a & 0xFFFFE000u) | ipart; b2 = (b2 & 0xFFFFE000u) | ipart;
            uA[sub] = kidx <= qposA ? a : 0u; uB[sub] = kidx <= qposB ? b2 : 0u;
        }
        LAS unsigned* dump = (LAS unsigned*)(lds + LDS_CNT) + wave;
#pragma unroll
        for (int sub = 0; sub < 4; ++sub) {
            const bool pA = uA[sub] > tauA, pB = uB[sub] > tauB;
            const unsigned long long mA = __builtin_amdgcn_ballot_w64(pA), mB = __builtin_amdgcn_ballot_w64(pB);
            const int loA = __popc((unsigned)mA), loB = __popc((unsigned)mB), hiA = __popc((unsigned)(mA >> 32)), hiB = __popc((unsigned)(mB >> 32));
            const int preA = mbcnt64(mA) - (hi ? loA : 0), preB = mbcnt64(mB) - (hi ? loB : 0);
            LAS unsigned* dA = pA ? bufA + cntA + preA : dump; LAS unsigned* dB = pB ? bufB + cntB + preB : dump;
            *dA = uA[sub]; *dB = uB[sub];
            cntA += hi ? hiA : loA; cntB += hi ? hiB : loB;
        }
        if (__builtin_amdgcn_ballot_w64(cntA > CAP - 128 || cntB > CAP - 128) != 0ull) { if (lane == 0) flg[t % 3] = 1u; }
    };
    v4u pa0, pa1, pb0, pb1;
    pa0 = *(const v4u*)(kbase + so0); pa1 = *(const v4u*)(kbase + so1);
    *(LAS v4u*)(lds + LDS_KT + sd0) = pa0; *(LAS v4u*)(lds + LDS_KT + sd1) = pa1;
    pb0 = pa0; pb1 = pa1;
    if (tid < 3) ((LAS unsigned*)(lds + LDS_CNT + 128))[tid] = 0u;
    if (ntile > 1) { pb0 = *(const v4u*)(kbase + 16384 + so0); pb1 = *(const v4u*)(kbase + 16384 + so1); }
    __syncthreads();
#pragma unroll 1
    for (int t = 0; t < ntile; t += 2) {
        if (t + 2 < ntile) { pa0 = *(const v4u*)(kbase + (size_t)(t + 2) * 16384 + so0); pa1 = *(const v4u*)(kbase + (size_t)(t + 2) * 16384 + so1); }
        compute_tile(t);
        if (t + 1 < ntile) { *(LAS v4u*)(lds + LDS_KT + 16384 + sd0) = pb0; *(LAS v4u*)(lds + LDS_KT + 16384 + sd1) = pb1; }
        __syncthreads();
        if (t + 1 < ntile) {
            if (t + 3 < ntile) { pb0 = *(const v4u*)(kbase + (size_t)(t + 3) * 16384 + so0); pb1 = *(const v4u*)(kbase + (size_t)(t + 3) * 16384 + so1); }
            compute_tile(t + 1);
            if (t + 2 < ntile) { *(LAS v4u*)(lds + LDS_KT + sd0) = pa0; *(LAS v4u*)(lds + LDS_KT + sd1) = pa1; }
            __syncthreads();
        }
    }
    }
    __builtin_amdgcn_s_setprio(0);
    unsigned short* IDXg = WSP(unsigned short, WS_IDX); int* NSELg = WSP(int, WS_NSEL);
#pragma unroll
    for (int qq = 0; qq < 4; ++qq) { int n = __builtin_amdgcn_readlane((qq & 1) ? cntB : cntA, (qq >> 1) * 32);
        if (n > TOPK) { int kept; (void)compact<true>(mybuf + qq * CAP, n, lane, kept, (LAS unsigned*)(lds + LDS_CNT) + wave); n = TOPK; }
        const v4u e4 = *(const LAS v4u*)(mybuf + qq * CAP + 4 * lane);
        v2u o;
        { const unsigned i0 = 4 * lane < n ? 8191u - (e4.x & 8191u) : 0u, i1 = 4 * lane + 1 < n ? 8191u - (e4.y & 8191u) : 0u, i2 = 4 * lane + 2 < n ? 8191u - (e4.z & 8191u) : 0u, i3 = 4 * lane + 3 < n ? 8191u - (e4.w & 8191u) : 0u;
          o.x = i0 | (i1 << 16); o.y = i2 | (i3 << 16); }
        const size_t row = rowbase + qw + qq;
        *(v2u*)(IDXg + row * TOPK + 4 * lane) = o;
        if (lane == 0) NSELg[row] = n; }
    LDS_WAIT();
    __syncthreads();
}

__device__ __forceinline__ void attend_wave(Frame& F, int b, int g, int t0) {
    const PArgs args = args_fresh(); const Tid TI = tid_fresh();
    const int lane = TI.lane, wave = TI.wave;
    const bf16* Qb = WSP(bf16, WS_Q); const bf16* Kb = WSP(bf16, WS_K); const bf16* Vb = WSP(bf16, WS_V); bf16* Ob = WSP(bf16, WS_O);
    const unsigned short* IDXg = WSP(unsigned short, WS_IDX); const int* NSELg = WSP(int, WS_NSEL);
    LAS unsigned char* Ks = F.lds + wave * 16384;
    LAS unsigned char* Vs = Ks + 8192;
    const size_t rowbase = (size_t)b * SEQ;
    const bf16* Kg = Kb + (size_t)(b * 4 + g) * SEQ * 64; const bf16* Vg = Vb + (size_t)(b * 4 + g) * SEQ * 64;
#define AT_KIDX(K, H, G) ((int)((K[H][((G) & 7) >> 1] >> (16 * ((G) & 1))) & 0xffffu))
#define AT_GATHER(K, BASE, C, dst) do { _Pragma("unroll") for (int i_ = 0; i_ < 8; ++i_) dst[i_] = *(const v4u*)((const char*)(BASE) + (unsigned)(AT_KIDX(K, i_ & 1, 4 * (C) + (i_ >> 1)) * 128 + 16 * (c8 ^ ks))); } while (0)
    v4u kA[2], kB[2], nA[2], nB[2]; bf16x8 bq0 = {}, bq1 = {}, bqn0 = {}, bqn1 = {};
    v4u kr[2][8], vr[2][8];
    { const int j = lane & 15, fq = lane >> 4, ks = lane >> 3, c8 = lane & 7; const size_t row = rowbase + t0;
#pragma unroll
      for (int h = 0; h < 2; ++h) { kA[h] = *(const v4u*)(IDXg + row * TOPK + 16 * (8 * h + ks)); kB[h] = *(const v4u*)(IDXg + row * TOPK + 16 * (8 * h + ks) + 8); }
      if (j < 4) { const bf16* qp = Qb + row * DM + (4 * g + j) * 64 + 8 * fq; bq0 = *(const bf16x8*)qp; bq1 = *(const bf16x8*)(qp + 32); }
      AT_GATHER(kA, Kg, 0, kr[0]); AT_GATHER(kA, Kg, 1, kr[1]); }
#pragma unroll 1
    for (int qi = 0; qi < 32; ++qi) {
        if (qi == 0) { if (wave >= 4) __builtin_amdgcn_s_setprio(1); } else if (qi == 16) { if (wave >= 4) __builtin_amdgcn_s_setprio(0); else __builtin_amdgcn_s_setprio(1); }
        int lq = lane; asm volatile("" : "+v"(lq));
        const int j = lq & 15, fq = lq >> 4, ks = lq >> 3, c8 = lq & 7;
        const size_t row = rowbase + t0 + qi; const int nsel = NSELg[row];
        const size_t rown = rowbase + t0 + min(qi + 1, 31);
        f32x4 lg[16];
#pragma unroll
        for (int C = 0; C < 4; ++C) {
#pragma unroll
            for (int i = 0; i < 8; ++i) *(LAS v4u*)(Ks + (8 * i + ks) * 128 + c8 * 16) = kr[C & 1][i];
            if (C + 2 < 4) AT_GATHER(kB, Kg, C + 2, kr[C & 1]);
            if (C == 2) AT_GATHER(kA, Vg, 0, vr[0]);
            if (C == 3) AT_GATHER(kA, Vg, 1, vr[1]);
#pragma unroll
            for (int gg = 0; gg < 4; ++gg) { const int G = 4 * C + gg; const int rr = 16 * gg + j;
                const bf16x8 a0 = *(const LAS bf16x8*)(Ks + rr * 128 + ((fq ^ (j & 7)) << 4)), a1 = *(const LAS bf16x8*)(Ks + rr * 128 + (((4 + fq) ^ (j & 7)) << 4));
                f32x4 acc = {0.f, 0.f, 0.f, 0.f};
                acc = __builtin_amdgcn_mfma_f32_16x16x32_bf16(a0, bq0, acc, 0, 0, 0);
                acc = __builtin_amdgcn_mfma_f32_16x16x32_bf16(a1, bq1, acc, 0, 0, 0);
                lg[G] = acc; }
        }
#pragma unroll
        for (int h = 0; h < 2; ++h) { nA[h] = *(const v4u*)(IDXg + rown * TOPK + 16 * (8 * h + ks)); nB[h] = *(const v4u*)(IDXg + rown * TOPK + 16 * (8 * h + ks) + 8); }
        if (j < 4) { const bf16* qp = Qb + rown * DM + (4 * g + j) * 64 + 8 * fq; bqn0 = *(const bf16x8*)qp; bqn1 = *(const bf16x8*)(qp + 32); }
        if (nsel < TOPK) {
#pragma unroll
            for (int G = 0; G < 16; ++G)
#pragma unroll
                for (int reg = 0; reg < 4; ++reg) if (16 * (4 * fq + reg) + G >= nsel) lg[G][reg] = -INFINITY;
        }
        float mx = -INFINITY, mx2 = -INFINITY;
#pragma unroll
        for (int G = 0; G < 16; ++G) { mx = fmaxf(fmaxf(mx, lg[G][0]), lg[G][1]); mx2 = fmaxf(fmaxf(mx2, lg[G][2]), lg[G][3]); }
        mx = fmaxf(mx, mx2);
        mx = fmaxf(mx, __shfl_xor(mx, 16)); mx = fmaxf(mx, __shfl_xor(mx, 32));
        h8 pb[8];
#pragma unroll
        for (int kk = 0; kk < 8; ++kk) { f32x8_t pv;
#pragma unroll
            for (int e = 0; e < 8; ++e) pv[e] = __builtin_amdgcn_exp2f(lg[2 * kk + (e >> 2)][e & 3] - mx);
            pb[kk] = __builtin_convertvector(pv, h8); }
        f32x4 osum = (f32x4){0.f, 0.f, 0.f, 0.f};
        { const _Float16 one = (_Float16)1.0f; h8 ones = {one, one, one, one, one, one, one, one}; asm volatile("" : "+v"(ones));
#pragma unroll
          for (int kk = 0; kk < 8; ++kk) osum = __builtin_amdgcn_mfma_f32_16x16x32_f16(ones, pb[kk], osum, 0, 0, 0); }
        f32x4 oacc[4];
#pragma unroll
        for (int db = 0; db < 4; ++db) oacc[db] = (f32x4){0.f, 0.f, 0.f, 0.f};
        const int tq_ = (lq >> 2) & 3, tp_ = lq & 3;
#pragma unroll
        for (int C = 0; C < 4; ++C) {
#pragma unroll
            for (int i = 0; i < 8; ++i) *(LAS v4u*)(Vs + (8 * i + ks) * 128 + c8 * 16) = vr[C & 1][i];
            if (C + 2 < 4) AT_GATHER(kB, Vg, C + 2, vr[C & 1]);
#pragma unroll
            for (int st = 0; st < 2; ++st) {
#pragma unroll
                for (int db = 0; db < 4; ++db) {
                    const int r0 = 16 * (2 * st) + 4 * fq + tq_, r1 = r0 + 16; const int ch = 2 * db + (tp_ >> 1);
                    const s16x4_t t0 = __builtin_amdgcn_ds_read_tr16_b64_v4i16((LAS s16x4_t*)(Vs + r0 * 128 + ((ch ^ (r0 & 7)) << 4) + 8 * (tp_ & 1)));
                    const s16x4_t t1 = __builtin_amdgcn_ds_read_tr16_b64_v4i16((LAS s16x4_t*)(Vs + r1 * 128 + ((ch ^ (r1 & 7)) << 4) + 8 * (tp_ & 1)));
                    const h8 va = __builtin_bit_cast(h8, (s16x8_t){t0[0], t0[1], t0[2], t0[3], t1[0], t1[1], t1[2], t1[3]});
                    oacc[db] = __builtin_amdgcn_mfma_f32_16x16x32_f16(va, pb[2 * C + st], oacc[db], 0, 0, 0);
                }
            }
            if (C == 0) { AT_GATHER(nA, Kg, 0, kr[0]); AT_GATHER(nA, Kg, 1, kr[1]); }
        }
        if (j < 4) { const float inv = 1.f / osum[0];
#pragma unroll
            for (int db = 0; db < 4; ++db) { v2u w; w.x = pk2(oacc[db][0] * inv, oacc[db][1] * inv); w.y = pk2(oacc[db][2] * inv, oacc[db][3] * inv);
                *(v2u*)(Ob + row * DM + (4 * g + j) * 64 + 16 * db + 4 * fq) = w; }
        }
        LDS_WAIT(); asm volatile("" ::: "memory");
#pragma unroll
        for (int h = 0; h < 2; ++h) { kA[h] = nA[h]; kB[h] = nB[h]; }
        bq0 = bqn0; bq1 = bqn1;
    }
#undef AT_GATHER
#undef AT_KIDX
    __builtin_amdgcn_s_setprio(0);
}

__device__ __forceinline__ void sample_unit(Frame& F, int li, int s) {
    const PArgs args = args_fresh(); const Tid TI = tid_fresh();
    LAS unsigned char* lds = F.lds; const int tid = TI.tid, lane = TI.lane, wave = TI.wave;
    LAS float* qi = (LAS float*)lds;
    LAS float* qs = qi + 512;
    LAS int* sel = (LAS int*)(qs + 1024);
    LAS float* lg = (LAS float*)(sel + 256);
    LAS int* cnt3 = (LAS int*)(lg + 4096);
    LAS int* cw = cnt3 + 4;
    const int row = MP + s;
    const bf16* QIb = WSP(bf16, WS_QI); const bf16* Qb = WSP(bf16, WS_Q); const float* WIb = WSP(float, WS_WI); bf16* Ob = WSP(bf16, WS_O);
    const float* ckidx = args.in(4) + (size_t)li * NPOOL * PAGE * IDIM; const float* ck = args.in(2) + (size_t)li * NPOOL * PAGE * KVW; const float* cv = args.in(3) + (size_t)li * NPOOL * PAGE * KVW;
    const int* pt = (const int*)args.in(6) + s * NPG;
    const float* nk = args.out() + O_KS + ((size_t)li * NS + s) * KVW; const float* nv = args.out() + O_VS + ((size_t)li * NS + s) * KVW; const float* nki = args.out() + O_KIS + ((size_t)li * NS + s) * IDIM;
    { const bf16 v = QIb[(size_t)row * IQW + tid]; qi[tid] = __uint_as_float((unsigned)v << 16); }
    { const bf16 v0 = Qb[(size_t)row * DM + tid], v1 = Qb[(size_t)row * DM + 512 + tid]; qs[tid] = __uint_as_float((unsigned)v0 << 16); qs[512 + tid] = __uint_as_float((unsigned)v1 << 16); }
    if (tid < 4) cnt3[tid] = 0;
    float wv[8];
#pragma unroll
    for (int h = 0; h < 8; ++h) wv[h] = WIb[(size_t)row * 8 + h];
    __syncthreads();
    unsigned long long keys[17];
#pragma unroll
    for (int j = 0; j < 17; ++j) {
        const int kidx = tid + 512 * j;
        if (kidx <= SEQ) {
            const float* kp = kidx < SEQ ? ckidx + ((size_t)pt[kidx >> 7] * PAGE + (kidx & 127)) * IDIM : nki;
            float acc[8];
#pragma unroll
            for (int h = 0; h < 8; ++h) acc[h] = 0.f;
            f32x4 kv[16];
#pragma unroll
            for (int d = 0; d < 16; ++d) kv[d] = *(const f32x4*)(kp + 4 * d);
            asm volatile("" ::: "memory");
#pragma unroll
            for (int d = 0; d < 64; d += 4) { const f32x4 k4 = kv[d >> 2];
#pragma unroll
                for (int h = 0; h < 8; ++h) { const f32x4 q4 = *(const LAS f32x4*)(qi + h * 64 + d); acc[h] += (q4[0] * k4[0] + q4[1] * k4[1]) + (q4[2] * k4[2] + q4[3] * k4[3]); } }
            float sc = 0.f;
#pragma unroll
            for (int h = 0; h < 8; ++h) sc = fmaf(wv[h], fmaxf(acc[h], 0.f), sc);
            unsigned u = __float_as_uint(sc); u ^= (u >> 31) ? 0xFFFFFFFFu : 0x80000000u;
            keys[j] = ((unsigned long long)u << 32) | (unsigned long long)(0xFFFFFFFFu - (unsigned)kidx);
        } else keys[j] = 0ull;
    }
    unsigned long long T = 0ull;
#pragma unroll 1
    for (int step = 0; step < 46; ++step) {
        const int bit = step < 32 ? 63 - step : 45 - step;
        if (step == 32) T |= 0xFFFFC000ull;
        const unsigned long long tr = T | (1ull << bit); int c = 0;
#pragma unroll
        for (int j = 0; j < 17; ++j) c += __popcll(__ballot(keys[j] >= tr));
        if (lane == 0) atomicAdd((int*)&cnt3[step % 3], c);
        __syncthreads();
        if (cnt3[step % 3] >= TOPK) T = tr;
        if (tid == 0) cnt3[(step + 2) % 3] = 0;
    }
#pragma unroll
    for (int j = 0; j < 17; ++j) { const int c = __popcll(__ballot(keys[j] >= T)); if (lane == 0) cw[j * 8 + wave] = c; }
    __syncthreads();
    if (tid == 0) { int run = 0; for (int i = 0; i < 136; ++i) { const int c = cw[i]; cw[i] = run; run += c; } }
    __syncthreads();
#pragma unroll
    for (int j = 0; j < 17; ++j) { const bool keep = keys[j] >= T; const unsigned long long m = __ballot(keep); if (keep) { const int pos = cw[j * 8 + wave] + mbcnt64(m); if (pos < TOPK) sel[pos] = tid + 512 * j; } }
    __syncthreads();
    LAS int* phys = cw + 144;
    if (tid < TOPK) { const int idx = sel[tid]; phys[tid] = idx < SEQ ? pt[idx >> 7] * PAGE + (idx & 127) : -1; }
    __syncthreads();
#pragma unroll
    for (int ii = 0; ii < 2; ++ii) {
        const int it = tid + 512 * ii;
        const int n = it & 255, kvh = it >> 8; const int pr = phys[n];
        const float* kp = pr >= 0 ? ck + (size_t)pr * KVW + kvh * 64 : nk + kvh * 64;
        f32x4 k4[16];
#pragma unroll
        for (int d = 0; d < 16; ++d) k4[d] = *(const f32x4*)(kp + 4 * d);
        float acc[4] = {0.f, 0.f, 0.f, 0.f};
#pragma unroll
        for (int d = 0; d < 16; ++d) {
#pragma unroll
            for (int i = 0; i < 4; ++i) { const f32x4 q4 = *(const LAS f32x4*)(qs + (4 * kvh + i) * 64 + 4 * d); acc[i] += (q4[0] * k4[d][0] + q4[1] * k4[d][1]) + (q4[2] * k4[d][2] + q4[3] * k4[d][3]); } }
#pragma unroll
        for (int i = 0; i < 4; ++i) lg[(4 * kvh + i) * 256 + n] = acc[i];
    }
    __syncthreads();
#pragma unroll
    for (int hh = 0; hh < 2; ++hh) { LAS float* l = lg + (2 * wave + hh) * 256; float v[4]; float mx = -INFINITY;
#pragma unroll
        for (int i = 0; i < 4; ++i) { v[i] = l[lane + 64 * i]; mx = fmaxf(mx, v[i]); }
        mx = wave_max(mx); float sum = 0.f;
#pragma unroll
        for (int i = 0; i < 4; ++i) { v[i] = __builtin_amdgcn_exp2f(v[i] - mx); sum += v[i]; }
        sum = wave_sum(sum); const float inv = 1.f / sum;
#pragma unroll
        for (int i = 0; i < 4; ++i) l[lane + 64 * i] = v[i] * inv; }
    __syncthreads();
    { const int hd = tid >> 5, dp = tid & 31, kvh = hd >> 2; float o0 = 0.f, o1 = 0.f;
#pragma unroll 1
      for (int n0 = 0; n0 < TOPK; n0 += 16) {
          f32x2 v[16];
#pragma unroll
          for (int k = 0; k < 16; ++k) { const int pr = phys[n0 + k]; const float* vp = pr >= 0 ? cv + (size_t)pr * KVW + kvh * 64 : nv + kvh * 64; v[k] = *(const f32x2*)(vp + 2 * dp); }
#pragma unroll
          for (int k = 0; k < 16; ++k) { const float p = lg[hd * 256 + n0 + k]; o0 = fmaf(p, v[k][0], o0); o1 = fmaf(p, v[k][1], o1); } }
      *(unsigned*)(Ob + (size_t)row * DM + hd * 64 + 2 * dp) = pk2(o0, o1); }
    __syncthreads();
}
}

#ifndef MK_SINGLE
#define MK_SINGLE 1
#endif
#ifndef EN_MASK
#define EN_MASK 0xFFFF
#endif
#define EN(b) ((EN_MASK >> (b)) & 1)
constexpr int N_PHASES = 32;
template <int NB, int NSTEPS, class Fn>
__device__ __forceinline__ float small_item(Frame& F, const bf16* A, int K, const bf16* W0, const bf16* W1, Fn fn) {
    const Tid T = tid_fresh(); const int lane = T.lane, wave = T.wave;
    const int kper = K >> 3, kbeg = wave * kper; constexpr int nsteps = NSTEPS;
    const bf16* ap = A + (size_t)(lane & 15) * K + 8 * (lane >> 4) + kbeg;
    const bf16* wp0 = W0 + (size_t)(lane & 15) * K + 8 * (lane >> 4) + kbeg;
    const bf16* wp1 = (NB == 2 ? W1 : W0) + (size_t)(lane & 15) * K + 8 * (lane >> 4) + kbeg;
    f32x4 d[NB][2];
#pragma unroll
    for (int nb = 0; nb < NB; ++nb) { d[nb][0] = (f32x4){0.f, 0.f, 0.f, 0.f}; d[nb][1] = d[nb][0]; }
    bf16x8 av0[nsteps], av1[nsteps], wv0[nsteps], wv1[NB == 2 ? nsteps : 1];
#pragma unroll
    for (int s = 0; s < nsteps; ++s) { av0[s] = *(const bf16x8*)(ap + 32 * s); av1[s] = *(const bf16x8*)(ap + (size_t)16 * K + 32 * s); wv0[s] = *(const bf16x8*)(wp0 + 32 * s);
        if constexpr (NB == 2) wv1[s] = *(const bf16x8*)(wp1 + 32 * s); }
    asm volatile("" ::: "memory");
#pragma unroll
    for (int s = 0; s < nsteps; ++s) {
        d[0][0] = __builtin_amdgcn_mfma_f32_16x16x32_bf16(wv0[s], av0[s], d[0][0], 0, 0, 0); d[0][1] = __builtin_amdgcn_mfma_f32_16x16x32_bf16(wv0[s], av1[s], d[0][1], 0, 0, 0);
        if constexpr (NB == 2) { d[1][0] = __builtin_amdgcn_mfma_f32_16x16x32_bf16(wv1[s], av0[s], d[1][0], 0, 0, 0); d[1][1] = __builtin_amdgcn_mfma_f32_16x16x32_bf16(wv1[s], av1[s], d[1][1], 0, 0, 0); }
    }
    LAS float* red = (LAS float*)(F.lds + RING_OFF);
#pragma unroll
    for (int nb = 0; nb < NB; ++nb)
#pragma unroll
        for (int f = 0; f < 2; ++f)
#pragma unroll
            for (int r = 0; r < 4; ++r) red[((wave * NB + nb) * 8 + f * 4 + r) * 64 + lane] = d[nb][f][r];
    __syncthreads();
    { const int i = wave, f = i >> 2, r = i & 3; float v[NB];
#pragma unroll
      for (int nb = 0; nb < NB; ++nb) { float s = 0.f;
#pragma unroll
          for (int w = 0; w < 8; ++w) s += red[((w * NB + nb) * 8 + i) * 64 + lane];
          v[nb] = s; }
      const float ret = fn((lane & 15) + 16 * f, 4 * (lane >> 4) + r, v[0], v[NB - 1]);
      __syncthreads();
      return ret; }
}
template <class Epi>
__device__ __forceinline__ void run_gemm(Frame& F, const bf16* A, const bf16* Bt, int M, int N, int K, const Epi E) {
    pg8::Gemm g{A, Bt, M, N, K}; pg8::StaticOrder S; S.init(M, N, F.G, (int)blockIdx.x);
    pg8::gemm_phase<Epi, pg8::StaticOrder, true, true>(F.lds + RING_OFF, g, S, E);
}

__global__ void __launch_bounds__(NWAVES * 64, 2) mega_fwd(Args kargs) {
    extern __shared__ __attribute__((aligned(16))) unsigned char lds_raw[];
    Frame F;
    F.lds = (LAS unsigned char*)lds_raw;
    F.MISC = (volatile LAS unsigned*)(F.lds + MISC_OFF);
    F.G = gridDim.x; { const int bx = blockIdx.x; F.vcu = (F.G % 8 == 0) ? (bx % 8) * (F.G / 8) + bx / 8 : bx; }
    for (int u = threadIdx.x; u < (LDS_BYTES - LDSCTL_OFF) / 4; u += NWAVES * 64) ((LAS unsigned*)(F.lds + LDSCTL_OFF))[u] = 0u;
    __syncthreads();
    const int lo = kargs.ph_lo, hi = kargs.ph_hi;
    unsigned* const barw = (unsigned*)(kargs.ws + WS_CTL) + CW_BAR;
    XcdBarrier bar; bar.bar = barw; bar.x = 0; bar.st = nullptr;
    if (hi - lo > 1) bar = xcd_barrier_post(barw, F.MISC + 8);
    int ph = 0;
#define PH_ON() (ph >= lo && ph < hi)
#define PH_END() do { if (ph >= lo && ph + 1 < hi) xcd_barrier(bar); ++ph; } while (0)

#ifndef PROBE_P0
#define PROBE_P0 1
#endif
    if (EN(0) && PH_ON()) { for (int rep = 0; rep < PROBE_P0; ++rep) p0_prologue(F); }
    PH_END();

#pragma unroll 1
    for (int j = 0; j < 12; ++j) {
        const int layer = j / 3, kind = j - 3 * layer, li = layer >> 1; const bool is_attn = (layer & 1) == 0;
#ifndef PROBE_MOD
#define PROBE_MOD 1
#endif
        if (j == 0) { if (EN(1) && PH_ON()) mod_phase(F, layer, kind); PH_END(); }
        if (kind != 1) {
            if (EN(2) && PH_ON()) { const PArgs args = args_fresh(); const int sff = 2 * layer + (kind >> 1);
                EpiSwiglu E{WSP(bf16, WS_U)};
#ifndef PROBE_FI
#define PROBE_FI 1
#endif
#pragma unroll 1
                for (int rep = 0; rep < PROBE_FI; ++rep) run_gemm(F, WSP(bf16, WS_H), WSP(bf16, WS_WFI) + (size_t)sff * NFFIN * DM, MROWS, NFFIN, DM, E);
                { constexpr int NU = (MROWS / 256) * (NFFIN / 256); const int tail = NU % F.G;
                  const int code = sff == 0 ? 2 : sff == 1 ? 3 : sff == 2 ? 4 : sff == 3 ? 9 : sff == 4 ? 5 : sff == 5 ? 11 : sff == 6 ? 7 : -1;
                  if (tail != 0) convert_in_tail(F, code, tail); else if (code >= 0) convert_set(F, code, F.vcu * NWAVES + __builtin_amdgcn_readfirstlane((int)threadIdx.x >> 6), F.G * NWAVES); } }
            PH_END();
        } else if (is_attn) {
            if (EN(4) && PH_ON()) { const PArgs args = args_fresh();
                EpiAttnIn E{WSP(bf16, WS_Q), WSP(bf16, WS_K), WSP(bf16, WS_V), WSP(bf16, WS_QI), WSP(bf16, WS_KI), WSP(float, WS_WI), args.in(15) + li * HDIM, args.in(16) + li * HDIM,
                            args.out() + O_KP + (size_t)li * MP * KVW, args.out() + O_VP + (size_t)li * MP * KVW, args.out() + O_KIP + (size_t)li * MP * IDIM,
                            args.out() + O_KS + (size_t)li * NS * KVW, args.out() + O_VS + (size_t)li * NS * KVW, args.out() + O_KIS + (size_t)li * NS * IDIM};
                run_gemm(F, WSP(bf16, WS_H), WSP(bf16, WS_WAI) + (size_t)li * ATT_NP * DM, MROWS, ATT_NP, DM, E);
                { constexpr int NU = (MROWS / 256) * (ATT_NP / 256); const int tail = NU % F.G; const int code = li == 0 ? 10 : 6;
                  if (tail != 0) convert_in_tail(F, code, tail); else convert_set(F, code, F.vcu * NWAVES + __builtin_amdgcn_readfirstlane((int)threadIdx.x >> 6), F.G * NWAVES); }
            }
            PH_END();
#ifndef PROBE_A1
#define PROBE_A1 1
#endif
            if (EN(5) && PH_ON()) {
                const int qb = (2 * F.vcu) / F.G;
#pragma unroll 1
              for (int rep = 0; rep < PROBE_A1; ++rep) {
                gu32* qhead = (gu32*)(args_fresh().ws() + WS_CTL) + CW_Q + (li * 2 + qb + 4 * rep) * 64;
#pragma unroll 1
                for (;;) {
                    if (threadIdx.x == 0) F.MISC[4] = __hip_atomic_fetch_add(qhead, 1u, __ATOMIC_RELAXED, __HIP_MEMORY_SCOPE_AGENT);
                    __syncthreads();
                    const int t = (int)F.MISC[4];
                    __syncthreads();
                    if (t >= 16 + 256) break;
                    if (t < 16) { if (EN(6)) a1::sample_unit(F, li, qb * 16 + t); }
                    else a1::prompt_unit(F, qb, 255 - (t - 16));
                }
              }
            }
            PH_END();
            if (EN(5) && PH_ON()) {
                const int grp = (8 * F.vcu) / F.G, wgi = F.vcu - grp * (F.G / 8), per = SEQ / (F.G / 8);
                const int wv = __builtin_amdgcn_readfirstlane((int)threadIdx.x >> 6);
#pragma unroll 1
                for (int q0 = wgi * per + 32 * wv; q0 < (wgi + 1) * per; q0 += 256) a1::attend_wave(F, grp >> 2, grp & 3, q0);
            }
            PH_END();
        } else {
            if (EN(8) && PH_ON()) { const PArgs args = args_fresh(); const float* st = args.in(5) + (size_t)li * NS * 2 * DM;
                EpiConvCU E{WSP(bf16, WS_Z), args.out() + O_CVP + (size_t)li * NBP * 2 * DM, args.out() + O_CVS + (size_t)li * NS * 2 * DM, st};
                run_gemm(F, WSP(bf16, WS_H), WSP(bf16, WS_WCU) + (size_t)li * 2 * DM * DM, MP, 2 * DM, DM, E);
                if (blockIdx.x < 64) { const int zb = blockIdx.x; const bf16* w0 = WSP(bf16, WS_WCU) + (size_t)li * 2 * DM * DM + (size_t)(256 * (zb >> 3) + 16 * (zb & 7)) * DM;
                    bf16* Zb = WSP(bf16, WS_Z); float* ocvs = args.out() + O_CVS + (size_t)li * NS * 2 * DM;
                    small_item<2, 4>(F, WSP(bf16, WS_H) + (size_t)MP * DM, DM, w0, w0 + (size_t)128 * DM, [=](int m, int c, float vc, float vu) {
                        const int col = 16 * zb + c; const float z = vc * vu; Zb[(size_t)(MP + m) * DM + col] = (bf16)(pk2(z, 0.f) & 0xffffu);
                        ocvs[(size_t)(2 * m + 1) * DM + col] = z; ocvs[(size_t)(2 * m) * DM + col] = st[(size_t)(2 * m + 1) * DM + col]; return 0.f; }); } }
            PH_END();
            if (EN(9) && PH_ON()) { const PArgs args = args_fresh(); const float* st = args.in(5) + (size_t)li * NS * 2 * DM;
                EpiConvB E{WSP(bf16, WS_Z), WSP(bf16, WS_O), args.in(18) + (size_t)li * 3 * DM, st}; run_gemm(F, WSP(bf16, WS_H), WSP(bf16, WS_WCB) + (size_t)li * DM * DM, MP, DM, DM, E);
                if (blockIdx.x < 64) { const int nb = blockIdx.x; const bf16* Zb = WSP(bf16, WS_Z); bf16* A2 = WSP(bf16, WS_O); const float* cw = args.in(18) + (size_t)li * 3 * DM;
                    small_item<1, 4>(F, WSP(bf16, WS_H) + (size_t)MP * DM, DM, WSP(bf16, WS_WCB) + (size_t)li * DM * DM + (size_t)16 * nb * DM, nullptr, [=](int m, int c, float v, float) {
                        const int col = 16 * nb + c; const float zt = __uint_as_float((unsigned)Zb[(size_t)(MP + m) * DM + col] << 16);
                        const float y = cw[col] * st[(size_t)(2 * m) * DM + col] + cw[DM + col] * st[(size_t)(2 * m + 1) * DM + col] + cw[2 * DM + col] * zt;
                        A2[(size_t)(MP + m) * DM + col] = (bf16)(pk2(v * y, 0.f) & 0xffffu); return 0.f; }); } }
            PH_END();
        }
        if (EN(3) && PH_ON()) { const PArgs args = args_fresh();
            const bf16* ra; const bf16* rb; int rk; int rflags;
            if (kind != 1) { const int sff = 2 * layer + (kind >> 1); ra = WSP(bf16, WS_U); rb = WSP(bf16, WS_WFO) + (size_t)sff * DM * DFF; rk = DFF; rflags = 1; }
            else if (is_attn) { ra = WSP(bf16, WS_O); rb = WSP(bf16, WS_WAO) + (size_t)li * DM * DM; rk = DM; rflags = 0; }
            else { ra = WSP(bf16, WS_O); rb = WSP(bf16, WS_WCO) + (size_t)li * DM * DM; rk = DM; rflags = 0; }
            const bool fuse = j < 11; const int nl = (j + 1) / 3, nk = (j + 1) - 3 * nl;
            const float* modn = WSP(float, WS_MOD) + (size_t)nl * NBATCH * MODW + nk * 3 * DM;
            float* xslots = WSP(float, WS_XS) + (size_t)j * XS_STRIDE; unsigned* pcnt = (unsigned*)(args.ws() + WS_CTL) + CW_PC + (size_t)j * 65 * 64;
            EpiResidMod E{WSP(float, WS_X), WSP(float, WS_MOD) + (size_t)layer * NBATCH * MODW + (3 * kind + 2) * DM, args.out() + O_YP, rflags | (j == 11 ? 2 : 0) | (fuse ? 4 : 0),
                          xslots, pcnt, WSP(bf16, WS_H), modn};
            float xk = 0.f; const bool smp = blockIdx.x < 64; const int nb = blockIdx.x;
            float* ss = xslots + (size_t)MP * 4; unsigned* scn = pcnt + 64 * 64;
            if (smp) { float* X = WSP(float, WS_X); const float* gate = WSP(float, WS_MOD) + (size_t)layer * NBATCH * MODW + (3 * kind + 2) * DM;
                float* outp = args.out() + O_YP; const float coef = (rflags & 1) ? 0.5f : 1.0f; const bool mirror = j == 11;
                const Tid T0 = tid_fresh(); const int pm_ = (T0.lane & 15) + 16 * (T0.wave >> 2), pc_ = 4 * (T0.lane >> 4) + (T0.wave & 3);
                const float xpre = X[(size_t)(MP + pm_) * DM + 16 * nb + pc_], gpre = gate[(size_t)(2 + pm_) * MODW + 16 * nb + pc_];
                auto fin = [=](int m, int c, float v, float) -> float {
                    const int col = 16 * nb + c; const size_t o = (size_t)(MP + m) * DM + col;
                    const float x = xpre + coef * gpre * v; X[o] = x; if (mirror) outp[o] = x; return x; };
                if (rk == DFF) xk = small_item<1, DFF / 256>(F, ra + (size_t)MP * rk, rk, rb + (size_t)16 * nb * rk, nullptr, fin);
                else xk = small_item<1, DM / 256>(F, ra + (size_t)MP * rk, rk, rb + (size_t)16 * nb * rk, nullptr, fin);
                if (fuse) { const Tid T = tid_fresh(); const int m = (T.lane & 15) + 16 * (T.wave >> 2);
                    LAS float* part = (LAS float*)(F.lds + RING_OFF + 65536);
                    float s = xk * xk; s += __shfl_xor(s, 16); s += __shfl_xor(s, 32);
                    if (T.lane < 16) part[(T.wave & 3) * 32 + m] = s;
                    __syncthreads();
                    if (T.tid < 32) { const float t4 = (part[T.tid] + part[32 + T.tid]) + (part[64 + T.tid] + part[96 + T.tid]);
                        __hip_atomic_store((unsigned*)ss + T.tid * 64 + nb, __float_as_uint(t4), __ATOMIC_RELAXED, __HIP_MEMORY_SCOPE_AGENT); }
                    asm volatile("s_waitcnt vmcnt(0)" ::: "memory");
                    __syncthreads();
                    if (T.tid == 0) (void)__hip_atomic_fetch_add(scn, 1u, __ATOMIC_RELAXED, __HIP_MEMORY_SCOPE_AGENT);
                } }
            run_gemm(F, ra, rb, MP, DM, rk, E);
            if (smp && fuse) { const Tid T = tid_fresh(); const int tid = T.tid;
                LAS float* rsl = (LAS float*)(F.lds + RING_OFF + 65536);
                if (tid == 0) { unsigned sp = 0;
                    while (__hip_atomic_load(scn, __ATOMIC_RELAXED, __HIP_MEMORY_SCOPE_AGENT) < 64u) { __builtin_amdgcn_s_sleep(2); if (++sp > (1u << 20)) break; }
                    __builtin_amdgcn_fence(__ATOMIC_ACQUIRE, "agent"); asm volatile("s_waitcnt vmcnt(0)" ::: "memory"); }
                __syncthreads();
                { const int m = tid >> 4, k4 = (tid & 15) * 4; f32x4 q4;
                  asm volatile("global_load_dwordx4 %0, %1, off sc1\n\ts_waitcnt vmcnt(0)" : "=v"(q4) : "v"((const unsigned*)ss + m * 64 + k4) : "memory");
                  float q = (q4[0] + q4[1]) + (q4[2] + q4[3]);
                  q += __shfl_xor(q, 1); q += __shfl_xor(q, 2); q += __shfl_xor(q, 4); q += __shfl_xor(q, 8);
                  if ((tid & 15) == 0) rsl[m] = __builtin_amdgcn_rsqf(q * (1.f / DM) + RMS_EPS); }
                __syncthreads();
                { const int m = (T.lane & 15) + 16 * (T.wave >> 2), c = 4 * (T.lane >> 4) + (T.wave & 3), col = 16 * nb + c; const float* mb = modn + (size_t)(2 + m) * MODW + col;
                  const float h = xk * rsl[m] * (mb[DM] + 1.f) + mb[0];
                  WSP(bf16, WS_H)[(size_t)(MP + m) * DM + col] = (bf16)(pk2(h, 0.f) & 0xffffu); }
                __syncthreads();
            } }
        PH_END();
    }
#undef PH_ON
#undef PH_END
}

extern "C" void kernel_launch(void* const* d_in, const int* in_sizes, int n_in, void* d_out, int out_size, void* d_ws, size_t ws_size, hipStream_t stream) {
    static int grid = 0;
    if (grid == 0) {
        if (n_in != 20 || (size_t)out_size != O_END || ws_size < WS_END) { fprintf(stderr, "kernel_launch: unexpected problem shape (n_in %d, out %d, ws %zu); nothing launched\n", n_in, out_size, ws_size); grid = -1; return; }
        int dev = 0, cus = 0, per_cu = 0;
        if (hipGetDevice(&dev) != hipSuccess || hipDeviceGetAttribute(&cus, hipDeviceAttributeMultiprocessorCount, dev) != hipSuccess) { grid = -1; return; }
        if (hipFuncSetAttribute((const void*)mega_fwd, hipFuncAttributeMaxDynamicSharedMemorySize, LDS_BYTES) != hipSuccess) { fprintf(stderr, "kernel_launch: hipFuncSetAttribute failed\n"); grid = -1; return; }
        if (hipOccupancyMaxActiveBlocksPerMultiprocessor(&per_cu, (const void*)mega_fwd, NWAVES * 64, LDS_BYTES) != hipSuccess || per_cu < 1)
            fprintf(stderr, "kernel_launch: note: occupancy query reports %d workgroups per CU\n", per_cu);
        (void)hipGetLastError();
        grid = cus;
    }
    if (grid < 0) return;
    if (hipMemsetAsync((char*)d_ws + WS_CTL, 0, CTL_ZERO_BYTES, stream) != hipSuccess) return;
    Args a{};
    for (int i = 0; i < 20; ++i) a.in[i] = (const float*)d_in[i];
    a.out = (float*)d_out; a.ws = (unsigned char*)d_ws;
#if MK_SINGLE
    a.ph_lo = 0; a.ph_hi = N_PHASES;
    hipLaunchKernelGGL(mega_fwd, dim3(grid), dim3(NWAVES * 64), LDS_BYTES, stream, a);
#else
    for (int p = 0; p < N_PHASES; ++p) { a.ph_lo = p; a.ph_hi = p + 1; hipLaunchKernelGGL(mega_fwd, dim3(grid), dim3(NWAVES * 64), LDS_BYTES, stream, a); }
#endif
}
```
